# Optimizing an MI355X kernel written in HIP

```python
import jax, jax.numpy as jnp
from jax import lax
import numpy as np

D_MODEL = 1024
BATCH = 8
SEQ = 2048
DEPTH = 2

D_A = D_MODEL
SG_GROUPS = 8
SG_GROUP_DIM = D_A // SG_GROUPS
SG_CHUNK = 128
D_H = D_MODEL
REC_HEAD_DIM = 128
REC_HEADS = D_H // REC_HEAD_DIM
REC_CHUNK = 64
D_FF = 4 * D_MODEL
EPS = 1e-6
N_IN = 2 * D_A + 5 * D_H + 2 * D_MODEL

kernel_name = "gmlp_hgrn2_gated_hybrid_encoder"


def rmsnorm(x, gain):
    xf = x.astype(jnp.float32)
    y = xf * lax.rsqrt(jnp.mean(jnp.square(xf), axis=-1, keepdims=True) + EPS)
    return (y * gain.astype(jnp.float32)).astype(x.dtype)


def spatial_gating(u, v, norm_gain, w_s, b_s):
    bsz, seq, _ = u.shape
    nch = seq // SG_CHUNK
    zu = jax.nn.gelu(u, approximate=False)
    zv = jax.nn.gelu(v, approximate=False)
    vg = zv.reshape(bsz, nch, SG_CHUNK, SG_GROUPS, SG_GROUP_DIM)
    vg = rmsnorm(vg, norm_gain.reshape(SG_GROUPS, SG_GROUP_DIM))
    mixed = jnp.einsum('gts,bcsgd->bctgd', w_s, vg) + b_s.T[None, None, :, :, None]
    return zu * mixed.reshape(bsz, seq, D_A)


def hgrn2_chunk_scan(q, k, v, logf):
    n, seq, h, dk = q.shape
    dv = v.shape[-1]
    nc = seq // REC_CHUNK

    def to_chunks(a):
        return a.reshape(n, nc, REC_CHUNK, h, a.shape[-1]).transpose(1, 0, 3, 2, 4)

    qc, kc, vc, gc = to_chunks(q), to_chunks(k), to_chunks(v), to_chunks(logf)
    bc = jnp.cumsum(gc, axis=3)
    causal_in_scan = jnp.tril(jnp.ones((REC_CHUNK, REC_CHUNK), dtype=bool))[:, :, None]

    def step(state, inp):
        qi, ki, vi, bi = inp
        rel = bi[:, :, :, None, :] - bi[:, :, None, :, :]
        decay = jnp.exp(jnp.where(causal_in_scan, rel, -jnp.inf))
        scores = jnp.einsum('nhtk,nhsk,nhtsk->nhts', qi, ki, decay)
        o_intra = jnp.einsum('nhts,nhsv->nhtv', scores, vi)
        o_inter = jnp.einsum('nhtk,nhkv->nhtv', qi * jnp.exp(bi), state)
        b_last = bi[:, :, -1:, :]
        new_state = jnp.exp(b_last[:, :, 0, :])[..., None] * state + jnp.einsum(
            'nhsk,nhsv->nhkv', ki * jnp.exp(b_last - bi), vi)
        return new_state, o_intra + o_inter

    state0 = jnp.zeros((n, h, dk, dv), jnp.float32)
    _, oc = lax.scan(step, state0, (qc, kc, vc, bc))
    return oc.transpose(1, 0, 3, 2, 4).reshape(n, seq, h, dv)


def hgrn2_bidir(q, f_fw, f_bw, i_in, og, lower, norm_gain):
    bsz, seq, _ = q.shape

    def heads(t):
        return t.astype(jnp.float32).reshape(bsz, seq, REC_HEADS, REC_HEAD_DIM)

    def log_forget(z, lb):
        lb = lb.reshape(REC_HEADS, REC_HEAD_DIM)
        return jnp.logaddexp(jnp.log(lb), jnp.log1p(-lb) + jax.nn.log_sigmoid(z))

    logf = jnp.concatenate([log_forget(heads(f_fw), lower[0]),
                            jnp.flip(log_forget(heads(f_bw), lower[1]), axis=1)], axis=0)
    key = -jnp.expm1(logf)
    qh = heads(q)
    vh = jax.nn.silu(heads(i_in))
    qq = jnp.concatenate([qh, jnp.flip(qh, axis=1)], axis=0)
    vv = jnp.concatenate([vh, jnp.flip(vh, axis=1)], axis=0)
    o = hgrn2_chunk_scan(qq, key, vv, logf)
    o = o[:bsz] + jnp.flip(o[bsz:], axis=1)
    o = rmsnorm(o, norm_gain.reshape(REC_HEADS, REC_HEAD_DIM))
    o = o.reshape(bsz, seq, D_H) * jax.nn.silu(og.astype(jnp.float32))
    return o.astype(og.dtype)


def setup_inputs(seed: int = 0) -> dict:
    key = jax.random.key(seed)
    ks = jax.random.split(key, 16)
    f32 = jnp.float32

    def nrm(k, shape, scale):
        return jax.random.normal(k, shape, f32) * scale

    return {
        "x": nrm(ks[0], (BATCH, SEQ, D_MODEL), 1.0),
        "w_in": nrm(ks[1], (DEPTH, D_MODEL, N_IN), D_MODEL ** -0.5),
        "ln_mix": 1.0 + nrm(ks[2], (DEPTH, D_MODEL), 0.02),
        "ln_mlp": 1.0 + nrm(ks[3], (DEPTH, D_MODEL), 0.02),
        "sg_norm": 1.0 + nrm(ks[4], (DEPTH, D_A), 0.02),
        "w_s": nrm(ks[5], (DEPTH, SG_GROUPS, SG_CHUNK, SG_CHUNK), SG_CHUNK ** -0.5),
        "b_s": 1.0 + nrm(ks[6], (DEPTH, SG_GROUPS, SG_CHUNK), 0.1),
        "lb_logits": nrm(ks[7], (DEPTH, 2, D_H), 1.0),
        "rec_norm": 1.0 + nrm(ks[8], (DEPTH, D_H), 0.02),
        "w_pa": nrm(ks[9], (DEPTH, D_A, D_MODEL), D_A ** -0.5),
        "w_pb": nrm(ks[10], (DEPTH, D_H, D_MODEL), D_H ** -0.5),
        "w_out": nrm(ks[11], (DEPTH, D_MODEL, D_MODEL), D_MODEL ** -0.5),
        "w_up": nrm(ks[12], (DEPTH, D_MODEL, D_FF), D_MODEL ** -0.5),
        "w_down": nrm(ks[13], (DEPTH, D_FF, D_MODEL), D_FF ** -0.5),
        "ln_final": 1.0 + nrm(ks[14], (D_MODEL,), 0.02),
    }


def reference(x, w_in, ln_mix, ln_mlp, sg_norm, w_s, b_s, lb_logits, rec_norm,
              w_pa, w_pb, w_out, w_up, w_down, ln_final):
    probs = jax.nn.softmax(lb_logits.astype(jnp.float32), axis=0)
    cum = jnp.cumsum(probs, axis=0)
    lower = cum - cum[0:1]
    splits = [D_A, 2 * D_A, 2 * D_A + D_H, 2 * D_A + 2 * D_H, 2 * D_A + 3 * D_H,
              2 * D_A + 4 * D_H, 2 * D_A + 5 * D_H, 2 * D_A + 5 * D_H + D_MODEL]
    h = x
    for l in range(DEPTH):
        xn = rmsnorm(h, ln_mix[l])
        proj = xn @ w_in[l]
        u, v, q, f_fw, f_bw, i_in, og, ga, gb = jnp.split(proj, splits, axis=-1)
        a = spatial_gating(u, v, sg_norm[l], w_s[l], b_s[l])
        r = hgrn2_bidir(q, f_fw, f_bw, i_in, og, lower[l], rec_norm[l])
        merged = jax.nn.sigmoid(ga) * (a @ w_pa[l]) + jax.nn.sigmoid(gb) * (r @ w_pb[l])
        h = h + merged @ w_out[l]
        hn = rmsnorm(h, ln_mlp[l])
        h = h + jnp.square(jax.nn.relu(hn @ w_up[l])) @ w_down[l]
    return rmsnorm(h, ln_final)
```

```cpp
#define ONE_LAUNCH 1
#include <hip/hip_runtime.h>
#include <hip/hip_cooperative_groups.h>
#include <cstdio>
#include <cstdint>
namespace cg = cooperative_groups;
namespace pg8 {
#define PG8_LAS __attribute__((address_space(3)))
typedef unsigned short bf16_t;
typedef short bf16x8 __attribute__((ext_vector_type(8)));
typedef float f32x4 __attribute__((ext_vector_type(4)));
typedef unsigned u32x4 __attribute__((ext_vector_type(4)));
constexpr int BM = 256, BK = 64, HALF = 128, HTB = HALF * BK * 2  , STAGE_BYTES = 8 * HTB, NXCD = 8, WGM = 8;

__host__ __device__ __forceinline__ int lds_byte(int r, int c) { const int st = (r >> 4) * 2 + (c >> 5), rr = r & 15, cc = c & 31, ob = rr * 64 + cc * 2; return st * 1024 + (ob ^ (((ob >> 9) & 1) << 5)); }
__host__ __device__ __forceinline__ void stage_rc(int b, int& R, int& C) { const int st = b / 1024, sb = b % 1024, swz = sb ^ (((sb >> 9) & 1) << 5); R = (st >> 1) * 16 + swz / 64; C = (st & 1) * 32 + (swz % 64) / 2; }
__host__ __device__ __forceinline__ int perm32(int rho) { const int n = rho >> 4, i = rho & 15; return 8 * (i >> 2) + 4 * n + (i & 3); }

struct Unit { int pm, pn; };
struct Gemm { const bf16_t* A; const bf16_t* Bt; int M, N, K; };

struct StaticOrder {
    int nM, nN, nwg, G, c;
    __host__ __device__ void init(int M, int N, int G_, int c_) { nM = M / BM; nN = N / BM; nwg = nM * nN; G = G_; c = c_; }
    __host__ __device__ bool next(int i, Unit& u) const {
        const long L = (long)i * G + c; if (L >= nwg) return false;
        int wgid = (int)L; { const int q = nwg / NXCD, r = nwg % NXCD, xcd = wgid % NXCD, off = wgid / NXCD; wgid = (xcd < r ? xcd * (q + 1) : r * (q + 1) + (xcd - r) * q) + off; }
        const int nig = WGM * nN, gid = wgid / nig, fm = gid * WGM, gsz = (nM - fm) < WGM ? (nM - fm) : WGM;
        u.pm = fm + ((wgid % nig) % gsz); u.pn = (wgid % nig) / gsz; return true;
    }
    __device__ __forceinline__ void a_ready(const Unit&) const {}
    __device__ __forceinline__ void done(const Unit&) const {}
};

typedef float cvt_f32x2_t __attribute__((ext_vector_type(2)));
typedef __bf16 cvt_bf16x2_t __attribute__((ext_vector_type(2)));
__device__ __forceinline__ unsigned cvt_pk_bf16(float lo, float hi) { cvt_f32x2_t v = {lo, hi}; cvt_bf16x2_t b = __builtin_convertvector(v, cvt_bf16x2_t); return __builtin_bit_cast(unsigned, b); }
typedef float f32x2 __attribute__((ext_vector_type(2)));
__device__ __forceinline__ f32x2 gelu_pk(f32x2 v) {
    const f32x2 av = __builtin_elementwise_abs(v), d = av * 0.2316418882f + 1.0f;
    f32x2 t; t.x = __builtin_amdgcn_rcpf(d.x); t.y = __builtin_amdgcn_rcpf(d.y);
    f32x2 q = t * 0.5307027145f + (-0.7265760135f); q = q * t + 0.7107068705f; q = q * t + (-0.142248368f); q = q * t + 0.127414796f; q = q * t;
    const f32x2 s = (v * v) * (-0.72134752044f);
    f32x2 e; e.x = __builtin_amdgcn_exp2f(s.x); e.y = __builtin_amdgcn_exp2f(s.y);
    const f32x2 m = v * (q * e), r = v - m;
    f32x2 o; o.x = v.x < 0.f ? m.x : r.x; o.y = v.y < 0.f ? m.y : r.y; return o;
}
__device__ __forceinline__ float bflo(unsigned u) { return __builtin_bit_cast(float, u << 16); }
__device__ __forceinline__ float bfhi(unsigned u) { return __builtin_bit_cast(float, u & 0xffff0000u); }
__device__ __forceinline__ float sigm(float z) { return __builtin_amdgcn_rcpf(1.0f + __expf(-z)); }
template <int MODE> struct EpiProj {
    static constexpr bool PERM = true, AFTER_DRAIN = false;
    bf16_t* out0; size_t sec_stride; const float* lb;
    __device__ __forceinline__ void operator()(const f32x4 (&acc)[2][2][4][2], const Unit& u, int wr, int wc, int fr, int fq) const {
        const int colt = u.pn * BM, sec = colt >> 10;
        bf16_t* base = out0 + (size_t)sec * sec_stride;
        const int col0 = (colt & 1023) + wc * 32 + 8 * fq, row0 = u.pm * BM + wr * 64 + fr;
        const float* lbrow = lb + sec * 1024 + col0;
#pragma unroll
        for (int ai = 0; ai < 2; ++ai)
#pragma unroll
            for (int m = 0; m < 4; ++m) { bf16_t* rowp = base + (size_t)(row0 + ai * HALF + m * 16) * 1024 + col0;
#pragma unroll
                for (int bj = 0; bj < 2; ++bj) { f32x4 v[2] = {acc[ai][bj][m][0], acc[ai][bj][m][1]};
#pragma unroll
                    for (int n = 0; n < 2; ++n) {
                        if (MODE == 0) { f32x2 a = gelu_pk((f32x2){v[n][0], v[n][1]}), b = gelu_pk((f32x2){v[n][2], v[n][3]}); v[n] = (f32x4){a.x, a.y, b.x, b.y}; }
                        else if (MODE == 2) { const f32x4 lbv = *(const f32x4*)(lbrow + bj * HALF + 4 * n);
#pragma unroll
                            for (int e = 0; e < 4; ++e) { const float l = lbv[e]; const float f = l + (1.0f - l) * sigm(v[n][e]); v[n][e] = __logf(f); }
                        } else if (MODE == 3) {
#pragma unroll
                            for (int e = 0; e < 4; ++e) v[n][e] = v[n][e] * sigm(v[n][e]);
                        } else if (MODE == 4) {
#pragma unroll
                            for (int e = 0; e < 4; ++e) v[n][e] = sigm(v[n][e]);
                        }
                    }
                    u32x4 w; w.x = cvt_pk_bf16(v[0][0], v[0][1]); w.y = cvt_pk_bf16(v[0][2], v[0][3]); w.z = cvt_pk_bf16(v[1][0], v[1][1]); w.w = cvt_pk_bf16(v[1][2], v[1][3]);
                    *(u32x4*)(rowp + bj * HALF) = w; } }
    }
};
struct EpiGate {
    static constexpr bool PERM = true, AFTER_DRAIN = false;
    const bf16_t* gate; const bf16_t* addend; bf16_t* out;
    __device__ __forceinline__ void operator()(const f32x4 (&acc)[2][2][4][2], const Unit& u, int wr, int wc, int fr, int fq) const {
        const int col0 = u.pn * BM + wc * 32 + 8 * fq, row0 = u.pm * BM + wr * 64 + fr;
#pragma unroll
        for (int ai = 0; ai < 2; ++ai)
#pragma unroll
            for (int m = 0; m < 4; ++m) { asm volatile("" ::: "memory"); __builtin_amdgcn_sched_barrier(0); const size_t ro = (size_t)(row0 + ai * HALF + m * 16) * 1024 + col0;
#pragma unroll
                for (int bj = 0; bj < 2; ++bj) {
                    const u32x4 gv = *(const u32x4*)(gate + ro + bj * HALF);
                    u32x4 av = (u32x4){0u, 0u, 0u, 0u}; if (addend) av = *(const u32x4*)(addend + ro + bj * HALF);
                    const f32x4 v0 = acc[ai][bj][m][0], v1 = acc[ai][bj][m][1];
                    u32x4 w;
                    w.x = cvt_pk_bf16(bflo(av.x) + bflo(gv.x) * v0[0], bfhi(av.x) + bfhi(gv.x) * v0[1]);
                    w.y = cvt_pk_bf16(bflo(av.y) + bflo(gv.y) * v0[2], bfhi(av.y) + bfhi(gv.y) * v0[3]);
                    w.z = cvt_pk_bf16(bflo(av.z) + bflo(gv.z) * v1[0], bfhi(av.z) + bfhi(gv.z) * v1[1]);
                    w.w = cvt_pk_bf16(bflo(av.w) + bflo(gv.w) * v1[2], bfhi(av.w) + bfhi(gv.w) * v1[3]);
                    *(u32x4*)(out + ro + bj * HALF) = w; } }
    }
};
struct EpiResid {
    static constexpr bool PERM = true, AFTER_DRAIN = false;
    const float* base; float* out;
    __device__ __forceinline__ void operator()(const f32x4 (&acc)[2][2][4][2], const Unit& u, int wr, int wc, int fr, int fq) const {
        const int col0 = u.pn * BM + wc * 32 + 8 * fq, row0 = u.pm * BM + wr * 64 + fr;
#pragma unroll
        for (int ai = 0; ai < 2; ++ai)
#pragma unroll
            for (int m = 0; m < 4; ++m) { asm volatile("" ::: "memory"); __builtin_amdgcn_sched_barrier(0); const size_t ro = (size_t)(row0 + ai * HALF + m * 16) * 1024 + col0;
#pragma unroll
                for (int bj = 0; bj < 2; ++bj)
#pragma unroll
                    for (int n = 0; n < 2; ++n) { const f32x4 b = *(const f32x4*)(base + ro + bj * HALF + 4 * n); *(f32x4*)(out + ro + bj * HALF + 4 * n) = b + acc[ai][bj][m][n]; } }
    }
};
struct EpiRelu2 {
    static constexpr bool PERM = true, AFTER_DRAIN = false;
    bf16_t* out; int ldc;
    __device__ __forceinline__ void operator()(const f32x4 (&acc)[2][2][4][2], const Unit& u, int wr, int wc, int fr, int fq) const {
        const int col0 = u.pn * BM + wc * 32 + 8 * fq, row0 = u.pm * BM + wr * 64 + fr;
#pragma unroll
        for (int ai = 0; ai < 2; ++ai)
#pragma unroll
            for (int m = 0; m < 4; ++m) { asm volatile("" ::: "memory"); __builtin_amdgcn_sched_barrier(0); bf16_t* rowp = out + (size_t)(row0 + ai * HALF + m * 16) * ldc + col0;
#pragma unroll
                for (int bj = 0; bj < 2; ++bj) { f32x4 v0 = acc[ai][bj][m][0], v1 = acc[ai][bj][m][1];
#pragma unroll
                    for (int e = 0; e < 4; ++e) { const float a = fmaxf(v0[e], 0.f), b = fmaxf(v1[e], 0.f); v0[e] = a * a; v1[e] = b * b; }
                    u32x4 w; w.x = cvt_pk_bf16(v0[0], v0[1]); w.y = cvt_pk_bf16(v0[2], v0[3]); w.z = cvt_pk_bf16(v1[0], v1[1]); w.w = cvt_pk_bf16(v1[2], v1[3]);
                    *(u32x4*)(rowp + bj * HALF) = w; } }
    }
};
template <class Epi, class Sched, bool ALIGN_EPI = false, bool SP2 = false>
__device__ __forceinline__ void gemm_phase(PG8_LAS unsigned char* lds, const Gemm g, const Sched& S, const Epi& E) {
    int tid_l = threadIdx.x; asm volatile("" : "+v"(tid_l));
    const int tid = tid_l, wid = __builtin_amdgcn_readfirstlane(tid >> 6), lane = tid & 63, wr = wid >> 2, wc = wid & 3, fr = lane & 15, fq = lane >> 4;
    const int K = g.K, nt = K / BK;
    unsigned voffA[2], voffB[2];
#pragma unroll
    for (int i = 0; i < 2; ++i) { int R, C; stage_rc(tid * 16 + i * 8192, R, C); const int Rb = Epi::PERM ? ((R & ~31) + perm32(R & 31)) : R;
        voffA[i] = (unsigned)(R * K + C) * 2u; voffB[i] = (unsigned)(Rb * K + C) * 2u; }
    const size_t kstep = (size_t)(BK * 2);
    const size_t hstep = (size_t)HALF * K * 2;
    const size_t tstep = 2 * hstep;
    const unsigned ldsw = (unsigned)wid * 1024u;
    const int aoff = lds_byte(wr * 64 + fr, fq * 8), boff = lds_byte(wc * 32 + fr, fq * 8);
#define PG8_SA(b, h) (((b) * 2 + (h)) * HTB)
#define PG8_SB(b, h) ((4 + (b) * 2 + (h)) * HTB)
#define PG8_STAGE(bufoff, gbase, voff) do { _Pragma("unroll") for (int _i = 0; _i < 2; ++_i) \
        __builtin_amdgcn_global_load_lds((const unsigned*)((const char*)(gbase) + (voff)[_i]), (PG8_LAS unsigned*)(lds + (bufoff) + ldsw + _i * 8192), 16, 0, 0); } while (0)
#define PG8_LDA(dst, b, h) do { _Pragma("unroll") for (int m = 0; m < 4; ++m) _Pragma("unroll") for (int k = 0; k < 2; ++k) dst[m][k] = *(const PG8_LAS bf16x8*)(lds + PG8_SA(b, h) + aoff + m * 2048 + k * 1024); } while (0)
#define PG8_LDB(dst, b, h) do { _Pragma("unroll") for (int n = 0; n < 2; ++n) _Pragma("unroll") for (int k = 0; k < 2; ++k) dst[n][k] = *(const PG8_LAS bf16x8*)(lds + PG8_SB(b, h) + boff + n * 2048 + k * 1024); } while (0)
#define PG8_MMA(ai, bj, At, Bt) do { __builtin_amdgcn_s_setprio(1); _Pragma("unroll") for (int m = 0; m < 4; ++m) _Pragma("unroll") for (int n = 0; n < 2; ++n) _Pragma("unroll") for (int k = 0; k < 2; ++k) \
        acc[ai][bj][m][n] = __builtin_amdgcn_mfma_f32_16x16x32_bf16(Bt[n][k], At[m][k], acc[ai][bj][m][n], 0, 0, 0); __builtin_amdgcn_s_setprio(0); } while (0)
#define PG8_WAIT_V(n) asm volatile("s_waitcnt vmcnt(" #n ")" ::: "memory")
#define PG8_WAIT_L(n) asm volatile("s_waitcnt lgkmcnt(" #n ")" ::: "memory")
#define PG8_BAR __builtin_amdgcn_s_barrier()
#define PG8_SCHED __builtin_amdgcn_sched_barrier(0)
    Unit cur, nxt; int ui = 0;
    if (!S.next(0, cur)) return;
    f32x4 acc[2][2][4][2];
#pragma unroll
    for (int a = 0; a < 2; ++a)
#pragma unroll
        for (int b = 0; b < 2; ++b)
#pragma unroll
            for (int m = 0; m < 4; ++m)
#pragma unroll
                for (int n = 0; n < 2; ++n) acc[a][b][m][n] = (f32x4){0.f, 0.f, 0.f, 0.f};
    bf16x8 At[4][2], B0[2][2], B1[2][2];
    const char* cA = (const char*)g.A + (size_t)cur.pm * tstep; const char* cB = (const char*)g.Bt + (size_t)cur.pn * tstep;
    S.a_ready(cur);
    if constexpr (SP2) {
        PG8_STAGE(PG8_SB(0, 0), cB, voffB); PG8_STAGE(PG8_SB(0, 1), cB + hstep, voffB); PG8_STAGE(PG8_SA(0, 0), cA, voffA); PG8_STAGE(PG8_SA(0, 1), cA + hstep, voffA);
        if (wr == 1) PG8_BAR;
        PG8_WAIT_V(2); PG8_BAR;
        PG8_STAGE(PG8_SB(1, 0), cB + kstep, voffB); PG8_STAGE(PG8_SA(1, 0), cA + kstep, voffA); PG8_STAGE(PG8_SB(1, 1), cB + hstep + kstep, voffB);
        PG8_WAIT_V(6); PG8_BAR;
    } else {
        PG8_STAGE(PG8_SB(0, 0), cB, voffB); PG8_STAGE(PG8_SA(0, 0), cA, voffA); PG8_STAGE(PG8_SB(0, 1), cB + hstep, voffB); PG8_STAGE(PG8_SA(0, 1), cA + hstep, voffA);
        if (wr == 1) PG8_BAR;
        PG8_WAIT_V(4); PG8_BAR;
        PG8_STAGE(PG8_SB(1, 0), cB + kstep, voffB); PG8_STAGE(PG8_SA(1, 0), cA + kstep, voffA); PG8_STAGE(PG8_SB(1, 1), cB + hstep + kstep, voffB);
        PG8_WAIT_V(6); PG8_BAR;
    }
    for (;;) {
        const bool has_next = S.next(ui + 1, nxt);
        const char* nA = has_next ? (const char*)g.A + (size_t)nxt.pm * tstep : cA; const char* nB = has_next ? (const char*)g.Bt + (size_t)nxt.pn * tstep : cB;
        for (int t = 0; t < nt; t += 2) {
            const bool last = (t == nt - 2);
            const char* a1 = cA + (size_t)(t + 1) * kstep;
            const char* a2 = last ? nA : cA + (size_t)(t + 2) * kstep; const char* b2 = last ? nB : cB + (size_t)(t + 2) * kstep;
            const char* a3 = a2 + kstep; const char* b3 = b2 + kstep;
            if (last && has_next) S.a_ready(nxt);
            if constexpr (SP2) {
            PG8_LDB(B0, 0, 0); PG8_LDB(B1, 0, 1); PG8_SCHED; PG8_LDA(At, 0, 0); PG8_STAGE(PG8_SA(1, 1), a1 + hstep, voffA);
            PG8_WAIT_V(8); PG8_WAIT_L(0); PG8_BAR; PG8_MMA(0, 0, At, B0); PG8_MMA(0, 1, At, B1); PG8_BAR; PG8_SCHED;
            PG8_LDA(At, 0, 1); PG8_STAGE(PG8_SB(0, 0), b2, voffB); PG8_STAGE(PG8_SB(0, 1), b2 + hstep, voffB); PG8_STAGE(PG8_SA(0, 0), a2, voffA);
            PG8_WAIT_V(8); PG8_WAIT_L(0); PG8_BAR; PG8_MMA(1, 0, At, B0); PG8_MMA(1, 1, At, B1); PG8_BAR; PG8_SCHED;
            PG8_LDB(B0, 1, 0); PG8_LDB(B1, 1, 1); PG8_SCHED; PG8_LDA(At, 1, 0); PG8_STAGE(PG8_SA(0, 1), a2 + hstep, voffA);
            PG8_WAIT_V(8); PG8_WAIT_L(0); PG8_BAR; PG8_MMA(0, 0, At, B0); PG8_MMA(0, 1, At, B1); PG8_BAR; PG8_SCHED;
            PG8_LDA(At, 1, 1); PG8_STAGE(PG8_SB(1, 0), b3, voffB); PG8_STAGE(PG8_SB(1, 1), b3 + hstep, voffB); PG8_STAGE(PG8_SA(1, 0), a3, voffA);
            PG8_WAIT_V(8); PG8_WAIT_L(0); PG8_BAR; PG8_MMA(1, 0, At, B0); PG8_MMA(1, 1, At, B1); PG8_BAR; PG8_SCHED;
            } else {
            PG8_LDB(B0, 0, 0); PG8_SCHED; PG8_LDA(At, 0, 0); PG8_STAGE(PG8_SA(1, 1), a1 + hstep, voffA);
            PG8_WAIT_L(8); PG8_BAR; PG8_WAIT_L(0); PG8_MMA(0, 0, At, B0); PG8_BAR; PG8_SCHED;
            PG8_LDB(B1, 0, 1); PG8_STAGE(PG8_SB(0, 0), b2, voffB);
            PG8_BAR; PG8_WAIT_L(0); PG8_MMA(0, 1, At, B1); PG8_BAR;
            PG8_LDA(At, 0, 1); PG8_STAGE(PG8_SA(0, 0), a2, voffA);
            PG8_BAR; PG8_WAIT_L(0); PG8_MMA(1, 0, At, B0); PG8_BAR; PG8_SCHED;
            PG8_STAGE(PG8_SB(0, 1), b2 + hstep, voffB);
            PG8_WAIT_V(6); PG8_BAR; PG8_MMA(1, 1, At, B1); PG8_BAR;
            PG8_LDB(B0, 1, 0); PG8_SCHED; PG8_LDA(At, 1, 0); PG8_STAGE(PG8_SA(0, 1), a2 + hstep, voffA);
            PG8_WAIT_L(8); PG8_BAR; PG8_WAIT_L(0); PG8_MMA(0, 0, At, B0); PG8_BAR; PG8_SCHED;
            PG8_LDB(B1, 1, 1); PG8_STAGE(PG8_SB(1, 0), b3, voffB);
            PG8_BAR; PG8_WAIT_L(0); PG8_MMA(0, 1, At, B1); PG8_BAR;
            PG8_LDA(At, 1, 1); PG8_STAGE(PG8_SA(1, 0), a3, voffA);
            PG8_BAR; PG8_WAIT_L(0); PG8_MMA(1, 0, At, B0); PG8_BAR; PG8_SCHED;
            PG8_STAGE(PG8_SB(1, 1), b3 + hstep, voffB);
            PG8_WAIT_V(6); PG8_BAR; PG8_MMA(1, 1, At, B1); PG8_BAR;
            }
        }
        if constexpr (ALIGN_EPI) { if (wr == 0) PG8_BAR; }
        if constexpr (!Epi::AFTER_DRAIN) { E(acc, cur, wr, wc, fr, fq); S.done(cur); }
        if (!has_next) break;
#pragma unroll
        for (int a = 0; a < 2; ++a)
#pragma unroll
            for (int b = 0; b < 2; ++b)
#pragma unroll
                for (int m = 0; m < 4; ++m)
#pragma unroll
                    for (int n = 0; n < 2; ++n) acc[a][b][m][n] = (f32x4){0.f, 0.f, 0.f, 0.f};
        cur = nxt; cA = nA; cB = nB; ++ui;
        if constexpr (ALIGN_EPI) { if (wr == 1) PG8_BAR; }
    }
    PG8_WAIT_V(0);
    if constexpr (!ALIGN_EPI) { if (wr == 0) PG8_BAR; }
    PG8_BAR;
    if constexpr (Epi::AFTER_DRAIN) { E.fused(acc, cur, wr, wc, fr, fq, lds, wid, lane); S.done(cur); }
#undef PG8_SA
#undef PG8_SB
#undef PG8_STAGE
#undef PG8_LDA
#undef PG8_LDB
#undef PG8_MMA
#undef PG8_WAIT_V
#undef PG8_WAIT_L
#undef PG8_BAR
#undef PG8_SCHED
}
}

#define LAS __attribute__((address_space(3)))
typedef unsigned short bf16;
typedef unsigned v4u __attribute__((ext_vector_type(4)));
typedef unsigned v2u __attribute__((ext_vector_type(2)));
typedef float f32x4 __attribute__((ext_vector_type(4)));
typedef float f32x2 __attribute__((ext_vector_type(2)));
typedef short bf16x8 __attribute__((ext_vector_type(8)));
typedef short s16x4 __attribute__((ext_vector_type(4)));
using pg8::bflo; using pg8::bfhi; using pg8::cvt_pk_bf16;

#ifndef PROJ_ALIGN
#define PROJ_ALIGN false
#endif
#ifndef ONE_LAUNCH
#define ONE_LAUNCH 1
#endif
constexpr int DM = 1024, BATCH = 8, SEQ = 2048, M = BATCH * SEQ, NIN = 9216, DFF = 4096, DEPTH = 2;
constexpr float EPS = 1e-6f;
constexpr int NTHR = 512, NWAVES = 8;
constexpr int LDS_BYTES = 131072;
constexpr size_t MiB = 1u << 20;
constexpr size_t WS_LB = 64 * 1024;
constexpr size_t WS_WIN = 1 * MiB, WS_WPA = 19 * MiB, WS_WPB = 21 * MiB, WS_WOUT = 23 * MiB;
constexpr size_t WS_B0 = 25 * MiB, BUFB = 32 * MiB;
constexpr size_t WS_END = WS_B0 + 8 * BUFB;
#define WS_BUF(i) (WS_B0 + (size_t)(i) * BUFB)
constexpr size_t WS_WUP = WS_BUF(6), WS_WDN = WS_BUF(6) + 8 * MiB;
constexpr int PH_PER_LAYER = 11, NPH = DEPTH * PH_PER_LAYER + 1;

__device__ __forceinline__ float wave_sum(float v) {
#pragma unroll
    for (int o = 1; o < 64; o <<= 1) v += __shfl_xor(v, o);
    return v;
}
__device__ __forceinline__ void transpose_item(const float* W, int K, int N, bf16* WT, LAS float* scr, int item, int lane) {
    const int nblk = N / 32, kb = item / nblk, nb = item % nblk, k0 = 64 * kb, n0 = 32 * nb;
#pragma unroll 8
    for (int i = 0; i < 32; ++i) { const int kk = 2 * i + (lane >> 5); scr[kk * 33 + (lane & 31)] = W[(size_t)(k0 + kk) * N + n0 + (lane & 31)]; }
    asm volatile("s_waitcnt lgkmcnt(0)" ::: "memory");
    const int c = lane & 7;
#pragma unroll
    for (int j = 0; j < 4; ++j) { const int n = (lane >> 3) + 8 * j; const LAS float* s = scr + (8 * c) * 33 + n;
        v4u o; o.x = cvt_pk_bf16(s[0 * 33], s[1 * 33]); o.y = cvt_pk_bf16(s[2 * 33], s[3 * 33]); o.z = cvt_pk_bf16(s[4 * 33], s[5 * 33]); o.w = cvt_pk_bf16(s[6 * 33], s[7 * 33]);
        *(v4u*)(WT + (size_t)(n0 + n) * K + k0 + 8 * c) = o; }
    asm volatile("s_waitcnt lgkmcnt(0)" ::: "memory");
}
__device__ __forceinline__ void convert_weight(const float* W, int K, int N, bf16* WT, LAS unsigned char* lds, int gw, int NGW, int wave, int lane) {
    LAS float* scr = (LAS float*)(lds + wave * 16384);
    const int nitems = (K / 64) * (N / 32);
    for (int it = gw; it < nitems; it += NGW) transpose_item(W, K, N, WT, scr, it, lane);
}
__device__ __forceinline__ void rms_row_bf16(const float* xrow, const float* gain, bf16* orow, int lane) {
    const f32x4* xr = (const f32x4*)xrow + lane; const f32x4* gr = (const f32x4*)gain + lane;
    f32x4 v[4]; float s = 0.f;
#pragma unroll
    for (int j = 0; j < 4; ++j) { v[j] = xr[64 * j]; s += (v[j].x * v[j].x + v[j].y * v[j].y) + (v[j].z * v[j].z + v[j].w * v[j].w); }
    const float rstd = rsqrtf(wave_sum(s) * (1.f / DM) + EPS);
    v2u* o8 = (v2u*)orow + lane;
#pragma unroll
    for (int j = 0; j < 4; ++j) { const f32x4 gg = gr[64 * j]; v2u o; o.x = cvt_pk_bf16(v[j].x * rstd * gg.x, v[j].y * rstd * gg.y); o.y = cvt_pk_bf16(v[j].z * rstd * gg.z, v[j].w * rstd * gg.w); o8[64 * j] = o; }
}
__device__ __forceinline__ void rms_row_f32(const float* xrow, const float* gain, float* orow, int lane) {
    const f32x4* xr = (const f32x4*)xrow + lane; const f32x4* gr = (const f32x4*)gain + lane;
    f32x4 v[4]; float s = 0.f;
#pragma unroll
    for (int j = 0; j < 4; ++j) { v[j] = xr[64 * j]; s += (v[j].x * v[j].x + v[j].y * v[j].y) + (v[j].z * v[j].z + v[j].w * v[j].w); }
    const float rstd = rsqrtf(wave_sum(s) * (1.f / DM) + EPS);
    f32x4* o = (f32x4*)orow + lane;
#pragma unroll
    for (int j = 0; j < 4; ++j) { const f32x4 gg = gr[64 * j]; o[64 * j] = v[j] * rstd * gg; }
}

__device__ __forceinline__ void sg_phase(LAS unsigned char* lds, bf16* ZU, const bf16* ZV, const float* ws_l, const float* bs_l, const float* sgn_l, int bid, int G) {
    int tid_l = threadIdx.x; asm volatile("" : "+v"(tid_l));
    const int tid = tid_l, lane = tid & 63, w = __builtin_amdgcn_readfirstlane(tid >> 6), g = lane >> 4, r16 = lane & 15;
    LAS unsigned char* VGT = lds; LAS unsigned char* WSL = lds + 34816;
    for (int item = bid; item < 1024; item += G) {
        const int gq = item & 7, bc = item >> 3, row0 = bc * 128, col0 = gq * 128;
        {
            const int s = tid >> 2, dq = tid & 3;
            v4u z[4]; float ss = 0.f;
#pragma unroll
            for (int e = 0; e < 4; ++e) { z[e] = *(const v4u*)(ZV + (size_t)(row0 + s) * 1024 + col0 + dq * 32 + 8 * e);
#pragma unroll
                for (int q = 0; q < 4; ++q) { const float a = bflo(z[e][q]), b = bfhi(z[e][q]); ss += a * a + b * b; } }
            ss += __shfl_xor(ss, 1); ss += __shfl_xor(ss, 2);
            const float rstd = rsqrtf(ss * (1.f / 128.f) + EPS);
#pragma unroll
            for (int e = 0; e < 4; ++e)
#pragma unroll
                for (int q = 0; q < 4; ++q) { const int d = dq * 32 + 8 * e + 2 * q;
                    const float a = bflo(z[e][q]) * rstd * sgn_l[col0 + d], b = bfhi(z[e][q]) * rstd * sgn_l[col0 + d + 1];
                    const unsigned pk = cvt_pk_bf16(a, b);
                    *(LAS unsigned short*)(VGT + d * 272 + s * 2) = (unsigned short)(pk & 0xffffu);
                    *(LAS unsigned short*)(VGT + (d + 1) * 272 + s * 2) = (unsigned short)(pk >> 16); }
            const int t = tid >> 2, sq = tid & 3; const float* wrow = ws_l + (size_t)gq * 16384 + t * 128 + sq * 32;
#pragma unroll
            for (int e = 0; e < 4; ++e) { const f32x4 a = *(const f32x4*)(wrow + 8 * e), b = *(const f32x4*)(wrow + 8 * e + 4);
                v4u o; o.x = cvt_pk_bf16(a.x, a.y); o.y = cvt_pk_bf16(a.z, a.w); o.z = cvt_pk_bf16(b.x, b.y); o.w = cvt_pk_bf16(b.z, b.w);
                *(LAS v4u*)(WSL + t * 272 + (sq * 32 + 8 * e) * 2) = o; }
        }
        __syncthreads();
        {
            bf16x8 bw[4];
#pragma unroll
            for (int ks = 0; ks < 4; ++ks) bw[ks] = *(const LAS bf16x8*)(WSL + (16 * w + r16) * 272 + (32 * ks + 8 * g) * 2);
            const int row = row0 + 16 * w + r16; const float bias = bs_l[gq * 128 + 16 * w + r16];
#pragma unroll
            for (int dt = 0; dt < 8; ++dt) { f32x4 acc = (f32x4){0.f, 0.f, 0.f, 0.f};
#pragma unroll
                for (int ks = 0; ks < 4; ++ks) { const bf16x8 a = *(const LAS bf16x8*)(VGT + (16 * dt + r16) * 272 + (32 * ks + 8 * g) * 2); acc = __builtin_amdgcn_mfma_f32_16x16x32_bf16(a, bw[ks], acc, 0, 0, 0); }
                v2u* p = (v2u*)(ZU + (size_t)row * 1024 + col0 + 16 * dt + 4 * g); const v2u zu = *p; v2u o;
                o.x = cvt_pk_bf16(bflo(zu.x) * (acc[0] + bias), bfhi(zu.x) * (acc[1] + bias)); o.y = cvt_pk_bf16(bflo(zu.y) * (acc[2] + bias), bfhi(zu.y) * (acc[3] + bias)); *p = o; }
        }
        __syncthreads();
    }
}

constexpr int HG_QH = 0, HG_KH = 17408, HG_KT = 34816, HG_VT = 53248, HG_PP = 62464, HG_TOT = 71680, HG_EBM = 75776, HG_EBL = 76288;
__device__ __forceinline__ void hg_phase(LAS unsigned char* lds, const bf16* Qb, const bf16* LFfw, const bf16* LFbw, const bf16* IVb, bf16* Ofw, bf16* Obw, int bid, int G) {
    int tid_l = threadIdx.x; asm volatile("" : "+v"(tid_l));
    const int tid = tid_l, lane = tid & 63, w = __builtin_amdgcn_readfirstlane(tid >> 6), g = lane >> 4, r16 = lane & 15;
    LAS unsigned char* QH = lds + HG_QH; LAS unsigned char* KH = lds + HG_KH; LAS unsigned char* KT = lds + HG_KT; LAS unsigned char* VT = lds + HG_VT;
    LAS unsigned char* PP = lds + HG_PP; LAS float* TOT = (LAS float*)(lds + HG_TOT); LAS float* EBM = (LAS float*)(lds + HG_EBM); LAS float* EBL = (LAS float*)(lds + HG_EBL);
    const int vs = tid >> 3, vc = tid & 7;
    for (int item = bid; item < 256; item += G) {
        const int vh = (item >> 3) & 1, chain = (item & 7) | ((item >> 4) << 3), dir = chain & 1, h = (chain >> 1) & 7, b = chain >> 4;
        const bf16* LF = dir ? LFbw : LFfw; bf16* O = dir ? Obw : Ofw;
        const size_t colq = (size_t)h * 128 + 2 * lane, colv = (size_t)h * 128 + vh * 64;
#define HG_ROW(c, tau) ((size_t)(b * SEQ + (dir ? (SEQ - 1 - (64 * (c) + (tau))) : (64 * (c) + (tau)))))
        f32x4 S[8];
#pragma unroll
        for (int kt = 0; kt < 8; ++kt) S[kt] = (f32x4){0.f, 0.f, 0.f, 0.f};
        unsigned lfr[8], qr[8]; v4u vr;
#pragma unroll
        for (int j = 0; j < 8; ++j) { const size_t ro = HG_ROW(0, 8 * w + j) * 1024 + colq; lfr[j] = *(const unsigned*)(LF + ro); qr[j] = *(const unsigned*)(Qb + ro); }
        vr = *(const v4u*)(IVb + HG_ROW(0, vs) * 1024 + colv + vc * 8);
        for (int c = 0; c < 32; ++c) {
            float c0[8], c1[8]; float a0 = 0.f, a1 = 0.f;
#pragma unroll
            for (int j = 0; j < 8; ++j) { a0 += bflo(lfr[j]); a1 += bfhi(lfr[j]); c0[j] = a0; c1[j] = a1; }
            *(LAS f32x2*)(TOT + w * 128 + 2 * lane) = (f32x2){a0, a1};
            __syncthreads();
            float off0 = 0.f, off1 = 0.f, bm0 = 0.f, bm1 = 0.f, bl0 = 0.f, bl1 = 0.f;
#pragma unroll
            for (int w2 = 0; w2 < 8; ++w2) { const f32x2 t = *(const LAS f32x2*)(TOT + w2 * 128 + 2 * lane);
                if (w2 < w) { off0 += t.x; off1 += t.y; } if (w2 < 4) { bm0 += t.x; bm1 += t.y; } bl0 += t.x; bl1 += t.y; }
            unsigned kt0[4], kt1[4];
#pragma unroll
            for (int j = 0; j < 8; ++j) {
                const float l0 = bflo(lfr[j]), l1 = bfhi(lfr[j]);
                const float d0 = off0 + c0[j] - bm0, d1 = off1 + c1[j] - bm1;
                const float eq0 = __expf(fminf(d0, 80.f)), eq1 = __expf(fminf(d1, 80.f));
                const float ek0 = __expf(fminf(-d0, 80.f)), ek1 = __expf(fminf(-d1, 80.f));
                const float kk0 = 1.f - __expf(l0), kk1 = 1.f - __expf(l1);
                const int tau = 8 * w + j;
                *(LAS unsigned*)(QH + tau * 272 + 4 * lane) = cvt_pk_bf16(bflo(qr[j]) * eq0, bfhi(qr[j]) * eq1);
                const unsigned kp = cvt_pk_bf16(kk0 * ek0, kk1 * ek1);
                *(LAS unsigned*)(KH + tau * 272 + 4 * lane) = kp;
                if ((j & 1) == 0) { kt0[j >> 1] = kp & 0xffffu; kt1[j >> 1] = kp >> 16; }
                else { kt0[j >> 1] |= kp << 16; kt1[j >> 1] |= kp & 0xffff0000u; }
            }
            *(LAS v4u*)(KT + (2 * lane) * 144 + 16 * w) = (v4u){kt0[0], kt0[1], kt0[2], kt0[3]};
            *(LAS v4u*)(KT + (2 * lane + 1) * 144 + 16 * w) = (v4u){kt1[0], kt1[1], kt1[2], kt1[3]};
            if (w == 0) { *(LAS f32x2*)(EBM + 2 * lane) = (f32x2){__expf(bm0), __expf(bm1)}; *(LAS f32x2*)(EBL + 2 * lane) = (f32x2){__expf(bl0 - bm0), __expf(bl1 - bm1)}; }
#pragma unroll
            for (int e = 0; e < 4; ++e) { const unsigned u = vr[e];
                *(LAS unsigned short*)(VT + (vc * 8 + 2 * e) * 144 + vs * 2) = (unsigned short)(u & 0xffffu);
                *(LAS unsigned short*)(VT + (vc * 8 + 2 * e + 1) * 144 + vs * 2) = (unsigned short)(u >> 16); }
            if (c + 1 < 32) {
#pragma unroll
                for (int j = 0; j < 8; ++j) { const size_t ro = HG_ROW(c + 1, 8 * w + j) * 1024 + colq; lfr[j] = *(const unsigned*)(LF + ro); qr[j] = *(const unsigned*)(Qb + ro); }
                vr = *(const v4u*)(IVb + HG_ROW(c + 1, vs) * 1024 + colv + vc * 8);
            }
            __syncthreads();
            {
                const int tt = w >> 1;
                bf16x8 bq[4];
#pragma unroll
                for (int ks = 0; ks < 4; ++ks) bq[ks] = *(const LAS bf16x8*)(QH + (16 * tt + r16) * 272 + (32 * ks + 8 * g) * 2);
#pragma unroll
                for (int si = 0; si < 2; ++si) { const int st = 2 * (w & 1) + si;
                    if (st <= tt) { f32x4 p = (f32x4){0.f, 0.f, 0.f, 0.f};
#pragma unroll
                        for (int ks = 0; ks < 4; ++ks) { const bf16x8 a = *(const LAS bf16x8*)(KH + (16 * st + r16) * 272 + (32 * ks + 8 * g) * 2); p = __builtin_amdgcn_mfma_f32_16x16x32_bf16(a, bq[ks], p, 0, 0, 0); }
                        if (st == tt) {
#pragma unroll
                            for (int i = 0; i < 4; ++i) if (4 * g + i > r16) p[i] = 0.f; }
                        *(LAS v2u*)(PP + (16 * tt + r16) * 144 + (16 * st + 4 * g) * 2) = (v2u){cvt_pk_bf16(p[0], p[1]), cvt_pk_bf16(p[2], p[3])};
                    } else if (st == tt + 1 && (tt & 1) == 0) *(LAS v2u*)(PP + (16 * tt + r16) * 144 + (16 * st + 4 * g) * 2) = (v2u){0u, 0u};
                }
            }
            __syncthreads();
            {
                const int vt = w & 3, th = w >> 2;
                bf16x8 As[4];
#pragma unroll
                for (int kt = 0; kt < 8; ++kt) S[kt] = S[kt] * *(const LAS f32x4*)(EBM + 16 * kt + 4 * g);
#pragma unroll
                for (int ks = 0; ks < 4; ++ks) { const unsigned x0 = cvt_pk_bf16(S[2 * ks][0], S[2 * ks][1]), x1 = cvt_pk_bf16(S[2 * ks][2], S[2 * ks][3]), x2 = cvt_pk_bf16(S[2 * ks + 1][0], S[2 * ks + 1][1]), x3 = cvt_pk_bf16(S[2 * ks + 1][2], S[2 * ks + 1][3]);
                    As[ks] = __builtin_bit_cast(bf16x8, (v4u){x0, x1, x2, x3}); }
                bf16x8 av[2];
#pragma unroll
                for (int ks = 0; ks < 2; ++ks) av[ks] = *(const LAS bf16x8*)(VT + (16 * vt + r16) * 144 + (32 * ks + 8 * g) * 2);
                f32x4 oacc[2];
#pragma unroll
                for (int ttl = 0; ttl < 2; ++ttl) { const int tt = 2 * th + ttl, trow = 16 * tt + r16; oacc[ttl] = (f32x4){0.f, 0.f, 0.f, 0.f};
#pragma unroll
                    for (int ks = 0; ks < 4; ++ks) { const v2u lo = *(const LAS v2u*)(QH + trow * 272 + (32 * ks + 4 * g) * 2), hi = *(const LAS v2u*)(QH + trow * 272 + (32 * ks + 16 + 4 * g) * 2);
                        oacc[ttl] = __builtin_amdgcn_mfma_f32_16x16x32_bf16(As[ks], __builtin_bit_cast(bf16x8, (v4u){lo.x, lo.y, hi.x, hi.y}), oacc[ttl], 0, 0, 0); }
#pragma unroll
                    for (int ks = 0; ks < 2; ++ks) if (ks <= (tt >> 1)) { const bf16x8 bp = *(const LAS bf16x8*)(PP + trow * 144 + (32 * ks + 8 * g) * 2); oacc[ttl] = __builtin_amdgcn_mfma_f32_16x16x32_bf16(av[ks], bp, oacc[ttl], 0, 0, 0); }
                }
#pragma unroll
                for (int kt = 0; kt < 8; ++kt) {
#pragma unroll
                    for (int ks = 0; ks < 2; ++ks) { const bf16x8 a = *(const LAS bf16x8*)(KT + (16 * kt + r16) * 144 + (32 * ks + 8 * g) * 2); S[kt] = __builtin_amdgcn_mfma_f32_16x16x32_bf16(a, av[ks], S[kt], 0, 0, 0); }
                    S[kt] = S[kt] * *(const LAS f32x4*)(EBL + 16 * kt + 4 * g); }
#pragma unroll
                for (int ttl = 0; ttl < 2; ++ttl) { const int tau = 16 * (2 * th + ttl) + r16;
                    *(v2u*)(O + HG_ROW(c, tau) * 1024 + colv + vt * 16 + 4 * g) = (v2u){cvt_pk_bf16(oacc[ttl][0], oacc[ttl][1]), cvt_pk_bf16(oacc[ttl][2], oacc[ttl][3])}; }
            }
        }
        __syncthreads();
#undef HG_ROW
    }
}

__device__ __forceinline__ void cb_row(bf16* Ofw, const bf16* Obw, const bf16* OG, const float* gain, size_t row, int lane) {
    const size_t o = row * 1024 + 16 * lane;
    v4u a[2], b[2], gq[2]; float s[16]; float ss = 0.f;
#pragma unroll
    for (int e = 0; e < 2; ++e) { a[e] = *(const v4u*)(Ofw + o + 8 * e); b[e] = *(const v4u*)(Obw + o + 8 * e); gq[e] = *(const v4u*)(OG + o + 8 * e); }
#pragma unroll
    for (int e = 0; e < 2; ++e)
#pragma unroll
        for (int q = 0; q < 4; ++q) { const float x = bflo(a[e][q]) + bflo(b[e][q]), y = bfhi(a[e][q]) + bfhi(b[e][q]); s[8 * e + 2 * q] = x; s[8 * e + 2 * q + 1] = y; ss += x * x + y * y; }
    ss += __shfl_xor(ss, 1); ss += __shfl_xor(ss, 2); ss += __shfl_xor(ss, 4);
    const float rstd = rsqrtf(ss * (1.f / 128.f) + EPS);
#pragma unroll
    for (int e = 0; e < 2; ++e) { v4u ov;
#pragma unroll
        for (int q = 0; q < 4; ++q) { const f32x2 gn = *(const f32x2*)(gain + 16 * lane + 8 * e + 2 * q);
            ov[q] = cvt_pk_bf16(s[8 * e + 2 * q] * rstd * gn.x * bflo(gq[e][q]), s[8 * e + 2 * q + 1] * rstd * gn.y * bfhi(gq[e][q])); }
        *(v4u*)(Ofw + o + 8 * e) = ov; }
}

struct Args { const float* in[15]; float* out; unsigned char* ws; int ph_lo, ph_hi; };

__global__ void __launch_bounds__(NTHR, 2) fwd(Args a) {
    extern __shared__ __attribute__((aligned(16))) unsigned char lds_raw[];
    LAS unsigned char* lds = (LAS unsigned char*)lds_raw;
    const int G = gridDim.x, bid = blockIdx.x, NGW = G * NWAVES;
    const float* x = a.in[0]; const float* w_in = a.in[1]; const float* ln_mix = a.in[2]; const float* ln_mlp = a.in[3]; const float* sg_norm = a.in[4];
    const float* w_s = a.in[5]; const float* b_s = a.in[6]; const float* lb_logits = a.in[7]; const float* rec_norm = a.in[8];
    const float* w_pa = a.in[9]; const float* w_pb = a.in[10]; const float* w_out = a.in[11]; const float* w_up = a.in[12]; const float* w_down = a.in[13]; const float* ln_final = a.in[14];
#define BUF(i) ((bf16*)(ws + WS_BUF(i)))
    for (int p = a.ph_lo; p < a.ph_hi; ++p) {
        if (p > a.ph_lo) { asm volatile("s_waitcnt vmcnt(0)" ::: "memory");
            cg::this_grid().sync(); }
        int tid = threadIdx.x; asm volatile("" : "+v"(tid));
        const int lane = tid & 63, wave = __builtin_amdgcn_readfirstlane(tid >> 6), gw = bid * NWAVES + wave;
        unsigned char* ws = a.ws; asm volatile("" : "+s"(ws));
        float* out = a.out; asm volatile("" : "+s"(out));
        float* LB = (float*)(ws + WS_LB);
        bf16* WIN = (bf16*)(ws + WS_WIN); bf16* WPA = (bf16*)(ws + WS_WPA); bf16* WPB = (bf16*)(ws + WS_WPB); bf16* WOUT = (bf16*)(ws + WS_WOUT);
        bf16* WUP = (bf16*)(ws + WS_WUP); bf16* WDN = (bf16*)(ws + WS_WDN);
#ifdef DBG_NRUN
        if (p == DBG_NRUN) {
            for (size_t i = (size_t)bid * NTHR + tid; i < (size_t)M * DM; i += (size_t)G * NTHR) { float s = (DBG_NRUN >= 8) ? out[i] : 0.f;
                for (int k = 0; k < 8; ++k) s += bflo((unsigned)((const bf16*)(ws + WS_BUF(k)))[i]); out[i] = s; }
            continue;
        }
        if (p > DBG_NRUN) continue;
#endif
        if (p == NPH - 1) {
            for (int m = gw; m < M; m += NGW) rms_row_f32(out + (size_t)m * DM, ln_final, out + (size_t)m * DM, lane);
            continue;
        }
        const int l = p / PH_PER_LAYER, j = p % PH_PER_LAYER;
        const float* hin = (l == 0) ? x : out;
#ifndef PHASE_MASK
#define PHASE_MASK 0x7ff
#endif
        if (!((PHASE_MASK >> j) & 1)) continue;
        switch (j) {
        case 0: {
#ifdef DBG_FILL
            if (l == 0) { v4u* fp = (v4u*)(ws + WS_BUF(1)); const size_t n16 = (size_t)7 * BUFB / 16; for (size_t i = (size_t)bid * NTHR + tid; i < n16; i += (size_t)G * NTHR) fp[i] = (v4u){DBG_FILL, DBG_FILL, DBG_FILL, DBG_FILL}; }
#endif
            convert_weight(w_in + (size_t)l * DM * NIN, DM, NIN, WIN, lds, gw, NGW, wave, lane);
            convert_weight(w_pa + (size_t)l * DM * DM, DM, DM, WPA, lds, gw, NGW, wave, lane);
            convert_weight(w_pb + (size_t)l * DM * DM, DM, DM, WPB, lds, gw, NGW, wave, lane);
            convert_weight(w_out + (size_t)l * DM * DM, DM, DM, WOUT, lds, gw, NGW, wave, lane);
            for (int i = bid * NTHR + tid; i < 2 * DM; i += G * NTHR) { LB[i] = 0.f; LB[2 * DM + i] = 1.f / (1.f + __expf(lb_logits[i] - lb_logits[2 * DM + i])); }
            for (int m = gw; m < M; m += NGW) rms_row_bf16(hin + (size_t)m * DM, ln_mix + l * DM, BUF(0) + (size_t)m * DM, lane);
            __syncthreads();
        } break;
        case 1: {
#define PROJ(MODE, sec0, nsec, bufi, lbp) { pg8::Gemm g{BUF(0), WIN + (size_t)(sec0) * DM * DM, M, (nsec) * DM, DM}; pg8::StaticOrder S; S.init(M, (nsec) * DM, G, bid); \
            pg8::EpiProj<MODE> E{BUF(bufi), (size_t)M * DM, lbp}; pg8::gemm_phase<pg8::EpiProj<MODE>, pg8::StaticOrder, PROJ_ALIGN, true>(lds, g, S, E); }
            PROJ(0, 0, 2, 1, LB) PROJ(1, 2, 1, 3, LB) PROJ(2, 3, 2, 4, LB + (size_t)l * 2 * DM) PROJ(3, 5, 1, 6, LB)
        } break;
        case 2: sg_phase(lds, BUF(1), BUF(2), w_s + (size_t)l * 8 * 16384, b_s + (size_t)l * 1024, sg_norm + (size_t)l * DM, bid, G); break;
        case 3: hg_phase(lds, BUF(3), BUF(4), BUF(5), BUF(6), BUF(2), BUF(7), bid, G); break;
        case 4: {
            PROJ(3, 6, 1, 3, LB) PROJ(4, 7, 2, 4, LB)
        } break;
        case 5: {
            convert_weight(w_up + (size_t)l * DM * DFF, DM, DFF, WUP, lds, gw, NGW, wave, lane);
            convert_weight(w_down + (size_t)l * DFF * DM, DFF, DM, WDN, lds, gw, NGW, wave, lane);
            for (int m = gw; m < M; m += NGW) cb_row(BUF(2), BUF(7), BUF(3), rec_norm + (size_t)l * DM, (size_t)m, lane);
            __syncthreads();
        } break;
        case 6: {
            { pg8::Gemm g{BUF(1), WPA, M, DM, DM}; pg8::StaticOrder S; S.init(M, DM, G, bid); pg8::EpiGate E{BUF(4), nullptr, BUF(4)};
              pg8::gemm_phase<pg8::EpiGate, pg8::StaticOrder, false, true>(lds, g, S, E); }
            { pg8::Gemm g{BUF(2), WPB, M, DM, DM}; pg8::StaticOrder S; S.init(M, DM, G, bid); pg8::EpiGate E{BUF(5), BUF(4), BUF(4)};
              pg8::gemm_phase<pg8::EpiGate, pg8::StaticOrder, false, true>(lds, g, S, E); }
        } break;
        case 7: {
            pg8::Gemm g{BUF(4), WOUT, M, DM, DM}; pg8::StaticOrder S; S.init(M, DM, G, bid); pg8::EpiResid E{hin, out};
            pg8::gemm_phase<pg8::EpiResid, pg8::StaticOrder, false, true>(lds, g, S, E);
        } break;
        case 8: {
            for (int m = gw; m < M; m += NGW) rms_row_bf16(out + (size_t)m * DM, ln_mlp + l * DM, BUF(0) + (size_t)m * DM, lane);
        } break;
        case 9: {
            pg8::Gemm g{BUF(0), WUP, M, DFF, DM}; pg8::StaticOrder S; S.init(M, DFF, G, bid); pg8::EpiRelu2 E{BUF(1), DFF};
            pg8::gemm_phase<pg8::EpiRelu2, pg8::StaticOrder, false, true>(lds, g, S, E);
        } break;
        case 10: {
            pg8::Gemm g{BUF(1), WDN, M, DM, DFF}; pg8::StaticOrder S; S.init(M, DM, G, bid); pg8::EpiResid E{out, out};
            pg8::gemm_phase<pg8::EpiResid, pg8::StaticOrder, false, true>(lds, g, S, E);
        } break;
        }
    }
#undef BUF
}

extern "C" void kernel_launch(void* const* d_in, const int* in_sizes, int n_in, void* d_out, int out_size, void* d_ws, size_t ws_size, hipStream_t stream) {
    static int grid = 0;
    if (grid == 0) {
        if (n_in != 15 || out_size != M * DM || ws_size < WS_END) { fprintf(stderr, "kernel_launch: unexpected problem (n_in %d, out %d, ws %zu < %zu)\n", n_in, out_size, ws_size, (size_t)WS_END); grid = -1; return; }
        int dev = 0, cus = 0, per_cu = 0;
        hipGetDevice(&dev); hipDeviceGetAttribute(&cus, hipDeviceAttributeMultiprocessorCount, dev);
        if (hipFuncSetAttribute((const void*)fwd, hipFuncAttributeMaxDynamicSharedMemorySize, LDS_BYTES) != hipSuccess) { fprintf(stderr, "kernel_launch: hipFuncSetAttribute failed\n"); grid = -1; return; }
        if (hipOccupancyMaxActiveBlocksPerMultiprocessor(&per_cu, (const void*)fwd, NTHR, LDS_BYTES) != hipSuccess || per_cu < 1) { fprintf(stderr, "kernel_launch: occupancy query says %d\n", per_cu); per_cu = 1; }
        (void)hipGetLastError();
        grid = cus;
    }
    if (grid < 0) return;
    Args a{};
    for (int i = 0; i < 15; ++i) a.in[i] = (const float*)d_in[i];
    a.out = (float*)d_out; a.ws = (unsigned char*)d_ws;
#if ONE_LAUNCH
    a.ph_lo = 0; a.ph_hi = NPH;
    void* args[] = {&a};
    hipError_t e = hipLaunchCooperativeKernel((const void*)fwd, dim3(grid), dim3(NTHR), args, LDS_BYTES, stream);
    if (e != hipSuccess) fprintf(stderr, "cooperative launch failed: %s (grid %d)\n", hipGetErrorString(e), grid);
#else
    for (int p = 0; p < NPH; ++p) { a.ph_lo = p; a.ph_hi = p + 1; hipLaunchKernelGGL(fwd, dim3(grid), dim3(NTHR), LDS_BYTES, stream, a); }
#endif
}
```

```cpp
#define ONE_LAUNCH 1
#include <hip/hip_runtime.h>
#include <hip/hip_cooperative_groups.h>
#include <cstdio>
#include <cstdint>
namespace cg = cooperative_groups;
namespace pg8 {
#define PG8_LAS __attribute__((address_space(3)))
typedef unsigned short bf16_t;
typedef short bf16x8 __attribute__((ext_vector_type(8)));
typedef float f32x4 __attribute__((ext_vector_type(4)));
typedef unsigned u32x4 __attribute__((ext_vector_type(4)));
constexpr int BM = 256, BK = 64, HALF = 128, HTB = HALF * BK * 2  , STAGE_BYTES = 8 * HTB, NXCD = 8, WGM = 8;

__host__ __device__ __forceinline__ int lds_byte(int r, int c) { const int st = (r >> 4) * 2 + (c >> 5), rr = r & 15, cc = c & 31, ob = rr * 64 + cc * 2; return st * 1024 + (ob ^ (((ob >> 9) & 1) << 5)); }
__host__ __device__ __forceinline__ void stage_rc(int b, int& R, int& C) { const int st = b / 1024, sb = b % 1024, swz = sb ^ (((sb >> 9) & 1) << 5); R = (st >> 1) * 16 + swz / 64; C = (st & 1) * 32 + (swz % 64) / 2; }
__host__ __device__ __forceinline__ int perm32(int rho) { const int n = rho >> 4, i = rho & 15; return 8 * (i >> 2) + 4 * n + (i & 3); }

struct Unit { int pm, pn; };
struct Gemm { const bf16_t* A; const bf16_t* Bt; int M, N, K; };

struct StaticOrder {
    int nM, nN, nwg, G, c;
    __host__ __device__ void init(int M, int N, int G_, int c_) { nM = M / BM; nN = N / BM; nwg = nM * nN; G = G_; c = c_; }
    __host__ __device__ bool next(int i, Unit& u) const {
        const long L = (long)i * G + c; if (L >= nwg) return false;
        int wgid = (int)L; { const int q = nwg / NXCD, r = nwg % NXCD, xcd = wgid % NXCD, off = wgid / NXCD; wgid = (xcd < r ? xcd * (q + 1) : r * (q + 1) + (xcd - r) * q) + off; }
        const int nig = WGM * nN, gid = wgid / nig, fm = gid * WGM, gsz = (nM - fm) < WGM ? (nM - fm) : WGM;
        u.pm = fm + ((wgid % nig) % gsz); u.pn = (wgid % nig) / gsz; return true;
    }
    __device__ __forceinline__ void a_ready(const Unit&) const {}
    __device__ __forceinline__ void done(const Unit&) const {}
};

typedef float cvt_f32x2_t __attribute__((ext_vector_type(2)));
typedef __bf16 cvt_bf16x2_t __attribute__((ext_vector_type(2)));
__device__ __forceinline__ unsigned cvt_pk_bf16(float lo, float hi) { cvt_f32x2_t v = {lo, hi}; cvt_bf16x2_t b = __builtin_convertvector(v, cvt_bf16x2_t); return __builtin_bit_cast(unsigned, b); }
typedef float f32x2 __attribute__((ext_vector_type(2)));
__device__ __forceinline__ f32x2 gelu_pk(f32x2 v) {
    const f32x2 av = __builtin_elementwise_abs(v), d = av * 0.2316418882f + 1.0f;
    f32x2 t; t.x = __builtin_amdgcn_rcpf(d.x); t.y = __builtin_amdgcn_rcpf(d.y);
    f32x2 q = t * 0.5307027145f + (-0.7265760135f); q = q * t + 0.7107068705f; q = q * t + (-0.142248368f); q = q * t + 0.127414796f; q = q * t;
    const f32x2 s = (v * v) * (-0.72134752044f);
    f32x2 e; e.x = __builtin_amdgcn_exp2f(s.x); e.y = __builtin_amdgcn_exp2f(s.y);
    const f32x2 m = v * (q * e), r = v - m;
    f32x2 o; o.x = v.x < 0.f ? m.x : r.x; o.y = v.y < 0.f ? m.y : r.y; return o;
}
__device__ __forceinline__ float bflo(unsigned u) { return __builtin_bit_cast(float, u << 16); }
__device__ __forceinline__ float bfhi(unsigned u) { return __builtin_bit_cast(float, u & 0xffff0000u); }
__device__ __forceinline__ float sigm(float z) { return __builtin_amdgcn_rcpf(1.0f + __expf(-z)); }
template <int MA, int MB> struct EpiProj {
    static constexpr bool PERM = true, AFTER_DRAIN = false;
    bf16_t* out0; size_t sec_stride; const float* lb; const float* rowsq; int split;
    template <int MODE> __device__ __forceinline__ void run(const f32x4 (&acc)[2][2][4][2], bf16_t* base, const float* lbrow, int row0, int col0) const {
#pragma unroll
        for (int ai = 0; ai < 2; ++ai)
#pragma unroll
            for (int m = 0; m < 4; ++m) { bf16_t* rowp = base + (size_t)(row0 + ai * HALF + m * 16) * 1024 + col0;
                const float rs = rowsq ? rsqrtf(rowsq[row0 + ai * HALF + m * 16] * (1.0f / 1024.0f) + 1e-6f) : 1.0f;
#pragma unroll
                for (int bj = 0; bj < 2; ++bj) { f32x4 v[2] = {acc[ai][bj][m][0] * rs, acc[ai][bj][m][1] * rs};
#pragma unroll
                    for (int n = 0; n < 2; ++n) {
                        if (MODE == 0) { f32x2 a = gelu_pk((f32x2){v[n][0], v[n][1]}), b = gelu_pk((f32x2){v[n][2], v[n][3]}); v[n] = (f32x4){a.x, a.y, b.x, b.y}; }
                        else if (MODE == 2) { const f32x4 lbv = *(const f32x4*)(lbrow + bj * HALF + 4 * n);
#pragma unroll
                            for (int e = 0; e < 4; ++e) { const float l = lbv[e]; const float f = l + (1.0f - l) * sigm(v[n][e]); v[n][e] = __logf(f); }
                        } else if (MODE == 3) {
#pragma unroll
                            for (int e = 0; e < 4; ++e) v[n][e] = v[n][e] * sigm(v[n][e]);
                        } else if (MODE == 4) {
#pragma unroll
                            for (int e = 0; e < 4; ++e) v[n][e] = sigm(v[n][e]);
                        }
                    }
                    u32x4 w; w.x = cvt_pk_bf16(v[0][0], v[0][1]); w.y = cvt_pk_bf16(v[0][2], v[0][3]); w.z = cvt_pk_bf16(v[1][0], v[1][1]); w.w = cvt_pk_bf16(v[1][2], v[1][3]);
                    *(u32x4*)(rowp + bj * HALF) = w; } }
    }
    __device__ __forceinline__ void operator()(const f32x4 (&acc)[2][2][4][2], const Unit& u, int wr, int wc, int fr, int fq) const {
        const int colt = u.pn * BM, sec = colt >> 10;
        bf16_t* base = out0 + (size_t)sec * sec_stride;
        const int col0 = (colt & 1023) + wc * 32 + 8 * fq, row0 = u.pm * BM + wr * 64 + fr;
        const float* lbrow = lb + sec * 1024 + col0;
        if (sec < split) run<MA>(acc, base, lbrow, row0, col0); else run<MB>(acc, base, lbrow, row0, col0);
    }
};
struct EpiGate {
    static constexpr bool PERM = true, AFTER_DRAIN = false;
    bf16_t* T; const bf16_t* gate2;
    __device__ __forceinline__ void operator()(const f32x4 (&acc)[2][2][4][2], const Unit& u, int wr, int wc, int fr, int fq) const {
        const bool second = u.pm >= 64;
        const int col0 = (u.pn & 3) * BM + wc * 32 + 8 * fq, row0 = (u.pm & 63) * BM + wr * 64 + fr;
        const bf16_t* gate = second ? gate2 : T;
#pragma unroll
        for (int ai = 0; ai < 2; ++ai)
#pragma unroll
            for (int m = 0; m < 4; ++m) { asm volatile("" ::: "memory"); __builtin_amdgcn_sched_barrier(0); const size_t ro = (size_t)(row0 + ai * HALF + m * 16) * 1024 + col0;
#pragma unroll
                for (int bj = 0; bj < 2; ++bj) {
                    const u32x4 gv = *(const u32x4*)(gate + ro + bj * HALF);
                    u32x4 av = (u32x4){0u, 0u, 0u, 0u}; if (second) av = *(const u32x4*)(T + ro + bj * HALF);
                    const f32x4 v0 = acc[ai][bj][m][0], v1 = acc[ai][bj][m][1];
                    u32x4 w;
                    w.x = cvt_pk_bf16(bflo(av.x) + bflo(gv.x) * v0[0], bfhi(av.x) + bfhi(gv.x) * v0[1]);
                    w.y = cvt_pk_bf16(bflo(av.y) + bflo(gv.y) * v0[2], bfhi(av.y) + bfhi(gv.y) * v0[3]);
                    w.z = cvt_pk_bf16(bflo(av.z) + bflo(gv.z) * v1[0], bfhi(av.z) + bfhi(gv.z) * v1[1]);
                    w.w = cvt_pk_bf16(bflo(av.w) + bflo(gv.w) * v1[2], bfhi(av.w) + bfhi(gv.w) * v1[3]);
                    *(u32x4*)(T + ro + bj * HALF) = w; } }
    }
};
struct PairOrder {
    StaticOrder S;
    __device__ void init(int M_, int N_, int G_, int c_) { S.init(M_, N_, G_, c_); }
    __device__ bool next(int i, Unit& u) const { if (!S.next(i >> 1, u)) return false; if (i & 1) { u.pm += 64; u.pn += 4; } return true; }
    __device__ __forceinline__ void a_ready(const Unit&) const {}
    __device__ __forceinline__ void done(const Unit&) const {}
};
struct EpiResid {
    static constexpr bool PERM = true, AFTER_DRAIN = false;
    const float* base; float* out; bf16_t* xg; const float* gain; float* rowsq;
    __device__ __forceinline__ void operator()(const f32x4 (&acc)[2][2][4][2], const Unit& u, int wr, int wc, int fr, int fq) const {
        const int col0 = u.pn * BM + wc * 32 + 8 * fq, row0 = u.pm * BM + wr * 64 + fr;
#pragma unroll
        for (int ai = 0; ai < 2; ++ai)
#pragma unroll
            for (int m = 0; m < 4; ++m) { asm volatile("" ::: "memory"); __builtin_amdgcn_sched_barrier(0); const int row = row0 + ai * HALF + m * 16; const size_t ro = (size_t)row * 1024 + col0; float ss = 0.f;
#pragma unroll
                for (int bj = 0; bj < 2; ++bj) { f32x4 h[2];
#pragma unroll
                    for (int n = 0; n < 2; ++n) { const f32x4 b = *(const f32x4*)(base + ro + bj * HALF + 4 * n); h[n] = b + acc[ai][bj][m][n]; *(f32x4*)(out + ro + bj * HALF + 4 * n) = h[n];
                        ss += (h[n][0] * h[n][0] + h[n][1] * h[n][1]) + (h[n][2] * h[n][2] + h[n][3] * h[n][3]); }
                    if (xg) { const f32x4 g0 = *(const f32x4*)(gain + col0 + bj * HALF), g1 = *(const f32x4*)(gain + col0 + bj * HALF + 4);
                        u32x4 w; w.x = cvt_pk_bf16(h[0][0] * g0[0], h[0][1] * g0[1]); w.y = cvt_pk_bf16(h[0][2] * g0[2], h[0][3] * g0[3]); w.z = cvt_pk_bf16(h[1][0] * g1[0], h[1][1] * g1[1]); w.w = cvt_pk_bf16(h[1][2] * g1[2], h[1][3] * g1[3]);
                        *(u32x4*)(xg + ro + bj * HALF) = w; } }
                if (xg) { ss += __shfl_xor(ss, 16); ss += __shfl_xor(ss, 32); if (fq == 0) atomicAdd(rowsq + row, ss); } }
    }
};
struct EpiRelu2 {
    static constexpr bool PERM = true, AFTER_DRAIN = false;
    bf16_t* out; int ldc; const float* rowsq;
    __device__ __forceinline__ void operator()(const f32x4 (&acc)[2][2][4][2], const Unit& u, int wr, int wc, int fr, int fq) const {
        const int col0 = u.pn * BM + wc * 32 + 8 * fq, row0 = u.pm * BM + wr * 64 + fr;
#pragma unroll
        for (int ai = 0; ai < 2; ++ai)
#pragma unroll
            for (int m = 0; m < 4; ++m) { asm volatile("" ::: "memory"); __builtin_amdgcn_sched_barrier(0); bf16_t* rowp = out + (size_t)(row0 + ai * HALF + m * 16) * ldc + col0;
                const float rs = rsqrtf(rowsq[row0 + ai * HALF + m * 16] * (1.0f / 1024.0f) + 1e-6f);
#pragma unroll
                for (int bj = 0; bj < 2; ++bj) { f32x4 v0 = acc[ai][bj][m][0] * rs, v1 = acc[ai][bj][m][1] * rs;
#pragma unroll
                    for (int e = 0; e < 4; ++e) { const float a = fmaxf(v0[e], 0.f), b = fmaxf(v1[e], 0.f); v0[e] = a * a; v1[e] = b * b; }
                    u32x4 w; w.x = cvt_pk_bf16(v0[0], v0[1]); w.y = cvt_pk_bf16(v0[2], v0[3]); w.z = cvt_pk_bf16(v1[0], v1[1]); w.w = cvt_pk_bf16(v1[2], v1[3]);
                    *(u32x4*)(rowp + bj * HALF) = w; } }
    }
};
template <class Epi, class Sched, bool ALIGN_EPI = false, bool SP2 = false>
__device__ __forceinline__ void gemm_phase(PG8_LAS unsigned char* lds, const Gemm g, const Sched& S, const Epi& E) {
    int tid_l = threadIdx.x; asm volatile("" : "+v"(tid_l));
    const int tid = tid_l, wid = __builtin_amdgcn_readfirstlane(tid >> 6), lane = tid & 63, wr = wid >> 2, wc = wid & 3, fr = lane & 15, fq = lane >> 4;
    const int K = g.K, nt = K / BK;
    unsigned voffA[2], voffB[2];
#pragma unroll
    for (int i = 0; i < 2; ++i) { int R, C; stage_rc(tid * 16 + i * 8192, R, C); const int Rb = Epi::PERM ? ((R & ~31) + perm32(R & 31)) : R;
        voffA[i] = (unsigned)(R * K + C) * 2u; voffB[i] = (unsigned)(Rb * K + C) * 2u; }
    const size_t kstep = (size_t)(BK * 2);
    const size_t hstep = (size_t)HALF * K * 2;
    const size_t tstep = 2 * hstep;
    const unsigned ldsw = (unsigned)wid * 1024u;
    const int aoff = lds_byte(wr * 64 + fr, fq * 8), boff = lds_byte(wc * 32 + fr, fq * 8);
#define PG8_SA(b, h) (((b) * 2 + (h)) * HTB)
#define PG8_SB(b, h) ((4 + (b) * 2 + (h)) * HTB)
#define PG8_STAGE(bufoff, gbase, voff) do { _Pragma("unroll") for (int _i = 0; _i < 2; ++_i) \
        __builtin_amdgcn_global_load_lds((const unsigned*)((const char*)(gbase) + (voff)[_i]), (PG8_LAS unsigned*)(lds + (bufoff) + ldsw + _i * 8192), 16, 0, 0); } while (0)
#define PG8_LDA(dst, b, h) do { _Pragma("unroll") for (int m = 0; m < 4; ++m) _Pragma("unroll") for (int k = 0; k < 2; ++k) dst[m][k] = *(const PG8_LAS bf16x8*)(lds + PG8_SA(b, h) + aoff + m * 2048 + k * 1024); } while (0)
#define PG8_LDB(dst, b, h) do { _Pragma("unroll") for (int n = 0; n < 2; ++n) _Pragma("unroll") for (int k = 0; k < 2; ++k) dst[n][k] = *(const PG8_LAS bf16x8*)(lds + PG8_SB(b, h) + boff + n * 2048 + k * 1024); } while (0)
#define PG8_MMA(ai, bj, At, Bt) do { __builtin_amdgcn_s_setprio(1); _Pragma("unroll") for (int m = 0; m < 4; ++m) _Pragma("unroll") for (int n = 0; n < 2; ++n) _Pragma("unroll") for (int k = 0; k < 2; ++k) \
        acc[ai][bj][m][n] = __builtin_amdgcn_mfma_f32_16x16x32_bf16(Bt[n][k], At[m][k], acc[ai][bj][m][n], 0, 0, 0); __builtin_amdgcn_s_setprio(0); } while (0)
#define PG8_WAIT_V(n) asm volatile("s_waitcnt vmcnt(" #n ")" ::: "memory")
#define PG8_WAIT_L(n) asm volatile("s_waitcnt lgkmcnt(" #n ")" ::: "memory")
#define PG8_BAR __builtin_amdgcn_s_barrier()
#define PG8_SCHED __builtin_amdgcn_sched_barrier(0)
    Unit cur, nxt; int ui = 0;
    if (!S.next(0, cur)) return;
    f32x4 acc[2][2][4][2];
#pragma unroll
    for (int a = 0; a < 2; ++a)
#pragma unroll
        for (int b = 0; b < 2; ++b)
#pragma unroll
            for (int m = 0; m < 4; ++m)
#pragma unroll
                for (int n = 0; n < 2; ++n) acc[a][b][m][n] = (f32x4){0.f, 0.f, 0.f, 0.f};
    bf16x8 At[4][2], B0[2][2], B1[2][2];
    const char* cA = (const char*)g.A + (size_t)cur.pm * tstep; const char* cB = (const char*)g.Bt + (size_t)cur.pn * tstep;
    S.a_ready(cur);
    if constexpr (SP2) {
        PG8_STAGE(PG8_SB(0, 0), cB, voffB); PG8_STAGE(PG8_SB(0, 1), cB + hstep, voffB); PG8_STAGE(PG8_SA(0, 0), cA, voffA); PG8_STAGE(PG8_SA(0, 1), cA + hstep, voffA);
        if (wr == 1) PG8_BAR;
        PG8_WAIT_V(2); PG8_BAR;
        PG8_STAGE(PG8_SB(1, 0), cB + kstep, voffB); PG8_STAGE(PG8_SA(1, 0), cA + kstep, voffA); PG8_STAGE(PG8_SB(1, 1), cB + hstep + kstep, voffB);
        PG8_WAIT_V(6); PG8_BAR;
    } else {
        PG8_STAGE(PG8_SB(0, 0), cB, voffB); PG8_STAGE(PG8_SA(0, 0), cA, voffA); PG8_STAGE(PG8_SB(0, 1), cB + hstep, voffB); PG8_STAGE(PG8_SA(0, 1), cA + hstep, voffA);
        if (wr == 1) PG8_BAR;
        PG8_WAIT_V(4); PG8_BAR;
        PG8_STAGE(PG8_SB(1, 0), cB + kstep, voffB); PG8_STAGE(PG8_SA(1, 0), cA + kstep, voffA); PG8_STAGE(PG8_SB(1, 1), cB + hstep + kstep, voffB);
        PG8_WAIT_V(6); PG8_BAR;
    }
    for (;;) {
        const bool has_next = S.next(ui + 1, nxt);
        const char* nA = has_next ? (const char*)g.A + (size_t)nxt.pm * tstep : cA; const char* nB = has_next ? (const char*)g.Bt + (size_t)nxt.pn * tstep : cB;
        for (int t = 0; t < nt; t += 2) {
            const bool last = (t == nt - 2);
            const char* a1 = cA + (size_t)(t + 1) * kstep;
            const char* a2 = last ? nA : cA + (size_t)(t + 2) * kstep; const char* b2 = last ? nB : cB + (size_t)(t + 2) * kstep;
            const char* a3 = a2 + kstep; const char* b3 = b2 + kstep;
            if (last && has_next) S.a_ready(nxt);
            if constexpr (SP2) {
            PG8_LDB(B0, 0, 0); PG8_LDB(B1, 0, 1); PG8_SCHED; PG8_LDA(At, 0, 0); PG8_STAGE(PG8_SA(1, 1), a1 + hstep, voffA);
            PG8_WAIT_V(8); PG8_WAIT_L(0); PG8_BAR; PG8_MMA(0, 0, At, B0); PG8_MMA(0, 1, At, B1); PG8_BAR; PG8_SCHED;
            PG8_LDA(At, 0, 1); PG8_STAGE(PG8_SB(0, 0), b2, voffB); PG8_STAGE(PG8_SB(0, 1), b2 + hstep, voffB); PG8_STAGE(PG8_SA(0, 0), a2, voffA);
            PG8_WAIT_V(8); PG8_WAIT_L(0); PG8_BAR; PG8_MMA(1, 0, At, B0); PG8_MMA(1, 1, At, B1); PG8_BAR; PG8_SCHED;
            PG8_LDB(B0, 1, 0); PG8_LDB(B1, 1, 1); PG8_SCHED; PG8_LDA(At, 1, 0); PG8_STAGE(PG8_SA(0, 1), a2 + hstep, voffA);
            PG8_WAIT_V(8); PG8_WAIT_L(0); PG8_BAR; PG8_MMA(0, 0, At, B0); PG8_MMA(0, 1, At, B1); PG8_BAR; PG8_SCHED;
            PG8_LDA(At, 1, 1); PG8_STAGE(PG8_SB(1, 0), b3, voffB); PG8_STAGE(PG8_SB(1, 1), b3 + hstep, voffB); PG8_STAGE(PG8_SA(1, 0), a3, voffA);
            PG8_WAIT_V(8); PG8_WAIT_L(0); PG8_BAR; PG8_MMA(1, 0, At, B0); PG8_MMA(1, 1, At, B1); PG8_BAR; PG8_SCHED;
            } else {
            PG8_LDB(B0, 0, 0); PG8_SCHED; PG8_LDA(At, 0, 0); PG8_STAGE(PG8_SA(1, 1), a1 + hstep, voffA);
            PG8_WAIT_L(8); PG8_BAR; PG8_WAIT_L(0); PG8_MMA(0, 0, At, B0); PG8_BAR; PG8_SCHED;
            PG8_LDB(B1, 0, 1); PG8_STAGE(PG8_SB(0, 0), b2, voffB);
            PG8_BAR; PG8_WAIT_L(0); PG8_MMA(0, 1, At, B1); PG8_BAR;
            PG8_LDA(At, 0, 1); PG8_STAGE(PG8_SA(0, 0), a2, voffA);
            PG8_BAR; PG8_WAIT_L(0); PG8_MMA(1, 0, At, B0); PG8_BAR; PG8_SCHED;
            PG8_STAGE(PG8_SB(0, 1), b2 + hstep, voffB);
            PG8_WAIT_V(6); PG8_BAR; PG8_MMA(1, 1, At, B1); PG8_BAR;
            PG8_LDB(B0, 1, 0); PG8_SCHED; PG8_LDA(At, 1, 0); PG8_STAGE(PG8_SA(0, 1), a2 + hstep, voffA);
            PG8_WAIT_L(8); PG8_BAR; PG8_WAIT_L(0); PG8_MMA(0, 0, At, B0); PG8_BAR; PG8_SCHED;
            PG8_LDB(B1, 1, 1); PG8_STAGE(PG8_SB(1, 0), b3, voffB);
            PG8_BAR; PG8_WAIT_L(0); PG8_MMA(0, 1, At, B1); PG8_BAR;
            PG8_LDA(At, 1, 1); PG8_STAGE(PG8_SA(1, 0), a3, voffA);
            PG8_BAR; PG8_WAIT_L(0); PG8_MMA(1, 0, At, B0); PG8_BAR; PG8_SCHED;
            PG8_STAGE(PG8_SB(1, 1), b3 + hstep, voffB);
            PG8_WAIT_V(6); PG8_BAR; PG8_MMA(1, 1, At, B1); PG8_BAR;
            }
        }
        if constexpr (ALIGN_EPI) { if (wr == 0) PG8_BAR; }
        if constexpr (!Epi::AFTER_DRAIN) { E(acc, cur, wr, wc, fr, fq); S.done(cur); }
        if (!has_next) break;
#pragma unroll
        for (int a = 0; a < 2; ++a)
#pragma unroll
            for (int b = 0; b < 2; ++b)
#pragma unroll
                for (int m = 0; m < 4; ++m)
#pragma unroll
                    for (int n = 0; n < 2; ++n) acc[a][b][m][n] = (f32x4){0.f, 0.f, 0.f, 0.f};
        cur = nxt; cA = nA; cB = nB; ++ui;
        if constexpr (ALIGN_EPI) { if (wr == 1) PG8_BAR; }
    }
    PG8_WAIT_V(0);
    if constexpr (!ALIGN_EPI) { if (wr == 0) PG8_BAR; }
    PG8_BAR;
    if constexpr (Epi::AFTER_DRAIN) { E.fused(acc, cur, wr, wc, fr, fq, lds, wid, lane); S.done(cur); }
#undef PG8_SA
#undef PG8_SB
#undef PG8_STAGE
#undef PG8_LDA
#undef PG8_LDB
#undef PG8_MMA
#undef PG8_WAIT_V
#undef PG8_WAIT_L
#undef PG8_BAR
#undef PG8_SCHED
}
}

#define LAS __attribute__((address_space(3)))
typedef unsigned short bf16;
typedef unsigned v4u __attribute__((ext_vector_type(4)));
typedef unsigned v2u __attribute__((ext_vector_type(2)));
typedef float f32x4 __attribute__((ext_vector_type(4)));
typedef float f32x2 __attribute__((ext_vector_type(2)));
typedef short bf16x8 __attribute__((ext_vector_type(8)));
typedef short s16x4 __attribute__((ext_vector_type(4)));
using pg8::bflo; using pg8::bfhi; using pg8::cvt_pk_bf16;

#ifndef PROJ_ALIGN
#define PROJ_ALIGN false
#endif
#ifndef ONE_LAUNCH
#define ONE_LAUNCH 1
#endif
constexpr int DM = 1024, BATCH = 8, SEQ = 2048, M = BATCH * SEQ, NIN = 9216, DFF = 4096, DEPTH = 2;
constexpr float EPS = 1e-6f;
constexpr int NTHR = 512, NWAVES = 8;
constexpr int LDS_RING = 131072, LDS_BYTES = LDS_RING + 64;
constexpr size_t MiB = 1u << 20;
constexpr size_t WS_RSQ = 256 * 1024;
constexpr size_t WS_LB = 64 * 1024;
constexpr size_t WS_WIN = 1 * MiB, WS_WPA = 19 * MiB, WS_WPB = 21 * MiB, WS_WOUT = 23 * MiB;
constexpr size_t WS_B0 = 25 * MiB, BUFB = 32 * MiB;
constexpr size_t WS_END = WS_B0 + 8 * BUFB;
#define WS_BUF(i) (WS_B0 + (size_t)(i) * BUFB)
constexpr size_t WS_WUP = WS_BUF(6), WS_WDN = WS_BUF(6) + 8 * MiB;
constexpr int PH_PER_LAYER = 10, NPH = DEPTH * PH_PER_LAYER + 1;

__device__ __forceinline__ float wave_sum(float v) {
#pragma unroll
    for (int o = 1; o < 64; o <<= 1) v += __shfl_xor(v, o);
    return v;
}
__device__ __forceinline__ void transpose_item(const float* W, int K, int N, bf16* WT, LAS float* scr, int item, int lane) {
    const int nblk = N / 32, kb = item / nblk, nb = item % nblk, k0 = 64 * kb, n0 = 32 * nb;
#pragma unroll 8
    for (int i = 0; i < 32; ++i) { const int kk = 2 * i + (lane >> 5); scr[kk * 33 + (lane & 31)] = W[(size_t)(k0 + kk) * N + n0 + (lane & 31)]; }
    asm volatile("s_waitcnt lgkmcnt(0)" ::: "memory");
    const int c = lane & 7;
#pragma unroll
    for (int j = 0; j < 4; ++j) { const int n = (lane >> 3) + 8 * j; const LAS float* s = scr + (8 * c) * 33 + n;
        v4u o; o.x = cvt_pk_bf16(s[0 * 33], s[1 * 33]); o.y = cvt_pk_bf16(s[2 * 33], s[3 * 33]); o.z = cvt_pk_bf16(s[4 * 33], s[5 * 33]); o.w = cvt_pk_bf16(s[6 * 33], s[7 * 33]);
        *(v4u*)(WT + (size_t)(n0 + n) * K + k0 + 8 * c) = o; }
    asm volatile("s_waitcnt lgkmcnt(0)" ::: "memory");
}
__device__ __forceinline__ void convert_weight(const float* W, int K, int N, bf16* WT, LAS unsigned char* lds, int gw, int NGW, int wave, int lane) {
    LAS float* scr = (LAS float*)(lds + wave * 16384);
    const int nitems = (K / 64) * (N / 32);
    for (int it = gw; it < nitems; it += NGW) transpose_item(W, K, N, WT, scr, it, lane);
}
__device__ __forceinline__ void rms_row_bf16(const float* xrow, const float* gain, bf16* orow, int lane) {
    const f32x4* xr = (const f32x4*)xrow + lane; const f32x4* gr = (const f32x4*)gain + lane;
    f32x4 v[4]; float s = 0.f;
#pragma unroll
    for (int j = 0; j < 4; ++j) { v[j] = xr[64 * j]; s += (v[j].x * v[j].x + v[j].y * v[j].y) + (v[j].z * v[j].z + v[j].w * v[j].w); }
    const float rstd = rsqrtf(wave_sum(s) * (1.f / DM) + EPS);
    v2u* o8 = (v2u*)orow + lane;
#pragma unroll
    for (int j = 0; j < 4; ++j) { const f32x4 gg = gr[64 * j]; v2u o; o.x = cvt_pk_bf16(v[j].x * rstd * gg.x, v[j].y * rstd * gg.y); o.y = cvt_pk_bf16(v[j].z * rstd * gg.z, v[j].w * rstd * gg.w); o8[64 * j] = o; }
}
__device__ __forceinline__ void rms_row_f32(const float* xrow, const float* gain, float* orow, int lane) {
    const f32x4* xr = (const f32x4*)xrow + lane; const f32x4* gr = (const f32x4*)gain + lane;
    f32x4 v[4]; float s = 0.f;
#pragma unroll
    for (int j = 0; j < 4; ++j) { v[j] = xr[64 * j]; s += (v[j].x * v[j].x + v[j].y * v[j].y) + (v[j].z * v[j].z + v[j].w * v[j].w); }
    const float rstd = rsqrtf(wave_sum(s) * (1.f / DM) + EPS);
    f32x4* o = (f32x4*)orow + lane;
#pragma unroll
    for (int j = 0; j < 4; ++j) { const f32x4 gg = gr[64 * j]; o[64 * j] = v[j] * rstd * gg; }
}

__device__ __forceinline__ void sg_phase(LAS unsigned char* lds, bf16* ZU, const bf16* ZV, const float* ws_l, const float* bs_l, const float* sgn_l, int bid, int G) {
    int tid_l = threadIdx.x; asm volatile("" : "+v"(tid_l));
    const int tid = tid_l, lane = tid & 63, w = __builtin_amdgcn_readfirstlane(tid >> 6), g = lane >> 4, r16 = lane & 15;
    LAS unsigned char* VGT = lds; LAS unsigned char* WSL = lds + 34816;
    for (int item = bid; item < 1024; item += G) {
        const int gq = item & 7, bc = item >> 3, row0 = bc * 128, col0 = gq * 128;
        {
            const int s = tid >> 2, dq = tid & 3;
            v4u z[4]; float ss = 0.f;
#pragma unroll
            for (int e = 0; e < 4; ++e) { z[e] = *(const v4u*)(ZV + (size_t)(row0 + s) * 1024 + col0 + dq * 32 + 8 * e);
#pragma unroll
                for (int q = 0; q < 4; ++q) { const float a = bflo(z[e][q]), b = bfhi(z[e][q]); ss += a * a + b * b; } }
            ss += __shfl_xor(ss, 1); ss += __shfl_xor(ss, 2);
            const float rstd = rsqrtf(ss * (1.f / 128.f) + EPS);
#pragma unroll
            for (int e = 0; e < 4; ++e)
#pragma unroll
                for (int q = 0; q < 4; ++q) { const int d = dq * 32 + 8 * e + 2 * q;
                    const float a = bflo(z[e][q]) * rstd * sgn_l[col0 + d], b = bfhi(z[e][q]) * rstd * sgn_l[col0 + d + 1];
                    const unsigned pk = cvt_pk_bf16(a, b);
                    *(LAS unsigned short*)(VGT + d * 272 + s * 2) = (unsigned short)(pk & 0xffffu);
                    *(LAS unsigned short*)(VGT + (d + 1) * 272 + s * 2) = (unsigned short)(pk >> 16); }
            const int t = tid >> 2, sq = tid & 3; const float* wrow = ws_l + (size_t)gq * 16384 + t * 128 + sq * 32;
#pragma unroll
            for (int e = 0; e < 4; ++e) { const f32x4 a = *(const f32x4*)(wrow + 8 * e), b = *(const f32x4*)(wrow + 8 * e + 4);
                v4u o; o.x = cvt_pk_bf16(a.x, a.y); o.y = cvt_pk_bf16(a.z, a.w); o.z = cvt_pk_bf16(b.x, b.y); o.w = cvt_pk_bf16(b.z, b.w);
                *(LAS v4u*)(WSL + t * 272 + (sq * 32 + 8 * e) * 2) = o; }
        }
        __syncthreads();
        {
            bf16x8 bw[4];
#pragma unroll
            for (int ks = 0; ks < 4; ++ks) bw[ks] = *(const LAS bf16x8*)(WSL + (16 * w + r16) * 272 + (32 * ks + 8 * g) * 2);
            const int row = row0 + 16 * w + r16; const float bias = bs_l[gq * 128 + 16 * w + r16];
#pragma unroll
            for (int dt = 0; dt < 8; ++dt) { f32x4 acc = (f32x4){0.f, 0.f, 0.f, 0.f};
#pragma unroll
                for (int ks = 0; ks < 4; ++ks) { const bf16x8 a = *(const LAS bf16x8*)(VGT + (16 * dt + r16) * 272 + (32 * ks + 8 * g) * 2); acc = __builtin_amdgcn_mfma_f32_16x16x32_bf16(a, bw[ks], acc, 0, 0, 0); }
                v2u* p = (v2u*)(ZU + (size_t)row * 1024 + col0 + 16 * dt + 4 * g); const v2u zu = *p; v2u o;
                o.x = cvt_pk_bf16(bflo(zu.x) * (acc[0] + bias), bfhi(zu.x) * (acc[1] + bias)); o.y = cvt_pk_bf16(bflo(zu.y) * (acc[2] + bias), bfhi(zu.y) * (acc[3] + bias)); *p = o; }
        }
        __syncthreads();
    }
}

constexpr int HG_QH = 0, HG_KH = 17408, HG_KT = 34816, HG_VT = 53248, HG_PP = 62464, HG_TOT = 71680, HG_EBM = 75776, HG_EBL = 76288;
__device__ __forceinline__ void hg_phase(LAS unsigned char* lds, const bf16* Qb, const bf16* LFfw, const bf16* LFbw, const bf16* IVb, bf16* Ofw, bf16* Obw, int bid, int G) {
    int tid_l = threadIdx.x; asm volatile("" : "+v"(tid_l));
    const int tid = tid_l, lane = tid & 63, w = __builtin_amdgcn_readfirstlane(tid >> 6), g = lane >> 4, r16 = lane & 15;
    LAS unsigned char* QH = lds + HG_QH; LAS unsigned char* KH = lds + HG_KH; LAS unsigned char* KT = lds + HG_KT; LAS unsigned char* VT = lds + HG_VT;
    LAS unsigned char* PP = lds + HG_PP; LAS float* TOT = (LAS float*)(lds + HG_TOT); LAS float* EBM = (LAS float*)(lds + HG_EBM); LAS float* EBL = (LAS float*)(lds + HG_EBL);
    const int vs = tid >> 3, vc = tid & 7;
    for (int item = bid; item < 256; item += G) {
        const int vh = (item >> 3) & 1, chain = (item & 7) | ((item >> 4) << 3), dir = chain & 1, h = (chain >> 1) & 7, b = chain >> 4;
        const bf16* LF = dir ? LFbw : LFfw; bf16* O = dir ? Obw : Ofw;
        const size_t colq = (size_t)h * 128 + 2 * lane, colv = (size_t)h * 128 + vh * 64;
#define HG_ROW(c, tau) ((size_t)(b * SEQ + (dir ? (SEQ - 1 - (64 * (c) + (tau))) : (64 * (c) + (tau)))))
        f32x4 S[8];
#pragma unroll
        for (int kt = 0; kt < 8; ++kt) S[kt] = (f32x4){0.f, 0.f, 0.f, 0.f};
        unsigned lfr[8], qr[8]; v4u vr;
#pragma unroll
        for (int j = 0; j < 8; ++j) { const size_t ro = HG_ROW(0, 8 * w + j) * 1024 + colq; lfr[j] = *(const unsigned*)(LF + ro); qr[j] = *(const unsigned*)(Qb + ro); }
        vr = *(const v4u*)(IVb + HG_ROW(0, vs) * 1024 + colv + vc * 8);
        for (int c = 0; c < 32; ++c) {
            float c0[8], c1[8]; float a0 = 0.f, a1 = 0.f;
#pragma unroll
            for (int j = 0; j < 8; ++j) { a0 += bflo(lfr[j]); a1 += bfhi(lfr[j]); c0[j] = a0; c1[j] = a1; }
            *(LAS f32x2*)(TOT + w * 128 + 2 * lane) = (f32x2){a0, a1};
            __syncthreads();
            float off0 = 0.f, off1 = 0.f, bm0 = 0.f, bm1 = 0.f, bl0 = 0.f, bl1 = 0.f;
#pragma unroll
            for (int w2 = 0; w2 < 8; ++w2) { const f32x2 t = *(const LAS f32x2*)(TOT + w2 * 128 + 2 * lane);
                if (w2 < w) { off0 += t.x; off1 += t.y; } if (w2 < 4) { bm0 += t.x; bm1 += t.y; } bl0 += t.x; bl1 += t.y; }
            unsigned kt0[4], kt1[4];
#pragma unroll
            for (int j = 0; j < 8; ++j) {
                const float l0 = bflo(lfr[j]), l1 = bfhi(lfr[j]);
                const float d0 = off0 + c0[j] - bm0, d1 = off1 + c1[j] - bm1;
                const float eq0 = __expf(fminf(d0, 80.f)), eq1 = __expf(fminf(d1, 80.f));
                const float ek0 = __expf(fminf(-d0, 80.f)), ek1 = __expf(fminf(-d1, 80.f));
                const float kk0 = 1.f - __expf(l0), kk1 = 1.f - __expf(l1);
                const int tau = 8 * w + j;
                *(LAS unsigned*)(QH + tau * 272 + 4 * lane) = cvt_pk_bf16(bflo(qr[j]) * eq0, bfhi(qr[j]) * eq1);
                const unsigned kp = cvt_pk_bf16(kk0 * ek0, kk1 * ek1);
                *(LAS unsigned*)(KH + tau * 272 + 4 * lane) = kp;
                if ((j & 1) == 0) { kt0[j >> 1] = kp & 0xffffu; kt1[j >> 1] = kp >> 16; }
                else { kt0[j >> 1] |= kp << 16; kt1[j >> 1] |= kp & 0xffff0000u; }
            }
            *(LAS v4u*)(KT + (2 * lane) * 144 + 16 * w) = (v4u){kt0[0], kt0[1], kt0[2], kt0[3]};
            *(LAS v4u*)(KT + (2 * lane + 1) * 144 + 16 * w) = (v4u){kt1[0], kt1[1], kt1[2], kt1[3]};
            if (w == 0) { *(LAS f32x2*)(EBM + 2 * lane) = (f32x2){__expf(bm0), __expf(bm1)}; *(LAS f32x2*)(EBL + 2 * lane) = (f32x2){__expf(bl0 - bm0), __expf(bl1 - bm1)}; }
#pragma unroll
            for (int e = 0; e < 4; ++e) { const unsigned u = vr[e];
                *(LAS unsigned short*)(VT + (vc * 8 + 2 * e) * 144 + vs * 2) = (unsigned short)(u & 0xffffu);
                *(LAS unsigned short*)(VT + (vc * 8 + 2 * e + 1) * 144 + vs * 2) = (unsigned short)(u >> 16); }
            if (c + 1 < 32) {
#pragma unroll
                for (int j = 0; j < 8; ++j) { const size_t ro = HG_ROW(c + 1, 8 * w + j) * 1024 + colq; lfr[j] = *(const unsigned*)(LF + ro); qr[j] = *(const unsigned*)(Qb + ro); }
                vr = *(const v4u*)(IVb + HG_ROW(c + 1, vs) * 1024 + colv + vc * 8);
            }
            __syncthreads();
            {
                const int tt = w >> 1;
                bf16x8 bq[4];
#pragma unroll
                for (int ks = 0; ks < 4; ++ks) bq[ks] = *(const LAS bf16x8*)(QH + (16 * tt + r16) * 272 + (32 * ks + 8 * g) * 2);
#pragma unroll
                for (int si = 0; si < 2; ++si) { const int st = 2 * (w & 1) + si;
                    if (st <= tt) { f32x4 p = (f32x4){0.f, 0.f, 0.f, 0.f};
#pragma unroll
                        for (int ks = 0; ks < 4; ++ks) { const bf16x8 a = *(const LAS bf16x8*)(KH + (16 * st + r16) * 272 + (32 * ks + 8 * g) * 2); p = __builtin_amdgcn_mfma_f32_16x16x32_bf16(a, bq[ks], p, 0, 0, 0); }
                        if (st == tt) {
#pragma unroll
                            for (int i = 0; i < 4; ++i) if (4 * g + i > r16) p[i] = 0.f; }
                        *(LAS v2u*)(PP + (16 * tt + r16) * 144 + (16 * st + 4 * g) * 2) = (v2u){cvt_pk_bf16(p[0], p[1]), cvt_pk_bf16(p[2], p[3])};
                    } else if (st == tt + 1 && (tt & 1) == 0) *(LAS v2u*)(PP + (16 * tt + r16) * 144 + (16 * st + 4 * g) * 2) = (v2u){0u, 0u};
                }
            }
            __syncthreads();
            {
                const int vt = w & 3, th = w >> 2;
                bf16x8 As[4];
#pragma unroll
                for (int kt = 0; kt < 8; ++kt) S[kt] = S[kt] * *(const LAS f32x4*)(EBM + 16 * kt + 4 * g);
#pragma unroll
                for (int ks = 0; ks < 4; ++ks) { const unsigned x0 = cvt_pk_bf16(S[2 * ks][0], S[2 * ks][1]), x1 = cvt_pk_bf16(S[2 * ks][2], S[2 * ks][3]), x2 = cvt_pk_bf16(S[2 * ks + 1][0], S[2 * ks + 1][1]), x3 = cvt_pk_bf16(S[2 * ks + 1][2], S[2 * ks + 1][3]);
                    As[ks] = __builtin_bit_cast(bf16x8, (v4u){x0, x1, x2, x3}); }
                bf16x8 av[2];
#pragma unroll
                for (int ks = 0; ks < 2; ++ks) av[ks] = *(const LAS bf16x8*)(VT + (16 * vt + r16) * 144 + (32 * ks + 8 * g) * 2);
                f32x4 oacc[2];
#pragma unroll
                for (int ttl = 0; ttl < 2; ++ttl) { const int tt = 2 * th + ttl, trow = 16 * tt + r16; oacc[ttl] = (f32x4){0.f, 0.f, 0.f, 0.f};
#pragma unroll
                    for (int ks = 0; ks < 4; ++ks) { const v2u lo = *(const LAS v2u*)(QH + trow * 272 + (32 * ks + 4 * g) * 2), hi = *(const LAS v2u*)(QH + trow * 272 + (32 * ks + 16 + 4 * g) * 2);
                        oacc[ttl] = __builtin_amdgcn_mfma_f32_16x16x32_bf16(As[ks], __builtin_bit_cast(bf16x8, (v4u){lo.x, lo.y, hi.x, hi.y}), oacc[ttl], 0, 0, 0); }
#pragma unroll
                    for (int ks = 0; ks < 2; ++ks) if (ks <= (tt >> 1)) { const bf16x8 bp = *(const LAS bf16x8*)(PP + trow * 144 + (32 * ks + 8 * g) * 2); oacc[ttl] = __builtin_amdgcn_mfma_f32_16x16x32_bf16(av[ks], bp, oacc[ttl], 0, 0, 0); }
                }
#pragma unroll
                for (int kt = 0; kt < 8; ++kt) {
#pragma unroll
                    for (int ks = 0; ks < 2; ++ks) { const bf16x8 a = *(const LAS bf16x8*)(KT + (16 * kt + r16) * 144 + (32 * ks + 8 * g) * 2); S[kt] = __builtin_amdgcn_mfma_f32_16x16x32_bf16(a, av[ks], S[kt], 0, 0, 0); }
                    S[kt] = S[kt] * *(const LAS f32x4*)(EBL + 16 * kt + 4 * g); }
#pragma unroll
                for (int ttl = 0; ttl < 2; ++ttl) { const int tau = 16 * (2 * th + ttl) + r16;
                    *(v2u*)(O + HG_ROW(c, tau) * 1024 + colv + vt * 16 + 4 * g) = (v2u){cvt_pk_bf16(oacc[ttl][0], oacc[ttl][1]), cvt_pk_bf16(oacc[ttl][2], oacc[ttl][3])}; }
            }
        }
        __syncthreads();
#undef HG_ROW
    }
}

__device__ __forceinline__ void cb_row(bf16* Ofw, const bf16* Obw, const bf16* OG, const float* gain, size_t row, int lane) {
    const size_t o = row * 1024 + 16 * lane;
    v4u a[2], b[2], gq[2]; float s[16]; float ss = 0.f;
#pragma unroll
    for (int e = 0; e < 2; ++e) { a[e] = *(const v4u*)(Ofw + o + 8 * e); b[e] = *(const v4u*)(Obw + o + 8 * e); gq[e] = *(const v4u*)(OG + o + 8 * e); }
#pragma unroll
    for (int e = 0; e < 2; ++e)
#pragma unroll
        for (int q = 0; q < 4; ++q) { const float x = bflo(a[e][q]) + bflo(b[e][q]), y = bfhi(a[e][q]) + bfhi(b[e][q]); s[8 * e + 2 * q] = x; s[8 * e + 2 * q + 1] = y; ss += x * x + y * y; }
    ss += __shfl_xor(ss, 1); ss += __shfl_xor(ss, 2); ss += __shfl_xor(ss, 4);
    const float rstd = rsqrtf(ss * (1.f / 128.f) + EPS);
#pragma unroll
    for (int e = 0; e < 2; ++e) { v4u ov;
#pragma unroll
        for (int q = 0; q < 4; ++q) { const f32x2 gn = *(const f32x2*)(gain + 16 * lane + 8 * e + 2 * q);
            ov[q] = cvt_pk_bf16(s[8 * e + 2 * q] * rstd * gn.x * bflo(gq[e][q]), s[8 * e + 2 * q + 1] * rstd * gn.y * bfhi(gq[e][q])); }
        *(v4u*)(Ofw + o + 8 * e) = ov; }
}

#define XB_TMO      128
#define XB_XCNT(j)  (256  + 64 * (j))
#define XB_XSUB(j)  (1280 + 64 * (j))
#define XB_XGEN(j)  (2304 + 64 * (j))
#define XB_TOP      3328
#define XB_TOPGEN   3392
#define XCD_BAR_WORDS 3456
#define XB_SPIN_CAP (1u << 18)

__device__ __forceinline__ unsigned xb_ld(unsigned* p)              { return __hip_atomic_load(p, __ATOMIC_RELAXED, __HIP_MEMORY_SCOPE_AGENT); }
__device__ __forceinline__ unsigned xb_add(unsigned* p, unsigned v) { return __hip_atomic_fetch_add(p, v, __ATOMIC_RELAXED, __HIP_MEMORY_SCOPE_AGENT); }
__device__ __forceinline__ unsigned xb_xcc_id() { return (unsigned)__builtin_amdgcn_s_getreg((3 << 11) | 20) & 0xFu; }
#define XB_SPIN(cond, bar) do { unsigned _sp = 0; while (cond) { __builtin_amdgcn_s_sleep(1); \
    if ((++_sp & 255u) == 0u) { if (xb_ld(&(bar)[XB_TMO])) break; if (_sp > XB_SPIN_CAP) { atomicAdd(&(bar)[XB_TMO], 1u); break; } } } } while (0)

struct XcdBarrier {
    unsigned* bar; unsigned x;
    volatile LAS unsigned* st;
};

__device__ __forceinline__ XcdBarrier xcd_barrier_post(unsigned* bar, volatile LAS unsigned* st) {
    XcdBarrier b; b.bar = bar; b.x = xb_xcc_id(); b.st = st;
    if (threadIdx.x == 0) (void)xb_add(&bar[XB_XCNT(b.x)], 1u);
    return b;
}
__device__ __forceinline__ void xcd_barrier_complete(unsigned* bar, unsigned x, unsigned& nloc, unsigned& nx) {
    const unsigned G = gridDim.x * gridDim.y * gridDim.z;
    unsigned sum, cnt, mine, sp = 0u;
    for (;;) {
        sum = 0u; cnt = 0u; mine = 0u;
#pragma unroll
        for (unsigned j = 0; j < 16; ++j) { const unsigned c = xb_ld(&bar[XB_XCNT(j)]); sum += c; cnt += (c > 0u) ? 1u : 0u; mine = (j == x) ? c : mine; }
        if (sum == G) break;
        __builtin_amdgcn_s_sleep(1);
        if ((++sp & 255u) == 0u) { if (xb_ld(&bar[XB_TMO])) break; if (sp > XB_SPIN_CAP) { atomicAdd(&bar[XB_TMO], 1u); break; } }
    }
    nloc = mine > 0u ? mine : 1u; nx = cnt > 0u ? cnt : 1u;
}

__device__ __forceinline__ void xcd_barrier(const XcdBarrier& b) {
    asm volatile("s_waitcnt vmcnt(0)" ::: "memory");
    __syncthreads();
    if (threadIdx.x == 0) {
        unsigned* bar = b.bar;
        __builtin_amdgcn_s_waitcnt(0);
        unsigned nloc = b.st[0], nx = b.st[1];
        if (nloc == 0u) { xcd_barrier_complete(bar, b.x, nloc, nx); b.st[0] = nloc; b.st[1] = nx; }
        const unsigned old = xb_add(&bar[XB_XSUB(b.x)], 1u);
        const unsigned gen = old / nloc;
        if (old + 1u == (gen + 1u) * nloc) {
            __builtin_amdgcn_fence(__ATOMIC_RELEASE, "agent");
            asm volatile("s_waitcnt vmcnt(0)" ::: "memory");
            const unsigned og = xb_add(&bar[XB_TOP], 1u);
            const unsigned tg = og / nx;
            if (og + 1u == (tg + 1u) * nx) xb_add(&bar[XB_TOPGEN], 1u);
            else XB_SPIN(xb_ld(&bar[XB_TOPGEN]) == tg, bar);
            __builtin_amdgcn_fence(__ATOMIC_ACQUIRE, "agent");
            xb_add(&bar[XB_XGEN(b.x)], 1u);
            asm volatile("s_waitcnt vmcnt(0)" ::: "memory");
        } else {
            XB_SPIN(xb_ld(&bar[XB_XGEN(b.x)]) == gen, bar);
            __builtin_amdgcn_fence(__ATOMIC_ACQUIRE, "agent");
            asm volatile("s_waitcnt vmcnt(0)" ::: "memory");
        }
    }
    __syncthreads();
}

struct Args { const float* in[15]; float* out; unsigned char* ws; int ph_lo, ph_hi; };

__global__ void __launch_bounds__(NTHR, 2) fwd(Args a) {
    extern __shared__ __attribute__((aligned(16))) unsigned char lds_raw[];
    LAS unsigned char* lds = (LAS unsigned char*)lds_raw;
    const int G = gridDim.x, bid = blockIdx.x, NGW = G * NWAVES;
    volatile LAS unsigned* MISC = (volatile LAS unsigned*)(lds + LDS_RING);
    if (threadIdx.x < 16) MISC[threadIdx.x] = 0u;
    __syncthreads();
    XcdBarrier xbar; xbar.bar = (unsigned*)a.ws; xbar.x = 0; xbar.st = nullptr;
    if (a.ph_hi - a.ph_lo > 1) xbar = xcd_barrier_post((unsigned*)a.ws, MISC);
    const float* x = a.in[0]; const float* w_in = a.in[1]; const float* ln_mix = a.in[2]; const float* ln_mlp = a.in[3]; const float* sg_norm = a.in[4];
    const float* w_s = a.in[5]; const float* b_s = a.in[6]; const float* lb_logits = a.in[7]; const float* rec_norm = a.in[8];
    const float* w_pa = a.in[9]; const float* w_pb = a.in[10]; const float* w_out = a.in[11]; const float* w_up = a.in[12]; const float* w_down = a.in[13]; const float* ln_final = a.in[14];
#define BUF(i) ((bf16*)(ws + WS_BUF(i)))
    for (int p = a.ph_lo; p < a.ph_hi; ++p) {
        if (p > a.ph_lo) { asm volatile("s_waitcnt vmcnt(0)" ::: "memory");
#ifdef PROBE_SYNC
            const unsigned long long ts0 = __builtin_amdgcn_s_memrealtime();
#endif
            if (p == a.ph_lo + 1) cg::this_grid().sync(); else xcd_barrier(xbar);
#ifdef PROBE_SYNC
            { const unsigned long long ts1 = __builtin_amdgcn_s_memrealtime(); if (blockIdx.x == PROBE_SYNC_BLK && threadIdx.x == 0) { float* pp = (float*)(a.ws + 32768); const float prev = (p == a.ph_lo + 1) ? 0.f : *(volatile float*)pp; *pp = prev + (float)(ts1 - ts0) * (1.0f / PROBE_DIV); } }
#endif
            }
        int tid = threadIdx.x; asm volatile("" : "+v"(tid));
        const int lane = tid & 63, wave = __builtin_amdgcn_readfirstlane(tid >> 6), gw = bid * NWAVES + wave;
        unsigned char* ws = a.ws; asm volatile("" : "+s"(ws));
        float* out = a.out; asm volatile("" : "+s"(out));
        float* LB = (float*)(ws + WS_LB); float* RSQ = (float*)(ws + WS_RSQ);
        bf16* WIN = (bf16*)(ws + WS_WIN); bf16* WPA = (bf16*)(ws + WS_WPA); bf16* WPB = (bf16*)(ws + WS_WPB); bf16* WOUT = (bf16*)(ws + WS_WOUT);
        bf16* WUP = (bf16*)(ws + WS_WUP); bf16* WDN = (bf16*)(ws + WS_WDN);
#ifdef DBG_NRUN
        if (p == DBG_NRUN) {
            for (size_t i = (size_t)bid * NTHR + tid; i < (size_t)M * DM; i += (size_t)G * NTHR) { float s = (DBG_NRUN >= 8) ? out[i] : 0.f;
                for (int k = 0; k < 8; ++k) s += bflo((unsigned)((const bf16*)(ws + WS_BUF(k)))[i]); out[i] = s; }
            continue;
        }
        if (p > DBG_NRUN) continue;
#endif
        if (p == NPH - 1) {
            for (int m = gw; m < M; m += NGW) rms_row_f32(out + (size_t)m * DM, ln_final, out + (size_t)m * DM, lane);
            continue;
        }
        const int l = p / PH_PER_LAYER, j = p % PH_PER_LAYER;
#ifdef PROBE_PH
        unsigned long long t0p = 0; if ((PROBE_PH >> j) & 1) t0p = __builtin_amdgcn_s_memrealtime();
#endif
        const float* hin = (l == 0) ? x : out;
#ifndef PHASE_MASK
#define PHASE_MASK 0x7ff
#endif
        if (!((PHASE_MASK >> j) & 1)) continue;
        switch (j) {
        case 0: {
#ifdef DBG_FILL
            if (l == 0) { v4u* fp = (v4u*)(ws + WS_BUF(1)); const size_t n16 = (size_t)7 * BUFB / 16; for (size_t i = (size_t)bid * NTHR + tid; i < n16; i += (size_t)G * NTHR) fp[i] = (v4u){DBG_FILL, DBG_FILL, DBG_FILL, DBG_FILL}; }
#endif
            convert_weight(w_in + (size_t)l * DM * NIN, DM, NIN, WIN, lds, gw, NGW, wave, lane);
            convert_weight(w_pa + (size_t)l * DM * DM, DM, DM, WPA, lds, gw, NGW, wave, lane);
            convert_weight(w_pb + (size_t)l * DM * DM, DM, DM, WPB, lds, gw, NGW, wave, lane);
            convert_weight(w_out + (size_t)l * DM * DM, DM, DM, WOUT, lds, gw, NGW, wave, lane);
            for (int i = bid * NTHR + tid; i < 2 * DM; i += G * NTHR) { LB[i] = 0.f; LB[2 * DM + i] = 1.f / (1.f + __expf(lb_logits[i] - lb_logits[2 * DM + i])); }
            if (l == 0) {
                for (int i = bid * NTHR + tid; i < 3 * M; i += G * NTHR) RSQ[i] = 0.f;
                for (int m = gw; m < M; m += NGW) rms_row_bf16(hin + (size_t)m * DM, ln_mix + l * DM, BUF(0) + (size_t)m * DM, lane);
            }
            __syncthreads();
        } break;
        case 1: {
#define PROJ(MA, MB, split, sec0, bufi, lbp) { pg8::Gemm g{BUF(0), WIN + (size_t)(sec0) * DM * DM, M, 3 * DM, DM}; pg8::StaticOrder S; S.init(M, 3 * DM, G, bid); \
            pg8::EpiProj<MA, MB> E{BUF(bufi), (size_t)M * DM, lbp, (l == 0) ? (const float*)nullptr : (const float*)(RSQ + M), split}; pg8::gemm_phase<pg8::EpiProj<MA, MB>, pg8::StaticOrder, PROJ_ALIGN, true>(lds, g, S, E); }
            PROJ(0, 1, 2, 0, 1, LB) PROJ(2, 3, 2, 3, 4, LB + (size_t)l * 2 * DM)
        } break;
        case 2: sg_phase(lds, BUF(1), BUF(2), w_s + (size_t)l * 8 * 16384, b_s + (size_t)l * 1024, sg_norm + (size_t)l * DM, bid, G); break;
        case 3: hg_phase(lds, BUF(3), BUF(4), BUF(5), BUF(6), BUF(2), BUF(7), bid, G); break;
        case 4: {
            PROJ(3, 4, 1, 6, 3, LB)
        } break;
        case 5: {
            convert_weight(w_up + (size_t)l * DM * DFF, DM, DFF, WUP, lds, gw, NGW, wave, lane);
            convert_weight(w_down + (size_t)l * DFF * DM, DFF, DM, WDN, lds, gw, NGW, wave, lane);
            for (int m = gw; m < M; m += NGW) cb_row(BUF(2), BUF(7), BUF(3), rec_norm + (size_t)l * DM, (size_t)m, lane);
            __syncthreads();
        } break;
        case 6: {
            pg8::Gemm g{BUF(1), WPA, 2 * M, 2 * DM, DM}; pg8::PairOrder S; S.init(M, DM, G, bid); pg8::EpiGate E{BUF(4), BUF(5)};
            pg8::gemm_phase<pg8::EpiGate, pg8::PairOrder, false, true>(lds, g, S, E);
        } break;
        case 7: {
            pg8::Gemm g{BUF(4), WOUT, M, DM, DM}; pg8::StaticOrder S; S.init(M, DM, G, bid); pg8::EpiResid E{hin, out, BUF(0), ln_mlp + l * DM, RSQ + (size_t)(l == 0 ? 0 : 2) * M};

            pg8::gemm_phase<pg8::EpiResid, pg8::StaticOrder, false, true>(lds, g, S, E);
        } break;
        case 8: {
            pg8::Gemm g{BUF(0), WUP, M, DFF, DM}; pg8::StaticOrder S; S.init(M, DFF, G, bid); pg8::EpiRelu2 E{BUF(1), DFF, RSQ + (size_t)(l == 0 ? 0 : 2) * M};
            pg8::gemm_phase<pg8::EpiRelu2, pg8::StaticOrder, false, true>(lds, g, S, E);
        } break;
        case 9: {
            pg8::Gemm g{BUF(1), WDN, M, DM, DFF}; pg8::StaticOrder S; S.init(M, DM, G, bid); pg8::EpiResid E{out, out, (l == 0) ? BUF(0) : (bf16*)nullptr, ln_mix + DM, RSQ + M};
            pg8::gemm_phase<pg8::EpiResid, pg8::StaticOrder, false, true>(lds, g, S, E);
        } break;
        }
#ifdef PROBE_PH
        if ((PROBE_PH >> j) & 1) { asm volatile("s_waitcnt vmcnt(0)" ::: "memory"); __syncthreads(); const unsigned long long t1p = __builtin_amdgcn_s_memrealtime();
#ifdef PROBE_MAX
            if (tid == 0) atomicMax((unsigned*)(ws + 32768) + 1 + p, (unsigned)(t1p - t0p));
#else
            if (bid == 0 && tid == 0) atomicAdd((unsigned*)(ws + 32768) + 1 + p, (unsigned)(t1p - t0p));
#endif
        }
#endif
    }
#if defined(PROBE_PH)
    if (bid == 0 && threadIdx.x == 0) { asm volatile("s_waitcnt vmcnt(0)" ::: "memory"); unsigned s = 0; for (int q = 0; q < NPH; ++q) s += __hip_atomic_load((unsigned*)(a.ws + 32768) + 1 + q, __ATOMIC_RELAXED, __HIP_MEMORY_SCOPE_AGENT); a.out[0] = (float)s * (1.0f / PROBE_DIV); }
#elif defined(PROBE_SYNC)
    if (bid == 0 && threadIdx.x == 0) { asm volatile("s_waitcnt vmcnt(0)" ::: "memory"); a.out[0] = *(volatile float*)(a.ws + 32768); }
#endif
#undef BUF
}

extern "C" void kernel_launch(void* const* d_in, const int* in_sizes, int n_in, void* d_out, int out_size, void* d_ws, size_t ws_size, hipStream_t stream) {
    static int grid = 0;
    if (grid == 0) {
        if (n_in != 15 || out_size != M * DM || ws_size < WS_END) { fprintf(stderr, "kernel_launch: unexpected problem (n_in %d, out %d, ws %zu < %zu)\n", n_in, out_size, ws_size, (size_t)WS_END); grid = -1; return; }
        int dev = 0, cus = 0, per_cu = 0;
        hipGetDevice(&dev); hipDeviceGetAttribute(&cus, hipDeviceAttributeMultiprocessorCount, dev);
        if (hipFuncSetAttribute((const void*)fwd, hipFuncAttributeMaxDynamicSharedMemorySize, LDS_BYTES) != hipSuccess) { fprintf(stderr, "kernel_launch: hipFuncSetAttribute failed\n"); grid = -1; return; }
        if (hipOccupancyMaxActiveBlocksPerMultiprocessor(&per_cu, (const void*)fwd, NTHR, LDS_BYTES) != hipSuccess || per_cu < 1) { fprintf(stderr, "kernel_launch: occupancy query says %d\n", per_cu); per_cu = 1; }
        (void)hipGetLastError();
        grid = cus;
    }
    if (grid < 0) return;
#if defined(PROBE_PH)
    (void)hipMemsetAsync((char*)d_ws + 32768, 0, 512, stream);
#endif
    (void)hipMemsetAsync(d_ws, 0, 16384, stream);
    Args a{};
    for (int i = 0; i < 15; ++i) a.in[i] = (const float*)d_in[i];
    a.out = (float*)d_out; a.ws = (unsigned char*)d_ws;
#if ONE_LAUNCH
    a.ph_lo = 0; a.ph_hi = NPH;
    void* args[] = {&a};
    hipError_t e = hipLaunchCooperativeKernel((const void*)fwd, dim3(grid), dim3(NTHR), args, LDS_BYTES, stream);
    if (e != hipSuccess) fprintf(stderr, "cooperative launch failed: %s (grid %d)\n", hipGetErrorString(e), grid);
#else
    for (int p = 0; p < NPH; ++p) { a.ph_lo = p; a.ph_hi = p + 1; hipLaunchKernelGGL(fwd, dim3(grid), dim3(NTHR), LDS_BYTES, stream, a); }
#endif
}
```

```cpp
#define ONE_LAUNCH 1
#include <hip/hip_runtime.h>
#include <hip/hip_cooperative_groups.h>
#include <cstdio>
#include <cstdint>
namespace cg = cooperative_groups;
namespace pg8 {
#define PG8_LAS __attribute__((address_space(3)))
typedef unsigned short bf16_t;
typedef short bf16x8 __attribute__((ext_vector_type(8)));
typedef float f32x4 __attribute__((ext_vector_type(4)));
typedef unsigned u32x4 __attribute__((ext_vector_type(4)));
constexpr int BM = 256, BK = 64, HALF = 128, HTB = HALF * BK * 2  , STAGE_BYTES = 8 * HTB, NXCD = 8, WGM = 8;

__host__ __device__ __forceinline__ int lds_byte(int r, int c) { const int st = (r >> 4) * 2 + (c >> 5), rr = r & 15, cc = c & 31, ob = rr * 64 + cc * 2; return st * 1024 + (ob ^ (((ob >> 9) & 1) << 5)); }
__host__ __device__ __forceinline__ void stage_rc(int b, int& R, int& C) { const int st = b / 1024, sb = b % 1024, swz = sb ^ (((sb >> 9) & 1) << 5); R = (st >> 1) * 16 + swz / 64; C = (st & 1) * 32 + (swz % 64) / 2; }
__host__ __device__ __forceinline__ int perm32(int rho) { const int n = rho >> 4, i = rho & 15; return 8 * (i >> 2) + 4 * n + (i & 3); }

struct Unit { int pm, pn; };
struct Gemm { const bf16_t* A; const bf16_t* Bt; int M, N, K; };

struct StaticOrder {
    int nM, nN, nwg, G, c;
    __host__ __device__ void init(int M, int N, int G_, int c_) { nM = M / BM; nN = N / BM; nwg = nM * nN; G = G_; c = c_; }
    __host__ __device__ bool next(int i, Unit& u) const {
        const long L = (long)i * G + c; if (L >= nwg) return false;
        int wgid = (int)L; { const int q = nwg / NXCD, r = nwg % NXCD, xcd = wgid % NXCD, off = wgid / NXCD; wgid = (xcd < r ? xcd * (q + 1) : r * (q + 1) + (xcd - r) * q) + off; }
        const int nig = WGM * nN, gid = wgid / nig, fm = gid * WGM, gsz = (nM - fm) < WGM ? (nM - fm) : WGM;
        u.pm = fm + ((wgid % nig) % gsz); u.pn = (wgid % nig) / gsz; return true;
    }
    __device__ __forceinline__ void a_ready(const Unit&) const {}
    __device__ __forceinline__ void done(const Unit&) const {}
};

typedef float cvt_f32x2_t __attribute__((ext_vector_type(2)));
typedef __bf16 cvt_bf16x2_t __attribute__((ext_vector_type(2)));
__device__ __forceinline__ unsigned cvt_pk_bf16(float lo, float hi) { cvt_f32x2_t v = {lo, hi}; cvt_bf16x2_t b = __builtin_convertvector(v, cvt_bf16x2_t); return __builtin_bit_cast(unsigned, b); }
typedef float f32x2 __attribute__((ext_vector_type(2)));
__device__ __forceinline__ f32x2 gelu_pk(f32x2 v) {
    const f32x2 av = __builtin_elementwise_abs(v), d = av * 0.2316418882f + 1.0f;
    f32x2 t; t.x = __builtin_amdgcn_rcpf(d.x); t.y = __builtin_amdgcn_rcpf(d.y);
    f32x2 q = t * 0.5307027145f + (-0.7265760135f); q = q * t + 0.7107068705f; q = q * t + (-0.142248368f); q = q * t + 0.127414796f; q = q * t;
    const f32x2 s = (v * v) * (-0.72134752044f);
    f32x2 e; e.x = __builtin_amdgcn_exp2f(s.x); e.y = __builtin_amdgcn_exp2f(s.y);
    const f32x2 m = v * (q * e), r = v - m;
    f32x2 o; o.x = v.x < 0.f ? m.x : r.x; o.y = v.y < 0.f ? m.y : r.y; return o;
}
__device__ __forceinline__ float bflo(unsigned u) { return __builtin_bit_cast(float, u << 16); }
__device__ __forceinline__ float bfhi(unsigned u) { return __builtin_bit_cast(float, u & 0xffff0000u); }
__device__ __forceinline__ float sigm(float z) { return __builtin_amdgcn_rcpf(1.0f + __expf(-z)); }
template <int MA, int MB> struct EpiProj {
    static constexpr bool PERM = true, AFTER_DRAIN = false;
    bf16_t* out0; size_t sec_stride; const float* lb; const float* rowsq; int split;
    template <int MODE> __device__ __forceinline__ void run(const f32x4 (&acc)[2][2][4][2], bf16_t* base, const float* lbrow, int row0, int col0) const {
#pragma unroll
        for (int ai = 0; ai < 2; ++ai)
#pragma unroll
            for (int m = 0; m < 4; ++m) { bf16_t* rowp = base + (size_t)(row0 + ai * HALF + m * 16) * 1024 + col0;
                const float rs = rowsq ? rsqrtf(rowsq[row0 + ai * HALF + m * 16] * (1.0f / 1024.0f) + 1e-6f) : 1.0f;
#pragma unroll
                for (int bj = 0; bj < 2; ++bj) { f32x4 v[2] = {acc[ai][bj][m][0] * rs, acc[ai][bj][m][1] * rs};
#pragma unroll
                    for (int n = 0; n < 2; ++n) {
                        if (MODE == 0) { f32x2 a = gelu_pk((f32x2){v[n][0], v[n][1]}), b = gelu_pk((f32x2){v[n][2], v[n][3]}); v[n] = (f32x4){a.x, a.y, b.x, b.y}; }
                        else if (MODE == 2) { const f32x4 lbv = *(const f32x4*)(lbrow + bj * HALF + 4 * n);
#pragma unroll
                            for (int e = 0; e < 4; ++e) { const float l = lbv[e]; const float f = l + (1.0f - l) * sigm(v[n][e]); v[n][e] = __log2f(f); }
                        } else if (MODE == 3) {
#pragma unroll
                            for (int e = 0; e < 4; ++e) v[n][e] = v[n][e] * sigm(v[n][e]);
                        } else if (MODE == 4) {
#pragma unroll
                            for (int e = 0; e < 4; ++e) v[n][e] = sigm(v[n][e]);
                        }
                    }
                    u32x4 w; w.x = cvt_pk_bf16(v[0][0], v[0][1]); w.y = cvt_pk_bf16(v[0][2], v[0][3]); w.z = cvt_pk_bf16(v[1][0], v[1][1]); w.w = cvt_pk_bf16(v[1][2], v[1][3]);
                    *(u32x4*)(rowp + bj * HALF) = w; } }
    }
    __device__ __forceinline__ void operator()(const f32x4 (&acc)[2][2][4][2], const Unit& u, int wr, int wc, int fr, int fq) const {
        const int colt = u.pn * BM, sec = colt >> 10;
        bf16_t* base = out0 + (size_t)sec * sec_stride;
        const int col0 = (colt & 1023) + wc * 32 + 8 * fq, row0 = u.pm * BM + wr * 64 + fr;
        const float* lbrow = lb + sec * 1024 + col0;
        if (sec < split) run<MA>(acc, base, lbrow, row0, col0); else run<MB>(acc, base, lbrow, row0, col0);
    }
};
struct EpiGate {
    static constexpr bool PERM = true, AFTER_DRAIN = false;
    bf16_t* T; const bf16_t* gate2;
    __device__ __forceinline__ void operator()(const f32x4 (&acc)[2][2][4][2], const Unit& u, int wr, int wc, int fr, int fq) const {
        const bool second = u.pm >= 64;
        const int col0 = (u.pn & 3) * BM + wc * 32 + 8 * fq, row0 = (u.pm & 63) * BM + wr * 64 + fr;
        const bf16_t* gate = second ? gate2 : T;
#pragma unroll
        for (int ai = 0; ai < 2; ++ai)
#pragma unroll
            for (int m = 0; m < 4; ++m) { asm volatile("" ::: "memory"); __builtin_amdgcn_sched_barrier(0); const size_t ro = (size_t)(row0 + ai * HALF + m * 16) * 1024 + col0;
#pragma unroll
                for (int bj = 0; bj < 2; ++bj) {
                    const u32x4 gv = *(const u32x4*)(gate + ro + bj * HALF);
                    u32x4 av = (u32x4){0u, 0u, 0u, 0u}; if (second) av = *(const u32x4*)(T + ro + bj * HALF);
                    const f32x4 v0 = acc[ai][bj][m][0], v1 = acc[ai][bj][m][1];
                    u32x4 w;
                    w.x = cvt_pk_bf16(bflo(av.x) + bflo(gv.x) * v0[0], bfhi(av.x) + bfhi(gv.x) * v0[1]);
                    w.y = cvt_pk_bf16(bflo(av.y) + bflo(gv.y) * v0[2], bfhi(av.y) + bfhi(gv.y) * v0[3]);
                    w.z = cvt_pk_bf16(bflo(av.z) + bflo(gv.z) * v1[0], bfhi(av.z) + bfhi(gv.z) * v1[1]);
                    w.w = cvt_pk_bf16(bflo(av.w) + bflo(gv.w) * v1[2], bfhi(av.w) + bfhi(gv.w) * v1[3]);
                    *(u32x4*)(T + ro + bj * HALF) = w; } }
    }
};
struct PairOrder {
    StaticOrder S;
    __device__ void init(int M_, int N_, int G_, int c_) { S.init(M_, N_, G_, c_); }
    __device__ bool next(int i, Unit& u) const { if (!S.next(i >> 1, u)) return false; if (i & 1) { u.pm += 64; u.pn += 4; } return true; }
    __device__ __forceinline__ void a_ready(const Unit&) const {}
    __device__ __forceinline__ void done(const Unit&) const {}
};
struct EpiResid {
    static constexpr bool PERM = true, AFTER_DRAIN = false;
    const float* base; float* out; bf16_t* xg; const float* gain; float* rowsq;
    __device__ __forceinline__ void operator()(const f32x4 (&acc)[2][2][4][2], const Unit& u, int wr, int wc, int fr, int fq) const {
        const int col0 = u.pn * BM + wc * 32 + 8 * fq, row0 = u.pm * BM + wr * 64 + fr;
#pragma unroll
        for (int ai = 0; ai < 2; ++ai)
#pragma unroll
            for (int m = 0; m < 4; ++m) { asm volatile("" ::: "memory"); __builtin_amdgcn_sched_barrier(0); const int row = row0 + ai * HALF + m * 16; const size_t ro = (size_t)row * 1024 + col0; float ss = 0.f;
#pragma unroll
                for (int bj = 0; bj < 2; ++bj) { f32x4 h[2];
#pragma unroll
                    for (int n = 0; n < 2; ++n) { const f32x4 b = *(const f32x4*)(base + ro + bj * HALF + 4 * n); h[n] = b + acc[ai][bj][m][n]; *(f32x4*)(out + ro + bj * HALF + 4 * n) = h[n];
                        ss += (h[n][0] * h[n][0] + h[n][1] * h[n][1]) + (h[n][2] * h[n][2] + h[n][3] * h[n][3]); }
                    if (xg) { const f32x4 g0 = *(const f32x4*)(gain + col0 + bj * HALF), g1 = *(const f32x4*)(gain + col0 + bj * HALF + 4);
                        u32x4 w; w.x = cvt_pk_bf16(h[0][0] * g0[0], h[0][1] * g0[1]); w.y = cvt_pk_bf16(h[0][2] * g0[2], h[0][3] * g0[3]); w.z = cvt_pk_bf16(h[1][0] * g1[0], h[1][1] * g1[1]); w.w = cvt_pk_bf16(h[1][2] * g1[2], h[1][3] * g1[3]);
                        *(u32x4*)(xg + ro + bj * HALF) = w; } }
                if (xg) { ss += __shfl_xor(ss, 16); ss += __shfl_xor(ss, 32); if (fq == 0) atomicAdd(rowsq + row, ss); } }
    }
};
struct EpiRelu2 {
    static constexpr bool PERM = true, AFTER_DRAIN = false;
    bf16_t* out; int ldc; const float* rowsq;
    __device__ __forceinline__ void operator()(const f32x4 (&acc)[2][2][4][2], const Unit& u, int wr, int wc, int fr, int fq) const {
        const int col0 = u.pn * BM + wc * 32 + 8 * fq, row0 = u.pm * BM + wr * 64 + fr;
#pragma unroll
        for (int ai = 0; ai < 2; ++ai)
#pragma unroll
            for (int m = 0; m < 4; ++m) { asm volatile("" ::: "memory"); __builtin_amdgcn_sched_barrier(0); bf16_t* rowp = out + (size_t)(row0 + ai * HALF + m * 16) * ldc + col0;
                const float rs = rsqrtf(rowsq[row0 + ai * HALF + m * 16] * (1.0f / 1024.0f) + 1e-6f);
#pragma unroll
                for (int bj = 0; bj < 2; ++bj) { f32x4 v0 = acc[ai][bj][m][0] * rs, v1 = acc[ai][bj][m][1] * rs;
#pragma unroll
                    for (int e = 0; e < 4; ++e) { const float a = fmaxf(v0[e], 0.f), b = fmaxf(v1[e], 0.f); v0[e] = a * a; v1[e] = b * b; }
                    u32x4 w; w.x = cvt_pk_bf16(v0[0], v0[1]); w.y = cvt_pk_bf16(v0[2], v0[3]); w.z = cvt_pk_bf16(v1[0], v1[1]); w.w = cvt_pk_bf16(v1[2], v1[3]);
                    *(u32x4*)(rowp + bj * HALF) = w; } }
    }
};
template <class Epi, class Sched, bool ALIGN_EPI = false, bool SP2 = false>
__device__ __forceinline__ void gemm_phase(PG8_LAS unsigned char* lds, const Gemm g, const Sched& S, const Epi& E) {
    int tid_l = threadIdx.x; asm volatile("" : "+v"(tid_l));
    const int tid = tid_l, wid = __builtin_amdgcn_readfirstlane(tid >> 6), lane = tid & 63, wr = wid >> 2, wc = wid & 3, fr = lane & 15, fq = lane >> 4;
    const int K = g.K, nt = K / BK;
    unsigned voffA[2], voffB[2];
#pragma unroll
    for (int i = 0; i < 2; ++i) { int R, C; stage_rc(tid * 16 + i * 8192, R, C); const int Rb = Epi::PERM ? ((R & ~31) + perm32(R & 31)) : R;
        voffA[i] = (unsigned)(R * K + C) * 2u; voffB[i] = (unsigned)(Rb * K + C) * 2u; }
    const size_t kstep = (size_t)(BK * 2);
    const size_t hstep = (size_t)HALF * K * 2;
    const size_t tstep = 2 * hstep;
    const unsigned ldsw = (unsigned)wid * 1024u;
    const int aoff = lds_byte(wr * 64 + fr, fq * 8), boff = lds_byte(wc * 32 + fr, fq * 8);
#define PG8_SA(b, h) (((b) * 2 + (h)) * HTB)
#define PG8_SB(b, h) ((4 + (b) * 2 + (h)) * HTB)
#define PG8_STAGE(bufoff, gbase, voff) do { _Pragma("unroll") for (int _i = 0; _i < 2; ++_i) \
        __builtin_amdgcn_global_load_lds((const unsigned*)((const char*)(gbase) + (voff)[_i]), (PG8_LAS unsigned*)(lds + (bufoff) + ldsw + _i * 8192), 16, 0, 0); } while (0)
#define PG8_LDA(dst, b, h) do { _Pragma("unroll") for (int m = 0; m < 4; ++m) _Pragma("unroll") for (int k = 0; k < 2; ++k) dst[m][k] = *(const PG8_LAS bf16x8*)(lds + PG8_SA(b, h) + aoff + m * 2048 + k * 1024); } while (0)
#define PG8_LDB(dst, b, h) do { _Pragma("unroll") for (int n = 0; n < 2; ++n) _Pragma("unroll") for (int k = 0; k < 2; ++k) dst[n][k] = *(const PG8_LAS bf16x8*)(lds + PG8_SB(b, h) + boff + n * 2048 + k * 1024); } while (0)
#define PG8_MMA(ai, bj, At, Bt) do { __builtin_amdgcn_s_setprio(1); _Pragma("unroll") for (int m = 0; m < 4; ++m) _Pragma("unroll") for (int n = 0; n < 2; ++n) _Pragma("unroll") for (int k = 0; k < 2; ++k) \
        acc[ai][bj][m][n] = __builtin_amdgcn_mfma_f32_16x16x32_bf16(Bt[n][k], At[m][k], acc[ai][bj][m][n], 0, 0, 0); __builtin_amdgcn_s_setprio(0); } while (0)
#define PG8_WAIT_V(n) asm volatile("s_waitcnt vmcnt(" #n ")" ::: "memory")
#define PG8_WAIT_L(n) asm volatile("s_waitcnt lgkmcnt(" #n ")" ::: "memory")
#define PG8_BAR __builtin_amdgcn_s_barrier()
#define PG8_SCHED __builtin_amdgcn_sched_barrier(0)
    Unit cur, nxt; int ui = 0;
    if (!S.next(0, cur)) return;
    f32x4 acc[2][2][4][2];
#pragma unroll
    for (int a = 0; a < 2; ++a)
#pragma unroll
        for (int b = 0; b < 2; ++b)
#pragma unroll
            for (int m = 0; m < 4; ++m)
#pragma unroll
                for (int n = 0; n < 2; ++n) acc[a][b][m][n] = (f32x4){0.f, 0.f, 0.f, 0.f};
    bf16x8 At[4][2], B0[2][2], B1[2][2];
    const char* cA = (const char*)g.A + (size_t)cur.pm * tstep; const char* cB = (const char*)g.Bt + (size_t)cur.pn * tstep;
    S.a_ready(cur);
    if constexpr (SP2) {
        PG8_STAGE(PG8_SB(0, 0), cB, voffB); PG8_STAGE(PG8_SB(0, 1), cB + hstep, voffB); PG8_STAGE(PG8_SA(0, 0), cA, voffA); PG8_STAGE(PG8_SA(0, 1), cA + hstep, voffA);
        if (wr == 1) PG8_BAR;
        PG8_WAIT_V(2); PG8_BAR;
        PG8_STAGE(PG8_SB(1, 0), cB + kstep, voffB); PG8_STAGE(PG8_SA(1, 0), cA + kstep, voffA); PG8_STAGE(PG8_SB(1, 1), cB + hstep + kstep, voffB);
        PG8_WAIT_V(6); PG8_BAR;
    } else {
        PG8_STAGE(PG8_SB(0, 0), cB, voffB); PG8_STAGE(PG8_SA(0, 0), cA, voffA); PG8_STAGE(PG8_SB(0, 1), cB + hstep, voffB); PG8_STAGE(PG8_SA(0, 1), cA + hstep, voffA);
        if (wr == 1) PG8_BAR;
        PG8_WAIT_V(4); PG8_BAR;
        PG8_STAGE(PG8_SB(1, 0), cB + kstep, voffB); PG8_STAGE(PG8_SA(1, 0), cA + kstep, voffA); PG8_STAGE(PG8_SB(1, 1), cB + hstep + kstep, voffB);
        PG8_WAIT_V(6); PG8_BAR;
    }
    for (;;) {
        const bool has_next = S.next(ui + 1, nxt);
        const char* nA = has_next ? (const char*)g.A + (size_t)nxt.pm * tstep : cA; const char* nB = has_next ? (const char*)g.Bt + (size_t)nxt.pn * tstep : cB;
        for (int t = 0; t < nt; t += 2) {
            const bool last = (t == nt - 2);
            const char* a1 = cA + (size_t)(t + 1) * kstep;
            const char* a2 = last ? nA : cA + (size_t)(t + 2) * kstep; const char* b2 = last ? nB : cB + (size_t)(t + 2) * kstep;
            const char* a3 = a2 + kstep; const char* b3 = b2 + kstep;
            if (last && has_next) S.a_ready(nxt);
            if constexpr (SP2) {
            PG8_LDB(B0, 0, 0); PG8_LDB(B1, 0, 1); PG8_SCHED; PG8_LDA(At, 0, 0); PG8_STAGE(PG8_SA(1, 1), a1 + hstep, voffA);
            PG8_WAIT_V(8); PG8_WAIT_L(0); PG8_BAR; PG8_MMA(0, 0, At, B0); PG8_MMA(0, 1, At, B1); PG8_BAR; PG8_SCHED;
            PG8_LDA(At, 0, 1); PG8_STAGE(PG8_SB(0, 0), b2, voffB); PG8_STAGE(PG8_SB(0, 1), b2 + hstep, voffB); PG8_STAGE(PG8_SA(0, 0), a2, voffA);
            PG8_WAIT_V(8); PG8_WAIT_L(0); PG8_BAR; PG8_MMA(1, 0, At, B0); PG8_MMA(1, 1, At, B1); PG8_BAR; PG8_SCHED;
            PG8_LDB(B0, 1, 0); PG8_LDB(B1, 1, 1); PG8_SCHED; PG8_LDA(At, 1, 0); PG8_STAGE(PG8_SA(0, 1), a2 + hstep, voffA);
            PG8_WAIT_V(8); PG8_WAIT_L(0); PG8_BAR; PG8_MMA(0, 0, At, B0); PG8_MMA(0, 1, At, B1); PG8_BAR; PG8_SCHED;
            PG8_LDA(At, 1, 1); PG8_STAGE(PG8_SB(1, 0), b3, voffB); PG8_STAGE(PG8_SB(1, 1), b3 + hstep, voffB); PG8_STAGE(PG8_SA(1, 0), a3, voffA);
            PG8_WAIT_V(8); PG8_WAIT_L(0); PG8_BAR; PG8_MMA(1, 0, At, B0); PG8_MMA(1, 1, At, B1); PG8_BAR; PG8_SCHED;
            } else {
            PG8_LDB(B0, 0, 0); PG8_SCHED; PG8_LDA(At, 0, 0); PG8_STAGE(PG8_SA(1, 1), a1 + hstep, voffA);
            PG8_WAIT_L(8); PG8_BAR; PG8_WAIT_L(0); PG8_MMA(0, 0, At, B0); PG8_BAR; PG8_SCHED;
            PG8_LDB(B1, 0, 1); PG8_STAGE(PG8_SB(0, 0), b2, voffB);
            PG8_BAR; PG8_WAIT_L(0); PG8_MMA(0, 1, At, B1); PG8_BAR;
            PG8_LDA(At, 0, 1); PG8_STAGE(PG8_SA(0, 0), a2, voffA);
            PG8_BAR; PG8_WAIT_L(0); PG8_MMA(1, 0, At, B0); PG8_BAR; PG8_SCHED;
            PG8_STAGE(PG8_SB(0, 1), b2 + hstep, voffB);
            PG8_WAIT_V(6); PG8_BAR; PG8_MMA(1, 1, At, B1); PG8_BAR;
            PG8_LDB(B0, 1, 0); PG8_SCHED; PG8_LDA(At, 1, 0); PG8_STAGE(PG8_SA(0, 1), a2 + hstep, voffA);
            PG8_WAIT_L(8); PG8_BAR; PG8_WAIT_L(0); PG8_MMA(0, 0, At, B0); PG8_BAR; PG8_SCHED;
            PG8_LDB(B1, 1, 1); PG8_STAGE(PG8_SB(1, 0), b3, voffB);
            PG8_BAR; PG8_WAIT_L(0); PG8_MMA(0, 1, At, B1); PG8_BAR;
            PG8_LDA(At, 1, 1); PG8_STAGE(PG8_SA(1, 0), a3, voffA);
            PG8_BAR; PG8_WAIT_L(0); PG8_MMA(1, 0, At, B0); PG8_BAR; PG8_SCHED;
            PG8_STAGE(PG8_SB(1, 1), b3 + hstep, voffB);
            PG8_WAIT_V(6); PG8_BAR; PG8_MMA(1, 1, At, B1); PG8_BAR;
            }
        }
        if constexpr (ALIGN_EPI) { if (wr == 0) PG8_BAR; }
        if constexpr (!Epi::AFTER_DRAIN) { E(acc, cur, wr, wc, fr, fq); S.done(cur); }
        if (!has_next) break;
#pragma unroll
        for (int a = 0; a < 2; ++a)
#pragma unroll
            for (int b = 0; b < 2; ++b)
#pragma unroll
                for (int m = 0; m < 4; ++m)
#pragma unroll
                    for (int n = 0; n < 2; ++n) acc[a][b][m][n] = (f32x4){0.f, 0.f, 0.f, 0.f};
        cur = nxt; cA = nA; cB = nB; ++ui;
        if constexpr (ALIGN_EPI) { if (wr == 1) PG8_BAR; }
    }
    PG8_WAIT_V(0);
    if constexpr (!ALIGN_EPI) { if (wr == 0) PG8_BAR; }
    PG8_BAR;
    if constexpr (Epi::AFTER_DRAIN) { E.fused(acc, cur, wr, wc, fr, fq, lds, wid, lane); S.done(cur); }
#undef PG8_SA
#undef PG8_SB
#undef PG8_STAGE
#undef PG8_LDA
#undef PG8_LDB
#undef PG8_MMA
#undef PG8_WAIT_V
#undef PG8_WAIT_L
#undef PG8_BAR
#undef PG8_SCHED
}
}

#define LAS __attribute__((address_space(3)))
typedef unsigned short bf16;
typedef unsigned v4u __attribute__((ext_vector_type(4)));
typedef unsigned v2u __attribute__((ext_vector_type(2)));
typedef float f32x4 __attribute__((ext_vector_type(4)));
typedef float f32x2 __attribute__((ext_vector_type(2)));
typedef short bf16x8 __attribute__((ext_vector_type(8)));
typedef short s16x4 __attribute__((ext_vector_type(4)));
using pg8::bflo; using pg8::bfhi; using pg8::cvt_pk_bf16;

#ifndef PROJ_ALIGN
#define PROJ_ALIGN true
#endif
#ifndef ONE_LAUNCH
#define ONE_LAUNCH 1
#endif
constexpr int DM = 1024, BATCH = 8, SEQ = 2048, M = BATCH * SEQ, NIN = 9216, DFF = 4096, DEPTH = 2;
constexpr float EPS = 1e-6f;
constexpr int NTHR = 512, NWAVES = 8;
constexpr int LDS_RING = 131072, LDS_BYTES = LDS_RING + 64;
constexpr size_t MiB = 1u << 20;
constexpr size_t WS_RSQ = 256 * 1024;
constexpr size_t WS_LB = 64 * 1024;
constexpr size_t WS_WIN = 1 * MiB, WS_WPA = 19 * MiB, WS_WPB = 21 * MiB, WS_WOUT = 23 * MiB;
constexpr size_t WS_B0 = 25 * MiB, BUFB = 32 * MiB;
constexpr size_t WS_END = WS_B0 + 8 * BUFB;
#define WS_BUF(i) (WS_B0 + (size_t)(i) * BUFB)
constexpr size_t WS_WUP = WS_BUF(6), WS_WDN = WS_BUF(6) + 8 * MiB;
constexpr int PH_PER_LAYER = 10, NPH = DEPTH * PH_PER_LAYER + 1;

__device__ __forceinline__ float wave_sum(float v) {
#pragma unroll
    for (int o = 1; o < 64; o <<= 1) v += __shfl_xor(v, o);
    return v;
}
__device__ __forceinline__ void transpose_item(const float* W, int K, int N, bf16* WT, LAS float* scr, int item, int lane) {
    const int nblk = N / 32, kb = item / nblk, nb = item % nblk, k0 = 64 * kb, n0 = 32 * nb;
#pragma unroll 8
    for (int i = 0; i < 32; ++i) { const int kk = 2 * i + (lane >> 5); scr[kk * 33 + (lane & 31)] = W[(size_t)(k0 + kk) * N + n0 + (lane & 31)]; }
    asm volatile("s_waitcnt lgkmcnt(0)" ::: "memory");
    const int c = lane & 7;
#pragma unroll
    for (int j = 0; j < 4; ++j) { const int n = (lane >> 3) + 8 * j; const LAS float* s = scr + (8 * c) * 33 + n;
        v4u o; o.x = cvt_pk_bf16(s[0 * 33], s[1 * 33]); o.y = cvt_pk_bf16(s[2 * 33], s[3 * 33]); o.z = cvt_pk_bf16(s[4 * 33], s[5 * 33]); o.w = cvt_pk_bf16(s[6 * 33], s[7 * 33]);
        *(v4u*)(WT + (size_t)(n0 + n) * K + k0 + 8 * c) = o; }
    asm volatile("s_waitcnt lgkmcnt(0)" ::: "memory");
}
__device__ __forceinline__ void convert_weight(const float* W, int K, int N, bf16* WT, LAS unsigned char* lds, int gw, int NGW, int wave, int lane) {
    LAS float* scr = (LAS float*)(lds + wave * 16384);
    const int nitems = (K / 64) * (N / 32);
    for (int it = gw; it < nitems; it += NGW) transpose_item(W, K, N, WT, scr, it, lane);
}
__device__ __forceinline__ void rms_row_bf16(const float* xrow, const float* gain, bf16* orow, int lane) {
    const f32x4* xr = (const f32x4*)xrow + lane; const f32x4* gr = (const f32x4*)gain + lane;
    f32x4 v[4]; float s = 0.f;
#pragma unroll
    for (int j = 0; j < 4; ++j) { v[j] = xr[64 * j]; s += (v[j].x * v[j].x + v[j].y * v[j].y) + (v[j].z * v[j].z + v[j].w * v[j].w); }
    const float rstd = rsqrtf(wave_sum(s) * (1.f / DM) + EPS);
    v2u* o8 = (v2u*)orow + lane;
#pragma unroll
    for (int j = 0; j < 4; ++j) { const f32x4 gg = gr[64 * j]; v2u o; o.x = cvt_pk_bf16(v[j].x * rstd * gg.x, v[j].y * rstd * gg.y); o.y = cvt_pk_bf16(v[j].z * rstd * gg.z, v[j].w * rstd * gg.w); o8[64 * j] = o; }
}
__device__ __forceinline__ void rms_row_f32(const float* xrow, const float* gain, float* orow, int lane) {
    const f32x4* xr = (const f32x4*)xrow + lane; const f32x4* gr = (const f32x4*)gain + lane;
    f32x4 v[4]; float s = 0.f;
#pragma unroll
    for (int j = 0; j < 4; ++j) { v[j] = xr[64 * j]; s += (v[j].x * v[j].x + v[j].y * v[j].y) + (v[j].z * v[j].z + v[j].w * v[j].w); }
    const float rstd = rsqrtf(wave_sum(s) * (1.f / DM) + EPS);
    f32x4* o = (f32x4*)orow + lane;
#pragma unroll
    for (int j = 0; j < 4; ++j) { const f32x4 gg = gr[64 * j]; o[64 * j] = v[j] * rstd * gg; }
}

__device__ __forceinline__ void sg_phase(LAS unsigned char* lds, bf16* ZU, const bf16* ZV, const float* ws_l, const float* bs_l, const float* sgn_l, int bid, int G) {
    int tid_l = threadIdx.x; asm volatile("" : "+v"(tid_l));
    const int tid = tid_l, lane = tid & 63, w = __builtin_amdgcn_readfirstlane(tid >> 6), g = lane >> 4, r16 = lane & 15;
    LAS unsigned char* VGT = lds; LAS unsigned char* WSL = lds + 34816;
    for (int item = bid; item < 1024; item += G) {
        const int gq = item & 7, bc = item >> 3, row0 = bc * 128, col0 = gq * 128;
        {
            const int s = tid >> 2, dq = tid & 3;
            v4u z[4]; float ss = 0.f;
#pragma unroll
            for (int e = 0; e < 4; ++e) { z[e] = *(const v4u*)(ZV + (size_t)(row0 + s) * 1024 + col0 + dq * 32 + 8 * e);
#pragma unroll
                for (int q = 0; q < 4; ++q) { const float a = bflo(z[e][q]), b = bfhi(z[e][q]); ss += a * a + b * b; } }
            ss += __shfl_xor(ss, 1); ss += __shfl_xor(ss, 2);
            const float rstd = rsqrtf(ss * (1.f / 128.f) + EPS);
#pragma unroll
            for (int e = 0; e < 4; ++e)
#pragma unroll
                for (int q = 0; q < 4; ++q) { const int d = dq * 32 + 8 * e + 2 * q;
                    const float a = bflo(z[e][q]) * rstd * sgn_l[col0 + d], b = bfhi(z[e][q]) * rstd * sgn_l[col0 + d + 1];
                    const unsigned pk = cvt_pk_bf16(a, b);
                    *(LAS unsigned short*)(VGT + d * 272 + s * 2) = (unsigned short)(pk & 0xffffu);
                    *(LAS unsigned short*)(VGT + (d + 1) * 272 + s * 2) = (unsigned short)(pk >> 16); }
            const int t = tid >> 2, sq = tid & 3; const float* wrow = ws_l + (size_t)gq * 16384 + t * 128 + sq * 32;
#pragma unroll
            for (int e = 0; e < 4; ++e) { const f32x4 a = *(const f32x4*)(wrow + 8 * e), b = *(const f32x4*)(wrow + 8 * e + 4);
                v4u o; o.x = cvt_pk_bf16(a.x, a.y); o.y = cvt_pk_bf16(a.z, a.w); o.z = cvt_pk_bf16(b.x, b.y); o.w = cvt_pk_bf16(b.z, b.w);
                *(LAS v4u*)(WSL + t * 272 + (sq * 32 + 8 * e) * 2) = o; }
        }
        __syncthreads();
        {
            bf16x8 bw[4];
#pragma unroll
            for (int ks = 0; ks < 4; ++ks) bw[ks] = *(const LAS bf16x8*)(WSL + (16 * w + r16) * 272 + (32 * ks + 8 * g) * 2);
            const int row = row0 + 16 * w + r16; const float bias = bs_l[gq * 128 + 16 * w + r16];
#pragma unroll
            for (int dt = 0; dt < 8; ++dt) { f32x4 acc = (f32x4){0.f, 0.f, 0.f, 0.f};
#pragma unroll
                for (int ks = 0; ks < 4; ++ks) { const bf16x8 a = *(const LAS bf16x8*)(VGT + (16 * dt + r16) * 272 + (32 * ks + 8 * g) * 2); acc = __builtin_amdgcn_mfma_f32_16x16x32_bf16(a, bw[ks], acc, 0, 0, 0); }
                v2u* p = (v2u*)(ZU + (size_t)row * 1024 + col0 + 16 * dt + 4 * g); const v2u zu = *p; v2u o;
                o.x = cvt_pk_bf16(bflo(zu.x) * (acc[0] + bias), bfhi(zu.x) * (acc[1] + bias)); o.y = cvt_pk_bf16(bflo(zu.y) * (acc[2] + bias), bfhi(zu.y) * (acc[3] + bias)); *p = o; }
        }
        __syncthreads();
    }
}

constexpr int HG_QH = 0, HG_KH = 17408, HG_KT = 34816, HG_VT = 53248, HG_EBM = 62464, HG_EBL = 62976, HG_IMG = 63488;
__device__ __forceinline__ bf16x8 hg_ld2(const LAS unsigned char* p) {
    const v2u lo = *(const LAS v2u*)p, hi = *(const LAS v2u*)(p + 32); return __builtin_bit_cast(bf16x8, (v4u){lo.x, lo.y, hi.x, hi.y});
}
__device__ __forceinline__ void hg_phase(LAS unsigned char* lds, const bf16* Qb, const bf16* LFfw, const bf16* LFbw, const bf16* IVb, bf16* Ofw, bf16* Obw, int bid, int G) {
    int tid_l = threadIdx.x; asm volatile("" : "+v"(tid_l));
    const int tid = tid_l, lane = tid & 63, w = __builtin_amdgcn_readfirstlane(tid >> 6), g = lane >> 4, r16 = lane & 15;
    const int vs = tid >> 3, vc = tid & 7;
    const int ek = 16 * w + r16, et0 = 16 * g;
    for (int item = bid; item < 256; item += G) {
        const int vh = (item >> 3) & 1, chain = (item & 7) | ((item >> 4) << 3), dir = chain & 1, h = (chain >> 1) & 7, b = chain >> 4;
        const bf16* LF = dir ? LFbw : LFfw; bf16* O = dir ? Obw : Ofw;
        const size_t colq = (size_t)h * 128 + ek, colv = (size_t)h * 128 + vh * 64;
#define HG_ROW(c, tau) ((size_t)(b * SEQ + (dir ? (SEQ - 1 - (64 * (c) + (tau))) : (64 * (c) + (tau)))))
        f32x4 S[8];
#pragma unroll
        for (int kt = 0; kt < 8; ++kt) S[kt] = (f32x4){0.f, 0.f, 0.f, 0.f};
        unsigned short lfr[16], qr[16]; v4u vr;
#define HG_LOAD(c) do { _Pragma("unroll") for (int j = 0; j < 16; ++j) { const size_t ro = HG_ROW(c, et0 + j) * 1024 + colq; lfr[j] = LF[ro]; qr[j] = Qb[ro]; } \
        vr = *(const v4u*)(IVb + HG_ROW(c, vs) * 1024 + colv + vc * 8); } while (0)
#define HG_EW(img) do { LAS unsigned char* I_ = lds + (img) * HG_IMG; float fj_[16]; float a_ = 0.f; \
        _Pragma("unroll") for (int j = 0; j < 16; ++j) { const float l_ = bflo((unsigned)lfr[j]); a_ += l_; fj_[j] = __builtin_amdgcn_exp2f(l_); } \
        const float l0_ = bflo((unsigned)lfr[0]); \
        const float t0_ = __shfl(a_, r16), t1_ = __shfl(a_, r16 + 16), t2_ = __shfl(a_, r16 + 32), t3_ = __shfl(a_, r16 + 48); \
        const float bm_ = t0_ + t1_, bl_ = (t0_ + t1_) + (t2_ + t3_); const float off_ = (g > 0 ? t0_ : 0.f) + (g > 1 ? t1_ : 0.f) + (g > 2 ? t2_ : 0.f) - bm_; \
          \
        float ek_ = __builtin_amdgcn_exp2f(fminf(-(off_ + a_), 115.f)); \
        unsigned kt_[8]; \
        _Pragma("unroll") for (int jp = 7; jp >= 0; --jp) { const float k1_ = (1.f - fj_[2 * jp + 1]) * ek_; ek_ *= fj_[2 * jp + 1]; const float k0_ = (1.f - fj_[2 * jp]) * ek_; ek_ *= fj_[2 * jp]; kt_[jp] = cvt_pk_bf16(k0_, k1_); } \
        float eq_ = __builtin_amdgcn_exp2f(fminf(off_ + l0_, 115.f)); \
        _Pragma("unroll") for (int jp = 0; jp < 8; ++jp) { if (jp > 0) eq_ *= fj_[2 * jp]; const float q0_ = bflo((unsigned)qr[2 * jp]) * eq_; eq_ *= fj_[2 * jp + 1]; const float q1_ = bflo((unsigned)qr[2 * jp + 1]) * eq_; \
            const unsigned qp_ = cvt_pk_bf16(q0_, q1_); \
            *(LAS unsigned short*)(I_ + HG_QH + (et0 + 2 * jp) * 272 + 2 * ek) = (unsigned short)(qp_ & 0xffffu); \
            *(LAS unsigned short*)(I_ + HG_QH + (et0 + 2 * jp + 1) * 272 + 2 * ek) = (unsigned short)(qp_ >> 16); \
            *(LAS unsigned short*)(I_ + HG_KH + (et0 + 2 * jp) * 272 + 2 * ek) = (unsigned short)(kt_[jp] & 0xffffu); \
            *(LAS unsigned short*)(I_ + HG_KH + (et0 + 2 * jp + 1) * 272 + 2 * ek) = (unsigned short)(kt_[jp] >> 16); } \
        *(LAS v4u*)(I_ + HG_KT + ek * 144 + 2 * et0) = (v4u){kt_[0], kt_[1], kt_[2], kt_[3]}; \
        *(LAS v4u*)(I_ + HG_KT + ek * 144 + 2 * et0 + 16) = (v4u){kt_[4], kt_[5], kt_[6], kt_[7]}; \
        if (g == 0) { *(LAS float*)(I_ + HG_EBM + 4 * ek) = __builtin_amdgcn_exp2f(bm_); *(LAS float*)(I_ + HG_EBL + 4 * ek) = __builtin_amdgcn_exp2f(bl_ - bm_); } \
        _Pragma("unroll") for (int e = 0; e < 4; ++e) { const unsigned u_ = vr[e]; \
            *(LAS unsigned short*)(I_ + HG_VT + (vc * 8 + 2 * e) * 144 + vs * 2) = (unsigned short)(u_ & 0xffffu); \
            *(LAS unsigned short*)(I_ + HG_VT + (vc * 8 + 2 * e + 1) * 144 + vs * 2) = (unsigned short)(u_ >> 16); } } while (0)
        HG_LOAD(0);
        HG_EW(0);
        HG_LOAD(1);
        __syncthreads();
        const int vt = w & 3, th = w >> 2;
        for (int c = 0; c < 32; ++c) {
#ifndef HG_SKIP_EW
            if (c + 1 < 32) { HG_EW((c + 1) & 1); if (c + 2 < 32) HG_LOAD(c + 2); }
#else
            if (c + 2 < 32) HG_LOAD(c + 2);
#endif
#ifndef HG_SKIP_MM
            {
                const LAS unsigned char* I = lds + (c & 1) * HG_IMG;
                const LAS unsigned char* QH = I + HG_QH; const LAS unsigned char* KH = I + HG_KH; const LAS unsigned char* KT = I + HG_KT; const LAS unsigned char* VT = I + HG_VT;
                const LAS float* EBM = (const LAS float*)(I + HG_EBM); const LAS float* EBL = (const LAS float*)(I + HG_EBL);
                bf16x8 As[4];
#pragma unroll
                for (int kt = 0; kt < 8; ++kt) S[kt] = S[kt] * *(const LAS f32x4*)(EBM + 16 * kt + 4 * g);
#pragma unroll
                for (int ks = 0; ks < 4; ++ks) { const unsigned x0 = cvt_pk_bf16(S[2 * ks][0], S[2 * ks][1]), x1 = cvt_pk_bf16(S[2 * ks][2], S[2 * ks][3]), x2 = cvt_pk_bf16(S[2 * ks + 1][0], S[2 * ks + 1][1]), x3 = cvt_pk_bf16(S[2 * ks + 1][2], S[2 * ks + 1][3]);
                    As[ks] = __builtin_bit_cast(bf16x8, (v4u){x0, x1, x2, x3}); }
                bf16x8 av[2];
#pragma unroll
                for (int ks = 0; ks < 2; ++ks) av[ks] = hg_ld2(VT + (16 * vt + r16) * 144 + (32 * ks + 4 * g) * 2);
#pragma unroll
                for (int ttl = 0; ttl < 2; ++ttl) { const int tt = th ? (1 + ttl) : (3 * ttl), trow = 16 * tt + r16;
                    bf16x8 bq[4];
#pragma unroll
                    for (int ks = 0; ks < 4; ++ks) bq[ks] = hg_ld2(QH + trow * 272 + (32 * ks + 4 * g) * 2);
                    f32x4 oacc = (f32x4){0.f, 0.f, 0.f, 0.f};
#pragma unroll
                    for (int ks = 0; ks < 4; ++ks) oacc = __builtin_amdgcn_mfma_f32_16x16x32_bf16(As[ks], bq[ks], oacc, 0, 0, 0);
#pragma unroll
                    for (int kp = 0; kp < 2; ++kp) if (kp <= (tt >> 1)) {
                        unsigned pw[4] = {0u, 0u, 0u, 0u};
#pragma unroll
                        for (int si = 0; si < 2; ++si) { const int st = 2 * kp + si; if (st <= tt) { f32x4 p = (f32x4){0.f, 0.f, 0.f, 0.f};
#pragma unroll
                                for (int ks = 0; ks < 4; ++ks) p = __builtin_amdgcn_mfma_f32_16x16x32_bf16(hg_ld2(KH + (16 * st + r16) * 272 + (32 * ks + 4 * g) * 2), bq[ks], p, 0, 0, 0);
                                if (st == tt) {
#pragma unroll
                                    for (int i = 0; i < 4; ++i) if (4 * g + i > r16) p[i] = 0.f; }
                                pw[2 * si] = cvt_pk_bf16(p[0], p[1]); pw[2 * si + 1] = cvt_pk_bf16(p[2], p[3]); } }
                        oacc = __builtin_amdgcn_mfma_f32_16x16x32_bf16(av[kp], __builtin_bit_cast(bf16x8, (v4u){pw[0], pw[1], pw[2], pw[3]}), oacc, 0, 0, 0);
                    }
                    *(v2u*)(O + HG_ROW(c, trow) * 1024 + colv + vt * 16 + 4 * g) = (v2u){cvt_pk_bf16(oacc[0], oacc[1]), cvt_pk_bf16(oacc[2], oacc[3])};
                }
#pragma unroll
                for (int kt = 0; kt < 8; ++kt) {
#pragma unroll
                    for (int ks = 0; ks < 2; ++ks) S[kt] = __builtin_amdgcn_mfma_f32_16x16x32_bf16(hg_ld2(KT + (16 * kt + r16) * 144 + (32 * ks + 4 * g) * 2), av[ks], S[kt], 0, 0, 0);
                    S[kt] = S[kt] * *(const LAS f32x4*)(EBL + 16 * kt + 4 * g); }
            }
#endif
            __syncthreads();
        }
#undef HG_ROW
#undef HG_LOAD
#undef HG_EW
    }
}

__device__ __forceinline__ void cb_row(bf16* Ofw, const bf16* Obw, const bf16* OG, const float* gain, size_t row, int lane) {
    const size_t o = row * 1024 + 16 * lane;
    v4u a[2], b[2], gq[2]; float s[16]; float ss = 0.f;
#pragma unroll
    for (int e = 0; e < 2; ++e) { a[e] = *(const v4u*)(Ofw + o + 8 * e); b[e] = *(const v4u*)(Obw + o + 8 * e); gq[e] = *(const v4u*)(OG + o + 8 * e); }
#pragma unroll
    for (int e = 0; e < 2; ++e)
#pragma unroll
        for (int q = 0; q < 4; ++q) { const float x = bflo(a[e][q]) + bflo(b[e][q]), y = bfhi(a[e][q]) + bfhi(b[e][q]); s[8 * e + 2 * q] = x; s[8 * e + 2 * q + 1] = y; ss += x * x + y * y; }
    ss += __shfl_xor(ss, 1); ss += __shfl_xor(ss, 2); ss += __shfl_xor(ss, 4);
    const float rstd = rsqrtf(ss * (1.f / 128.f) + EPS);
#pragma unroll
    for (int e = 0; e < 2; ++e) { v4u ov;
#pragma unroll
        for (int q = 0; q < 4; ++q) { const f32x2 gn = *(const f32x2*)(gain + 16 * lane + 8 * e + 2 * q);
            ov[q] = cvt_pk_bf16(s[8 * e + 2 * q] * rstd * gn.x * bflo(gq[e][q]), s[8 * e + 2 * q + 1] * rstd * gn.y * bfhi(gq[e][q])); }
        *(v4u*)(Ofw + o + 8 * e) = ov; }
}

#define XB_TMO      128
#define XB_XCNT(j)  (256  + 64 * (j))
#define XB_XSUB(j)  (1280 + 64 * (j))
#define XB_XGEN(j)  (2304 + 64 * (j))
#define XB_TOP      3328
#define XB_TOPGEN   3392
#define XCD_BAR_WORDS 3456
#define XB_SPIN_CAP (1u << 18)

__device__ __forceinline__ unsigned xb_ld(unsigned* p)              { return __hip_atomic_load(p, __ATOMIC_RELAXED, __HIP_MEMORY_SCOPE_AGENT); }
__device__ __forceinline__ unsigned xb_add(unsigned* p, unsigned v) { return __hip_atomic_fetch_add(p, v, __ATOMIC_RELAXED, __HIP_MEMORY_SCOPE_AGENT); }
__device__ __forceinline__ unsigned xb_xcc_id() { return (unsigned)__builtin_amdgcn_s_getreg((3 << 11) | 20) & 0xFu; }
#define XB_SPIN(cond, bar) do { unsigned _sp = 0; while (cond) { __builtin_amdgcn_s_sleep(1); \
    if ((++_sp & 255u) == 0u) { if (xb_ld(&(bar)[XB_TMO])) break; if (_sp > XB_SPIN_CAP) { atomicAdd(&(bar)[XB_TMO], 1u); break; } } } } while (0)

struct XcdBarrier {
    unsigned* bar; unsigned x;
    volatile LAS unsigned* st;
};

__device__ __forceinline__ XcdBarrier xcd_barrier_post(unsigned* bar, volatile LAS unsigned* st) {
    XcdBarrier b; b.bar = bar; b.x = xb_xcc_id(); b.st = st;
    if (threadIdx.x == 0) (void)xb_add(&bar[XB_XCNT(b.x)], 1u);
    return b;
}
__device__ __forceinline__ void xcd_barrier_complete(unsigned* bar, unsigned x, unsigned& nloc, unsigned& nx) {
    const unsigned G = gridDim.x * gridDim.y * gridDim.z;
    unsigned sum, cnt, mine, sp = 0u;
    for (;;) {
        sum = 0u; cnt = 0u; mine = 0u;
#pragma unroll
        for (unsigned j = 0; j < 16; ++j) { const unsigned c = xb_ld(&bar[XB_XCNT(j)]); sum += c; cnt += (c > 0u) ? 1u : 0u; mine = (j == x) ? c : mine; }
        if (sum == G) break;
        __builtin_amdgcn_s_sleep(1);
        if ((++sp & 255u) == 0u) { if (xb_ld(&bar[XB_TMO])) break; if (sp > XB_SPIN_CAP) { atomicAdd(&bar[XB_TMO], 1u); break; } }
    }
    nloc = mine > 0u ? mine : 1u; nx = cnt > 0u ? cnt : 1u;
}

__device__ __forceinline__ void xcd_barrier(const XcdBarrier& b) {
    asm volatile("s_waitcnt vmcnt(0)" ::: "memory");
    __syncthreads();
    if (threadIdx.x == 0) {
        unsigned* bar = b.bar;
        __builtin_amdgcn_s_waitcnt(0);
        unsigned nloc = b.st[0], nx = b.st[1];
        if (nloc == 0u) { xcd_barrier_complete(bar, b.x, nloc, nx); b.st[0] = nloc; b.st[1] = nx; }
        const unsigned old = xb_add(&bar[XB_XSUB(b.x)], 1u);
        const unsigned gen = old / nloc;
        if (old + 1u == (gen + 1u) * nloc) {
            __builtin_amdgcn_fence(__ATOMIC_RELEASE, "agent");
            asm volatile("s_waitcnt vmcnt(0)" ::: "memory");
            const unsigned og = xb_add(&bar[XB_TOP], 1u);
            const unsigned tg = og / nx;
            if (og + 1u == (tg + 1u) * nx) xb_add(&bar[XB_TOPGEN], 1u);
            else XB_SPIN(xb_ld(&bar[XB_TOPGEN]) == tg, bar);
            __builtin_amdgcn_fence(__ATOMIC_ACQUIRE, "agent");
            xb_add(&bar[XB_XGEN(b.x)], 1u);
            asm volatile("s_waitcnt vmcnt(0)" ::: "memory");
        } else {
            XB_SPIN(xb_ld(&bar[XB_XGEN(b.x)]) == gen, bar);
            __builtin_amdgcn_fence(__ATOMIC_ACQUIRE, "agent");
            asm volatile("s_waitcnt vmcnt(0)" ::: "memory");
        }
    }
    __syncthreads();
}

struct Args { const float* in[15]; float* out; unsigned char* ws; int ph_lo, ph_hi; };

__global__ void __launch_bounds__(NTHR, 2) fwd(Args a) {
    extern __shared__ __attribute__((aligned(16))) unsigned char lds_raw[];
    LAS unsigned char* lds = (LAS unsigned char*)lds_raw;
    const int G = gridDim.x, bid = blockIdx.x, NGW = G * NWAVES;
    volatile LAS unsigned* MISC = (volatile LAS unsigned*)(lds + LDS_RING);
    if (threadIdx.x < 16) MISC[threadIdx.x] = 0u;
    __syncthreads();
    XcdBarrier xbar; xbar.bar = (unsigned*)a.ws; xbar.x = 0; xbar.st = nullptr;
    if (a.ph_hi - a.ph_lo > 1) xbar = xcd_barrier_post((unsigned*)a.ws, MISC);
    const float* x = a.in[0]; const float* w_in = a.in[1]; const float* ln_mix = a.in[2]; const float* ln_mlp = a.in[3]; const float* sg_norm = a.in[4];
    const float* w_s = a.in[5]; const float* b_s = a.in[6]; const float* lb_logits = a.in[7]; const float* rec_norm = a.in[8];
    const float* w_pa = a.in[9]; const float* w_pb = a.in[10]; const float* w_out = a.in[11]; const float* w_up = a.in[12]; const float* w_down = a.in[13]; const float* ln_final = a.in[14];
#define BUF(i) ((bf16*)(ws + WS_BUF(i)))
    for (int p = a.ph_lo; p < a.ph_hi; ++p) {
        if (p > a.ph_lo) { asm volatile("s_waitcnt vmcnt(0)" ::: "memory");
#ifdef PROBE_SYNC
            const unsigned long long ts0 = __builtin_amdgcn_s_memrealtime();
#endif
            if (p == a.ph_lo + 1) cg::this_grid().sync(); else xcd_barrier(xbar);
#ifdef PROBE_SYNC
            { const unsigned long long ts1 = __builtin_amdgcn_s_memrealtime(); if (blockIdx.x == PROBE_SYNC_BLK && threadIdx.x == 0) { float* pp = (float*)(a.ws + 32768); const float prev = (p == a.ph_lo + 1) ? 0.f : *(volatile float*)pp; *pp = prev + (float)(ts1 - ts0) * (1.0f / PROBE_DIV); } }
#endif
            }
        int tid = threadIdx.x; asm volatile("" : "+v"(tid));
        const int lane = tid & 63, wave = __builtin_amdgcn_readfirstlane(tid >> 6), gw = bid * NWAVES + wave;
        unsigned char* ws = a.ws; asm volatile("" : "+s"(ws));
        float* out = a.out; asm volatile("" : "+s"(out));
        float* LB = (float*)(ws + WS_LB); float* RSQ = (float*)(ws + WS_RSQ);
        bf16* WIN = (bf16*)(ws + WS_WIN); bf16* WPA = (bf16*)(ws + WS_WPA); bf16* WPB = (bf16*)(ws + WS_WPB); bf16* WOUT = (bf16*)(ws + WS_WOUT);
        bf16* WUP = (bf16*)(ws + WS_WUP); bf16* WDN = (bf16*)(ws + WS_WDN);
#ifdef DBG_NRUN
        if (p == DBG_NRUN) {
            for (size_t i = (size_t)bid * NTHR + tid; i < (size_t)M * DM; i += (size_t)G * NTHR) { float s = (DBG_NRUN >= 8) ? out[i] : 0.f;
                for (int k = 0; k < 8; ++k) s += bflo((unsigned)((const bf16*)(ws + WS_BUF(k)))[i]); out[i] = s; }
            continue;
        }
        if (p > DBG_NRUN) continue;
#endif
        if (p == NPH - 1) {
            for (int m = gw; m < M; m += NGW) rms_row_f32(out + (size_t)m * DM, ln_final, out + (size_t)m * DM, lane);
            continue;
        }
        const int l = p / PH_PER_LAYER, j = p % PH_PER_LAYER;
#ifdef PROBE_PH
        unsigned long long t0p = 0; if ((PROBE_PH >> j) & 1) t0p = __builtin_amdgcn_s_memrealtime();
#endif
        const float* hin = (l == 0) ? x : out;
#ifndef PHASE_MASK
#define PHASE_MASK 0x7ff
#endif
        if (!((PHASE_MASK >> j) & 1)) continue;
        switch (j) {
        case 0: {
#ifdef DBG_FILL
            if (l == 0) { v4u* fp = (v4u*)(ws + WS_BUF(1)); const size_t n16 = (size_t)7 * BUFB / 16; for (size_t i = (size_t)bid * NTHR + tid; i < n16; i += (size_t)G * NTHR) fp[i] = (v4u){DBG_FILL, DBG_FILL, DBG_FILL, DBG_FILL}; }
#endif
            convert_weight(w_in + (size_t)l * DM * NIN, DM, NIN, WIN, lds, gw, NGW, wave, lane);
            convert_weight(w_pa + (size_t)l * DM * DM, DM, DM, WPA, lds, gw, NGW, wave, lane);
            convert_weight(w_pb + (size_t)l * DM * DM, DM, DM, WPB, lds, gw, NGW, wave, lane);
            convert_weight(w_out + (size_t)l * DM * DM, DM, DM, WOUT, lds, gw, NGW, wave, lane);
            for (int i = bid * NTHR + tid; i < 2 * DM; i += G * NTHR) { LB[i] = 0.f; LB[2 * DM + i] = 1.f / (1.f + __expf(lb_logits[i] - lb_logits[2 * DM + i])); }
            if (l == 0) {
                for (int i = bid * NTHR + tid; i < 3 * M; i += G * NTHR) RSQ[i] = 0.f;
                for (int m = gw; m < M; m += NGW) rms_row_bf16(hin + (size_t)m * DM, ln_mix + l * DM, BUF(0) + (size_t)m * DM, lane);
            }
            __syncthreads();
        } break;
        case 1: {
#define PROJ(MA, MB, split, sec0, bufi, lbp) { pg8::Gemm g{BUF(0), WIN + (size_t)(sec0) * DM * DM, M, 3 * DM, DM}; pg8::StaticOrder S; S.init(M, 3 * DM, G, bid); \
            pg8::EpiProj<MA, MB> E{BUF(bufi), (size_t)M * DM, lbp, (l == 0) ? (const float*)nullptr : (const float*)(RSQ + M), split}; pg8::gemm_phase<pg8::EpiProj<MA, MB>, pg8::StaticOrder, PROJ_ALIGN, true>(lds, g, S, E); }
            PROJ(0, 1, 2, 0, 1, LB) PROJ(2, 3, 2, 3, 4, LB + (size_t)l * 2 * DM)
        } break;
        case 2: sg_phase(lds, BUF(1), BUF(2), w_s + (size_t)l * 8 * 16384, b_s + (size_t)l * 1024, sg_norm + (size_t)l * DM, bid, G); break;
        case 3: hg_phase(lds, BUF(3), BUF(4), BUF(5), BUF(6), BUF(2), BUF(7), bid, G); break;
        case 4: {
            PROJ(3, 4, 1, 6, 3, LB)
        } break;
        case 5: {
            convert_weight(w_up + (size_t)l * DM * DFF, DM, DFF, WUP, lds, gw, NGW, wave, lane);
            convert_weight(w_down + (size_t)l * DFF * DM, DFF, DM, WDN, lds, gw, NGW, wave, lane);
            for (int m = gw; m < M; m += NGW) cb_row(BUF(2), BUF(7), BUF(3), rec_norm + (size_t)l * DM, (size_t)m, lane);
            __syncthreads();
        } break;
        case 6: {
            pg8::Gemm g{BUF(1), WPA, 2 * M, 2 * DM, DM}; pg8::PairOrder S; S.init(M, DM, G, bid); pg8::EpiGate E{BUF(4), BUF(5)};
            pg8::gemm_phase<pg8::EpiGate, pg8::PairOrder, true, true>(lds, g, S, E);
        } break;
        case 7: {
            pg8::Gemm g{BUF(4), WOUT, M, DM, DM}; pg8::StaticOrder S; S.init(M, DM, G, bid); pg8::EpiResid E{hin, out, BUF(0), ln_mlp + l * DM, RSQ + (size_t)(l == 0 ? 0 : 2) * M};

            pg8::gemm_phase<pg8::EpiResid, pg8::StaticOrder, false, true>(lds, g, S, E);
        } break;
        case 8: {
            pg8::Gemm g{BUF(0), WUP, M, DFF, DM}; pg8::StaticOrder S; S.init(M, DFF, G, bid); pg8::EpiRelu2 E{BUF(1), DFF, RSQ + (size_t)(l == 0 ? 0 : 2) * M};
            pg8::gemm_phase<pg8::EpiRelu2, pg8::StaticOrder, true, true>(lds, g, S, E);
        } break;
        case 9: {
            pg8::Gemm g{BUF(1), WDN, M, DM, DFF}; pg8::StaticOrder S; S.init(M, DM, G, bid); pg8::EpiResid E{out, out, (l == 0) ? BUF(0) : (bf16*)nullptr, ln_mix + DM, RSQ + M};
            pg8::gemm_phase<pg8::EpiResid, pg8::StaticOrder, false, true>(lds, g, S, E);
        } break;
        }
#ifdef PROBE_PH
        if ((PROBE_PH >> j) & 1) { asm volatile("s_waitcnt vmcnt(0)" ::: "memory"); __syncthreads(); const unsigned long long t1p = __builtin_amdgcn_s_memrealtime();
#ifdef PROBE_MAX
            if (tid == 0) atomicMax((unsigned*)(ws + 32768) + 1 + p, (unsigned)(t1p - t0p));
#else
            if (bid == 0 && tid == 0) atomicAdd((unsigned*)(ws + 32768) + 1 + p, (unsigned)(t1p - t0p));
#endif
        }
#endif
    }
#if defined(PROBE_PH)
    if (bid == 0 && threadIdx.x == 0) { asm volatile("s_waitcnt vmcnt(0)" ::: "memory"); unsigned s = 0; for (int q = 0; q < NPH; ++q) s += __hip_atomic_load((unsigned*)(a.ws + 32768) + 1 + q, __ATOMIC_RELAXED, __HIP_MEMORY_SCOPE_AGENT); a.out[0] = (float)s * (1.0f / PROBE_DIV); }
#elif defined(PROBE_SYNC)
    if (bid == 0 && threadIdx.x == 0) { asm volatile("s_waitcnt vmcnt(0)" ::: "memory"); a.out[0] = *(volatile float*)(a.ws + 32768); }
#endif
#undef BUF
}

extern "C" void kernel_launch(void* const* d_in, const int* in_sizes, int n_in, void* d_out, int out_size, void* d_ws, size_t ws_size, hipStream_t stream) {
    static int grid = 0;
    if (grid == 0) {
        if (n_in != 15 || out_size != M * DM || ws_size < WS_END) { fprintf(stderr, "kernel_launch: unexpected problem (n_in %d, out %d, ws %zu < %zu)\n", n_in, out_size, ws_size, (size_t)WS_END); grid = -1; return; }
        int dev = 0, cus = 0, per_cu = 0;
        hipGetDevice(&dev); hipDeviceGetAttribute(&cus, hipDeviceAttributeMultiprocessorCount, dev);
        if (hipFuncSetAttribute((const void*)fwd, hipFuncAttributeMaxDynamicSharedMemorySize, LDS_BYTES) != hipSuccess) { fprintf(stderr, "kernel_launch: hipFuncSetAttribute failed\n"); grid = -1; return; }
        if (hipOccupancyMaxActiveBlocksPerMultiprocessor(&per_cu, (const void*)fwd, NTHR, LDS_BYTES) != hipSuccess || per_cu < 1) { fprintf(stderr, "kernel_launch: occupancy query says %d\n", per_cu); per_cu = 1; }
        (void)hipGetLastError();
        grid = cus;
    }
    if (grid < 0) return;
#if defined(PROBE_PH)
    (void)hipMemsetAsync((char*)d_ws + 32768, 0, 512, stream);
#endif
    (void)hipMemsetAsync(d_ws, 0, 16384, stream);
    Args a{};
    for (int i = 0; i < 15; ++i) a.in[i] = (const float*)d_in[i];
    a.out = (float*)d_out; a.ws = (unsigned char*)d_ws;
#if ONE_LAUNCH
    a.ph_lo = 0; a.ph_hi = NPH;
    void* args[] = {&a};
    hipError_t e = hipLaunchCooperativeKernel((const void*)fwd, dim3(grid), dim3(NTHR), args, LDS_BYTES, stream);
    if (e != hipSuccess) fprintf(stderr, "cooperative launch failed: %s (grid %d)\n", hipGetErrorString(e), grid);
#else
    for (int p = 0; p < NPH; ++p) { a.ph_lo = p; a.ph_hi = p + 1; hipLaunchKernelGGL(fwd, dim3(grid), dim3(NTHR), LDS_BYTES, stream, a); }
#endif
}
```

```cpp
#define ONE_LAUNCH 1
#include <hip/hip_runtime.h>
#include <hip/hip_cooperative_groups.h>
#include <cstdio>
#include <cstdint>
namespace cg = cooperative_groups;
namespace pg8 {
#define PG8_LAS __attribute__((address_space(3)))
typedef unsigned short bf16_t;
typedef short bf16x8 __attribute__((ext_vector_type(8)));
typedef float f32x4 __attribute__((ext_vector_type(4)));
typedef unsigned u32x4 __attribute__((ext_vector_type(4)));
constexpr int BM = 256, BK = 64, HALF = 128, HTB = HALF * BK * 2  , STAGE_BYTES = 8 * HTB, NXCD = 8, WGM = 8;

__host__ __device__ __forceinline__ int lds_byte(int r, int c) { const int st = (r >> 4) * 2 + (c >> 5), rr = r & 15, cc = c & 31, ob = rr * 64 + cc * 2; return st * 1024 + (ob ^ (((ob >> 9) & 1) << 5)); }
__host__ __device__ __forceinline__ void stage_rc(int b, int& R, int& C) { const int st = b / 1024, sb = b % 1024, swz = sb ^ (((sb >> 9) & 1) << 5); R = (st >> 1) * 16 + swz / 64; C = (st & 1) * 32 + (swz % 64) / 2; }
__host__ __device__ __forceinline__ int perm32(int rho) { const int n = rho >> 4, i = rho & 15; return 8 * (i >> 2) + 4 * n + (i & 3); }

struct Unit { int pm, pn; };
struct Gemm { const bf16_t* A; const bf16_t* Bt; int M, N, K; };

struct StaticOrder {
    int nM, nN, nwg, G, c;
    __host__ __device__ void init(int M, int N, int G_, int c_) { nM = M / BM; nN = N / BM; nwg = nM * nN; G = G_; c = c_; }
    __host__ __device__ bool next(int i, Unit& u) const {
        const long L = (long)i * G + c; if (L >= nwg) return false;
        int wgid = (int)L; { const int q = nwg / NXCD, r = nwg % NXCD, xcd = wgid % NXCD, off = wgid / NXCD; wgid = (xcd < r ? xcd * (q + 1) : r * (q + 1) + (xcd - r) * q) + off; }
        const int nig = WGM * nN, gid = wgid / nig, fm = gid * WGM, gsz = (nM - fm) < WGM ? (nM - fm) : WGM;
        u.pm = fm + ((wgid % nig) % gsz); u.pn = (wgid % nig) / gsz; return true;
    }
    __device__ __forceinline__ void a_ready(const Unit&) const {}
    __device__ __forceinline__ void done(const Unit&) const {}
};

typedef float cvt_f32x2_t __attribute__((ext_vector_type(2)));
typedef __bf16 cvt_bf16x2_t __attribute__((ext_vector_type(2)));
__device__ __forceinline__ unsigned cvt_pk_bf16(float lo, float hi) { cvt_f32x2_t v = {lo, hi}; cvt_bf16x2_t b = __builtin_convertvector(v, cvt_bf16x2_t); return __builtin_bit_cast(unsigned, b); }
typedef float f32x2 __attribute__((ext_vector_type(2)));
__device__ __forceinline__ f32x2 gelu_pk(f32x2 v) {
    const f32x2 av = __builtin_elementwise_abs(v), d = av * 0.2316418882f + 1.0f;
    f32x2 t; t.x = __builtin_amdgcn_rcpf(d.x); t.y = __builtin_amdgcn_rcpf(d.y);
    f32x2 q = t * 0.5307027145f + (-0.7265760135f); q = q * t + 0.7107068705f; q = q * t + (-0.142248368f); q = q * t + 0.127414796f; q = q * t;
    const f32x2 s = (v * v) * (-0.72134752044f);
    f32x2 e; e.x = __builtin_amdgcn_exp2f(s.x); e.y = __builtin_amdgcn_exp2f(s.y);
    const f32x2 m = v * (q * e), r = v - m;
    f32x2 o; o.x = v.x < 0.f ? m.x : r.x; o.y = v.y < 0.f ? m.y : r.y; return o;
}
__device__ __forceinline__ float bflo(unsigned u) { return __builtin_bit_cast(float, u << 16); }
__device__ __forceinline__ float bfhi(unsigned u) { return __builtin_bit_cast(float, u & 0xffff0000u); }
__device__ __forceinline__ float sigm(float z) { return __builtin_amdgcn_rcpf(1.0f + __expf(-z)); }
template <int MA, int MB> struct EpiProj {
    static constexpr bool PERM = true, AFTER_DRAIN = false;
    bf16_t* out0; size_t sec_stride; const float* lb; const float* rowsq; int split;
    template <int MODE> __device__ __forceinline__ void run(const f32x4 (&acc)[2][2][4][2], bf16_t* base, const float* lbrow, int row0, int col0) const {
#pragma unroll
        for (int ai = 0; ai < 2; ++ai)
#pragma unroll
            for (int m = 0; m < 4; ++m) { bf16_t* rowp = base + (size_t)(row0 + ai * HALF + m * 16) * 1024 + col0;
                const float rs = rowsq ? rsqrtf(rowsq[row0 + ai * HALF + m * 16] * (1.0f / 1024.0f) + 1e-6f) : 1.0f;
#pragma unroll
                for (int bj = 0; bj < 2; ++bj) { f32x4 v[2] = {acc[ai][bj][m][0] * rs, acc[ai][bj][m][1] * rs};
#pragma unroll
                    for (int n = 0; n < 2; ++n) {
                        if (MODE == 0) { f32x2 a = gelu_pk((f32x2){v[n][0], v[n][1]}), b = gelu_pk((f32x2){v[n][2], v[n][3]}); v[n] = (f32x4){a.x, a.y, b.x, b.y}; }
                        else if (MODE == 2) { const f32x4 lbv = *(const f32x4*)(lbrow + bj * HALF + 4 * n);
#pragma unroll
                            for (int e = 0; e < 4; ++e) { const float l = lbv[e]; const float f = l + (1.0f - l) * sigm(v[n][e]); v[n][e] = __log2f(f); }
                        } else if (MODE == 3) {
#pragma unroll
                            for (int e = 0; e < 4; ++e) v[n][e] = v[n][e] * sigm(v[n][e]);
                        } else if (MODE == 4) {
#pragma unroll
                            for (int e = 0; e < 4; ++e) v[n][e] = sigm(v[n][e]);
                        }
                    }
                    u32x4 w; w.x = cvt_pk_bf16(v[0][0], v[0][1]); w.y = cvt_pk_bf16(v[0][2], v[0][3]); w.z = cvt_pk_bf16(v[1][0], v[1][1]); w.w = cvt_pk_bf16(v[1][2], v[1][3]);
                    *(u32x4*)(rowp + bj * HALF) = w; } }
    }
    __device__ __forceinline__ void operator()(const f32x4 (&acc)[2][2][4][2], const Unit& u, int wr, int wc, int fr, int fq) const {
        const int colt = u.pn * BM, sec = colt >> 10;
        bf16_t* base = out0 + (size_t)sec * sec_stride;
        const int col0 = (colt & 1023) + wc * 32 + 8 * fq, row0 = u.pm * BM + wr * 64 + fr;
        const float* lbrow = lb + sec * 1024 + col0;
        if (sec < split) run<MA>(acc, base, lbrow, row0, col0); else run<MB>(acc, base, lbrow, row0, col0);
    }
};
struct EpiGate {
    static constexpr bool PERM = true, AFTER_DRAIN = false;
    bf16_t* T; const bf16_t* gate2;
    __device__ __forceinline__ void operator()(const f32x4 (&acc)[2][2][4][2], const Unit& u, int wr, int wc, int fr, int fq) const {
        const bool second = u.pm >= 64;
        const int col0 = (u.pn & 3) * BM + wc * 32 + 8 * fq, row0 = (u.pm & 63) * BM + wr * 64 + fr;
        const bf16_t* gate = second ? gate2 : T;
#pragma unroll
        for (int ai = 0; ai < 2; ++ai)
#pragma unroll
            for (int m = 0; m < 4; ++m) { asm volatile("" ::: "memory"); __builtin_amdgcn_sched_barrier(0); const size_t ro = (size_t)(row0 + ai * HALF + m * 16) * 1024 + col0;
#pragma unroll
                for (int bj = 0; bj < 2; ++bj) {
                    const u32x4 gv = *(const u32x4*)(gate + ro + bj * HALF);
                    u32x4 av = (u32x4){0u, 0u, 0u, 0u}; if (second) av = *(const u32x4*)(T + ro + bj * HALF);
                    const f32x4 v0 = acc[ai][bj][m][0], v1 = acc[ai][bj][m][1];
                    u32x4 w;
                    w.x = cvt_pk_bf16(bflo(av.x) + bflo(gv.x) * v0[0], bfhi(av.x) + bfhi(gv.x) * v0[1]);
                    w.y = cvt_pk_bf16(bflo(av.y) + bflo(gv.y) * v0[2], bfhi(av.y) + bfhi(gv.y) * v0[3]);
                    w.z = cvt_pk_bf16(bflo(av.z) + bflo(gv.z) * v1[0], bfhi(av.z) + bfhi(gv.z) * v1[1]);
                    w.w = cvt_pk_bf16(bflo(av.w) + bflo(gv.w) * v1[2], bfhi(av.w) + bfhi(gv.w) * v1[3]);
                    *(u32x4*)(T + ro + bj * HALF) = w; } }
    }
};
struct PairOrder {
    StaticOrder S;
    __device__ void init(int M_, int N_, int G_, int c_) { S.init(M_, N_, G_, c_); }
    __device__ bool next(int i, Unit& u) const { if (!S.next(i >> 1, u)) return false; if (i & 1) { u.pm += 64; u.pn += 4; } return true; }
    __device__ __forceinline__ void a_ready(const Unit&) const {}
    __device__ __forceinline__ void done(const Unit&) const {}
};
struct EpiResid {
    static constexpr bool PERM = true, AFTER_DRAIN = false;
    const float* base; float* out; bf16_t* xg; const float* gain; float* rowsq;
    __device__ __forceinline__ void operator()(const f32x4 (&acc)[2][2][4][2], const Unit& u, int wr, int wc, int fr, int fq) const {
        const int col0 = u.pn * BM + wc * 32 + 8 * fq, row0 = u.pm * BM + wr * 64 + fr;
#pragma unroll
        for (int ai = 0; ai < 2; ++ai)
#pragma unroll
            for (int m = 0; m < 4; ++m) { asm volatile("" ::: "memory"); __builtin_amdgcn_sched_barrier(0); const int row = row0 + ai * HALF + m * 16; const size_t ro = (size_t)row * 1024 + col0; float ss = 0.f;
#pragma unroll
                for (int bj = 0; bj < 2; ++bj) { f32x4 h[2];
#pragma unroll
                    for (int n = 0; n < 2; ++n) { const f32x4 b = *(const f32x4*)(base + ro + bj * HALF + 4 * n); h[n] = b + acc[ai][bj][m][n]; *(f32x4*)(out + ro + bj * HALF + 4 * n) = h[n];
                        ss += (h[n][0] * h[n][0] + h[n][1] * h[n][1]) + (h[n][2] * h[n][2] + h[n][3] * h[n][3]); }
                    if (xg) { const f32x4 g0 = *(const f32x4*)(gain + col0 + bj * HALF), g1 = *(const f32x4*)(gain + col0 + bj * HALF + 4);
                        u32x4 w; w.x = cvt_pk_bf16(h[0][0] * g0[0], h[0][1] * g0[1]); w.y = cvt_pk_bf16(h[0][2] * g0[2], h[0][3] * g0[3]); w.z = cvt_pk_bf16(h[1][0] * g1[0], h[1][1] * g1[1]); w.w = cvt_pk_bf16(h[1][2] * g1[2], h[1][3] * g1[3]);
                        *(u32x4*)(xg + ro + bj * HALF) = w; } }
                if (xg) { ss += __shfl_xor(ss, 16); ss += __shfl_xor(ss, 32); if (fq == 0) atomicAdd(rowsq + row, ss); } }
    }
};
struct EpiRelu2 {
    static constexpr bool PERM = true, AFTER_DRAIN = false;
    bf16_t* out; int ldc; const float* rowsq;
    __device__ __forceinline__ void operator()(const f32x4 (&acc)[2][2][4][2], const Unit& u, int wr, int wc, int fr, int fq) const {
        const int col0 = u.pn * BM + wc * 32 + 8 * fq, row0 = u.pm * BM + wr * 64 + fr;
#pragma unroll
        for (int ai = 0; ai < 2; ++ai)
#pragma unroll
            for (int m = 0; m < 4; ++m) { asm volatile("" ::: "memory"); __builtin_amdgcn_sched_barrier(0); bf16_t* rowp = out + (size_t)(row0 + ai * HALF + m * 16) * ldc + col0;
                const float rs = rsqrtf(rowsq[row0 + ai * HALF + m * 16] * (1.0f / 1024.0f) + 1e-6f);
#pragma unroll
                for (int bj = 0; bj < 2; ++bj) { f32x4 v0 = acc[ai][bj][m][0] * rs, v1 = acc[ai][bj][m][1] * rs;
#pragma unroll
                    for (int e = 0; e < 4; ++e) { const float a = fmaxf(v0[e], 0.f), b = fmaxf(v1[e], 0.f); v0[e] = a * a; v1[e] = b * b; }
                    u32x4 w; w.x = cvt_pk_bf16(v0[0], v0[1]); w.y = cvt_pk_bf16(v0[2], v0[3]); w.z = cvt_pk_bf16(v1[0], v1[1]); w.w = cvt_pk_bf16(v1[2], v1[3]);
                    *(u32x4*)(rowp + bj * HALF) = w; } }
    }
};
template <class Epi, class Sched, bool ALIGN_EPI = false, bool SP2 = false>
__device__ __forceinline__ void gemm_phase(PG8_LAS unsigned char* lds, const Gemm g, const Sched& S, const Epi& E) {
    int tid_l = threadIdx.x; asm volatile("" : "+v"(tid_l));
    const int tid = tid_l, wid = __builtin_amdgcn_readfirstlane(tid >> 6), lane = tid & 63, wr = wid >> 2, wc = wid & 3, fr = lane & 15, fq = lane >> 4;
    const int K = g.K, nt = K / BK;
    unsigned voffA[2], voffB[2];
#pragma unroll
    for (int i = 0; i < 2; ++i) { int R, C; stage_rc(tid * 16 + i * 8192, R, C); const int Rb = Epi::PERM ? ((R & ~31) + perm32(R & 31)) : R;
        voffA[i] = (unsigned)(R * K + C) * 2u; voffB[i] = (unsigned)(Rb * K + C) * 2u; }
    const size_t kstep = (size_t)(BK * 2);
    const size_t hstep = (size_t)HALF * K * 2;
    const size_t tstep = 2 * hstep;
    const unsigned ldsw = (unsigned)wid * 1024u;
    const int aoff = lds_byte(wr * 64 + fr, fq * 8), boff = lds_byte(wc * 32 + fr, fq * 8);
#define PG8_SA(b, h) (((b) * 2 + (h)) * HTB)
#define PG8_SB(b, h) ((4 + (b) * 2 + (h)) * HTB)
#define PG8_STAGE(bufoff, gbase, voff) do { _Pragma("unroll") for (int _i = 0; _i < 2; ++_i) \
        __builtin_amdgcn_global_load_lds((const unsigned*)((const char*)(gbase) + (voff)[_i]), (PG8_LAS unsigned*)(lds + (bufoff) + ldsw + _i * 8192), 16, 0, 0); } while (0)
#define PG8_LDA(dst, b, h) do { _Pragma("unroll") for (int m = 0; m < 4; ++m) _Pragma("unroll") for (int k = 0; k < 2; ++k) dst[m][k] = *(const PG8_LAS bf16x8*)(lds + PG8_SA(b, h) + aoff + m * 2048 + k * 1024); } while (0)
#define PG8_LDB(dst, b, h) do { _Pragma("unroll") for (int n = 0; n < 2; ++n) _Pragma("unroll") for (int k = 0; k < 2; ++k) dst[n][k] = *(const PG8_LAS bf16x8*)(lds + PG8_SB(b, h) + boff + n * 2048 + k * 1024); } while (0)
#define PG8_MMA(ai, bj, At, Bt) do { __builtin_amdgcn_s_setprio(1); _Pragma("unroll") for (int m = 0; m < 4; ++m) _Pragma("unroll") for (int n = 0; n < 2; ++n) _Pragma("unroll") for (int k = 0; k < 2; ++k) \
        acc[ai][bj][m][n] = __builtin_amdgcn_mfma_f32_16x16x32_bf16(Bt[n][k], At[m][k], acc[ai][bj][m][n], 0, 0, 0); __builtin_amdgcn_s_setprio(0); } while (0)
#define PG8_WAIT_V(n) asm volatile("s_waitcnt vmcnt(" #n ")" ::: "memory")
#define PG8_WAIT_L(n) asm volatile("s_waitcnt lgkmcnt(" #n ")" ::: "memory")
#define PG8_BAR __builtin_amdgcn_s_barrier()
#define PG8_SCHED __builtin_amdgcn_sched_barrier(0)
    Unit cur, nxt; int ui = 0;
    if (!S.next(0, cur)) return;
    f32x4 acc[2][2][4][2];
#pragma unroll
    for (int a = 0; a < 2; ++a)
#pragma unroll
        for (int b = 0; b < 2; ++b)
#pragma unroll
            for (int m = 0; m < 4; ++m)
#pragma unroll
                for (int n = 0; n < 2; ++n) acc[a][b][m][n] = (f32x4){0.f, 0.f, 0.f, 0.f};
    bf16x8 At[4][2], B0[2][2], B1[2][2];
    const char* cA = (const char*)g.A + (size_t)cur.pm * tstep; const char* cB = (const char*)g.Bt + (size_t)cur.pn * tstep;
    S.a_ready(cur);
    if constexpr (SP2) {
        PG8_STAGE(PG8_SB(0, 0), cB, voffB); PG8_STAGE(PG8_SB(0, 1), cB + hstep, voffB); PG8_STAGE(PG8_SA(0, 0), cA, voffA); PG8_STAGE(PG8_SA(0, 1), cA + hstep, voffA);
        if (wr == 1) PG8_BAR;
        PG8_WAIT_V(2); PG8_BAR;
        PG8_STAGE(PG8_SB(1, 0), cB + kstep, voffB); PG8_STAGE(PG8_SA(1, 0), cA + kstep, voffA); PG8_STAGE(PG8_SB(1, 1), cB + hstep + kstep, voffB);
        PG8_WAIT_V(6); PG8_BAR;
    } else {
        PG8_STAGE(PG8_SB(0, 0), cB, voffB); PG8_STAGE(PG8_SA(0, 0), cA, voffA); PG8_STAGE(PG8_SB(0, 1), cB + hstep, voffB); PG8_STAGE(PG8_SA(0, 1), cA + hstep, voffA);
        if (wr == 1) PG8_BAR;
        PG8_WAIT_V(4); PG8_BAR;
        PG8_STAGE(PG8_SB(1, 0), cB + kstep, voffB); PG8_STAGE(PG8_SA(1, 0), cA + kstep, voffA); PG8_STAGE(PG8_SB(1, 1), cB + hstep + kstep, voffB);
        PG8_WAIT_V(6); PG8_BAR;
    }
    for (;;) {
        const bool has_next = S.next(ui + 1, nxt);
        const char* nA = has_next ? (const char*)g.A + (size_t)nxt.pm * tstep : cA; const char* nB = has_next ? (const char*)g.Bt + (size_t)nxt.pn * tstep : cB;
        for (int t = 0; t < nt; t += 2) {
            const bool last = (t == nt - 2);
            const char* a1 = cA + (size_t)(t + 1) * kstep;
            const char* a2 = last ? nA : cA + (size_t)(t + 2) * kstep; const char* b2 = last ? nB : cB + (size_t)(t + 2) * kstep;
            const char* a3 = a2 + kstep; const char* b3 = b2 + kstep;
            if (last && has_next) S.a_ready(nxt);
            if constexpr (SP2) {
            PG8_LDB(B0, 0, 0); PG8_LDB(B1, 0, 1); PG8_SCHED; PG8_LDA(At, 0, 0); PG8_STAGE(PG8_SA(1, 1), a1 + hstep, voffA);
            PG8_WAIT_V(8); PG8_WAIT_L(0); PG8_BAR; PG8_MMA(0, 0, At, B0); PG8_MMA(0, 1, At, B1); PG8_BAR; PG8_SCHED;
            PG8_LDA(At, 0, 1); PG8_STAGE(PG8_SB(0, 0), b2, voffB); PG8_STAGE(PG8_SB(0, 1), b2 + hstep, voffB); PG8_STAGE(PG8_SA(0, 0), a2, voffA);
            PG8_WAIT_V(8); PG8_WAIT_L(0); PG8_BAR; PG8_MMA(1, 0, At, B0); PG8_MMA(1, 1, At, B1); PG8_BAR; PG8_SCHED;
            PG8_LDB(B0, 1, 0); PG8_LDB(B1, 1, 1); PG8_SCHED; PG8_LDA(At, 1, 0); PG8_STAGE(PG8_SA(0, 1), a2 + hstep, voffA);
            PG8_WAIT_V(8); PG8_WAIT_L(0); PG8_BAR; PG8_MMA(0, 0, At, B0); PG8_MMA(0, 1, At, B1); PG8_BAR; PG8_SCHED;
            PG8_LDA(At, 1, 1); PG8_STAGE(PG8_SB(1, 0), b3, voffB); PG8_STAGE(PG8_SB(1, 1), b3 + hstep, voffB); PG8_STAGE(PG8_SA(1, 0), a3, voffA);
            PG8_WAIT_V(8); PG8_WAIT_L(0); PG8_BAR; PG8_MMA(1, 0, At, B0); PG8_MMA(1, 1, At, B1); PG8_BAR; PG8_SCHED;
            } else {
            PG8_LDB(B0, 0, 0); PG8_SCHED; PG8_LDA(At, 0, 0); PG8_STAGE(PG8_SA(1, 1), a1 + hstep, voffA);
            PG8_WAIT_L(8); PG8_BAR; PG8_WAIT_L(0); PG8_MMA(0, 0, At, B0); PG8_BAR; PG8_SCHED;
            PG8_LDB(B1, 0, 1); PG8_STAGE(PG8_SB(0, 0), b2, voffB);
            PG8_BAR; PG8_WAIT_L(0); PG8_MMA(0, 1, At, B1); PG8_BAR;
            PG8_LDA(At, 0, 1); PG8_STAGE(PG8_SA(0, 0), a2, voffA);
            PG8_BAR; PG8_WAIT_L(0); PG8_MMA(1, 0, At, B0); PG8_BAR; PG8_SCHED;
            PG8_STAGE(PG8_SB(0, 1), b2 + hstep, voffB);
            PG8_WAIT_V(6); PG8_BAR; PG8_MMA(1, 1, At, B1); PG8_BAR;
            PG8_LDB(B0, 1, 0); PG8_SCHED; PG8_LDA(At, 1, 0); PG8_STAGE(PG8_SA(0, 1), a2 + hstep, voffA);
            PG8_WAIT_L(8); PG8_BAR; PG8_WAIT_L(0); PG8_MMA(0, 0, At, B0); PG8_BAR; PG8_SCHED;
            PG8_LDB(B1, 1, 1); PG8_STAGE(PG8_SB(1, 0), b3, voffB);
            PG8_BAR; PG8_WAIT_L(0); PG8_MMA(0, 1, At, B1); PG8_BAR;
            PG8_LDA(At, 1, 1); PG8_STAGE(PG8_SA(1, 0), a3, voffA);
            PG8_BAR; PG8_WAIT_L(0); PG8_MMA(1, 0, At, B0); PG8_BAR; PG8_SCHED;
            PG8_STAGE(PG8_SB(1, 1), b3 + hstep, voffB);
            PG8_WAIT_V(6); PG8_BAR; PG8_MMA(1, 1, At, B1); PG8_BAR;
            }
        }
        if constexpr (ALIGN_EPI) { if (wr == 0) PG8_BAR; }
        if constexpr (!Epi::AFTER_DRAIN) { E(acc, cur, wr, wc, fr, fq); S.done(cur); }
        if (!has_next) break;
#pragma unroll
        for (int a = 0; a < 2; ++a)
#pragma unroll
            for (int b = 0; b < 2; ++b)
#pragma unroll
                for (int m = 0; m < 4; ++m)
#pragma unroll
                    for (int n = 0; n < 2; ++n) acc[a][b][m][n] = (f32x4){0.f, 0.f, 0.f, 0.f};
        cur = nxt; cA = nA; cB = nB; ++ui;
        if constexpr (ALIGN_EPI) { if (wr == 1) PG8_BAR; }
    }
    PG8_WAIT_V(0);
    if constexpr (!ALIGN_EPI) { if (wr == 0) PG8_BAR; }
    PG8_BAR;
    if constexpr (Epi::AFTER_DRAIN) { E.fused(acc, cur, wr, wc, fr, fq, lds, wid, lane); S.done(cur); }
#undef PG8_SA
#undef PG8_SB
#undef PG8_STAGE
#undef PG8_LDA
#undef PG8_LDB
#undef PG8_MMA
#undef PG8_WAIT_V
#undef PG8_WAIT_L
#undef PG8_BAR
#undef PG8_SCHED
}
}

#define LAS __attribute__((address_space(3)))
typedef unsigned short bf16;
typedef unsigned v4u __attribute__((ext_vector_type(4)));
typedef unsigned v2u __attribute__((ext_vector_type(2)));
typedef float f32x4 __attribute__((ext_vector_type(4)));
typedef float f32x2 __attribute__((ext_vector_type(2)));
typedef short bf16x8 __attribute__((ext_vector_type(8)));
typedef short s16x4 __attribute__((ext_vector_type(4)));
using pg8::bflo; using pg8::bfhi; using pg8::cvt_pk_bf16;

#ifndef PROJ_ALIGN
#define PROJ_ALIGN true
#endif
#ifndef ONE_LAUNCH
#define ONE_LAUNCH 1
#endif
constexpr int DM = 1024, BATCH = 8, SEQ = 2048, M = BATCH * SEQ, NIN = 9216, DFF = 4096, DEPTH = 2;
constexpr float EPS = 1e-6f;
constexpr int NTHR = 512, NWAVES = 8;
constexpr int LDS_RING = 131072, LDS_BYTES = LDS_RING + 64;
constexpr size_t MiB = 1u << 20;
constexpr size_t WS_RSQ = 256 * 1024;
constexpr size_t WS_LB = 64 * 1024;
constexpr size_t WS_WIN = 1 * MiB, WS_WPA = 19 * MiB, WS_WPB = 21 * MiB, WS_WOUT = 23 * MiB;
constexpr size_t WS_B0 = 25 * MiB, BUFB = 32 * MiB;
constexpr size_t WS_END = WS_B0 + 8 * BUFB;
#define WS_BUF(i) (WS_B0 + (size_t)(i) * BUFB)
constexpr size_t WS_WUP = WS_BUF(6), WS_WDN = WS_BUF(6) + 8 * MiB;
constexpr int PH_PER_LAYER = 10, NPH = DEPTH * PH_PER_LAYER + 1;

__device__ __forceinline__ float wave_sum(float v) {
#pragma unroll
    for (int o = 1; o < 64; o <<= 1) v += __shfl_xor(v, o);
    return v;
}
__device__ __forceinline__ void transpose_item(const float* W, int K, int N, bf16* WT, LAS float* scr, int item, int lane) {
    const int nblk = N / 32, kb = item / nblk, nb = item % nblk, k0 = 64 * kb, n0 = 32 * nb;
#pragma unroll 8
    for (int i = 0; i < 32; ++i) { const int kk = 2 * i + (lane >> 5); scr[kk * 33 + (lane & 31)] = W[(size_t)(k0 + kk) * N + n0 + (lane & 31)]; }
    asm volatile("s_waitcnt lgkmcnt(0)" ::: "memory");
    const int c = lane & 7;
#pragma unroll
    for (int j = 0; j < 4; ++j) { const int n = (lane >> 3) + 8 * j; const LAS float* s = scr + (8 * c) * 33 + n;
        v4u o; o.x = cvt_pk_bf16(s[0 * 33], s[1 * 33]); o.y = cvt_pk_bf16(s[2 * 33], s[3 * 33]); o.z = cvt_pk_bf16(s[4 * 33], s[5 * 33]); o.w = cvt_pk_bf16(s[6 * 33], s[7 * 33]);
        *(v4u*)(WT + (size_t)(n0 + n) * K + k0 + 8 * c) = o; }
    asm volatile("s_waitcnt lgkmcnt(0)" ::: "memory");
}
__device__ __forceinline__ void convert_weight(const float* W, int K, int N, bf16* WT, LAS unsigned char* lds, int gw, int NGW, int wave, int lane) {
    LAS float* scr = (LAS float*)(lds + wave * 16384);
    const int nitems = (K / 64) * (N / 32);
    for (int it = gw; it < nitems; it += NGW) transpose_item(W, K, N, WT, scr, it, lane);
}
__device__ __forceinline__ void rms_row_bf16(const float* xrow, const float* gain, bf16* orow, int lane) {
    const f32x4* xr = (const f32x4*)xrow + lane; const f32x4* gr = (const f32x4*)gain + lane;
    f32x4 v[4]; float s = 0.f;
#pragma unroll
    for (int j = 0; j < 4; ++j) { v[j] = xr[64 * j]; s += (v[j].x * v[j].x + v[j].y * v[j].y) + (v[j].z * v[j].z + v[j].w * v[j].w); }
    const float rstd = rsqrtf(wave_sum(s) * (1.f / DM) + EPS);
    v2u* o8 = (v2u*)orow + lane;
#pragma unroll
    for (int j = 0; j < 4; ++j) { const f32x4 gg = gr[64 * j]; v2u o; o.x = cvt_pk_bf16(v[j].x * rstd * gg.x, v[j].y * rstd * gg.y); o.y = cvt_pk_bf16(v[j].z * rstd * gg.z, v[j].w * rstd * gg.w); o8[64 * j] = o; }
}
__device__ __forceinline__ void rms_row_f32(const float* xrow, const float* gain, float* orow, int lane) {
    const f32x4* xr = (const f32x4*)xrow + lane; const f32x4* gr = (const f32x4*)gain + lane;
    f32x4 v[4]; float s = 0.f;
#pragma unroll
    for (int j = 0; j < 4; ++j) { v[j] = xr[64 * j]; s += (v[j].x * v[j].x + v[j].y * v[j].y) + (v[j].z * v[j].z + v[j].w * v[j].w); }
    const float rstd = rsqrtf(wave_sum(s) * (1.f / DM) + EPS);
    f32x4* o = (f32x4*)orow + lane;
#pragma unroll
    for (int j = 0; j < 4; ++j) { const f32x4 gg = gr[64 * j]; o[64 * j] = v[j] * rstd * gg; }
}

__device__ __forceinline__ void sg_phase(LAS unsigned char* lds, bf16* ZU, const bf16* ZV, const float* ws_l, const float* bs_l, const float* sgn_l, int bid, int G) {
    int tid_l = threadIdx.x; asm volatile("" : "+v"(tid_l));
    const int tid = tid_l, lane = tid & 63, w = __builtin_amdgcn_readfirstlane(tid >> 6), g = lane >> 4, r16 = lane & 15;
    LAS unsigned char* VGT = lds; LAS unsigned char* WSL = lds + 34816;
    for (int item = bid; item < 1024; item += G) {
        const int gq = item & 7, bc = item >> 3, row0 = bc * 128, col0 = gq * 128;
        {
            const int s = tid >> 2, dq = tid & 3;
            v4u z[4]; float ss = 0.f;
#pragma unroll
            for (int e = 0; e < 4; ++e) { z[e] = *(const v4u*)(ZV + (size_t)(row0 + s) * 1024 + col0 + dq * 32 + 8 * e);
#pragma unroll
                for (int q = 0; q < 4; ++q) { const float a = bflo(z[e][q]), b = bfhi(z[e][q]); ss += a * a + b * b; } }
            ss += __shfl_xor(ss, 1); ss += __shfl_xor(ss, 2);
            const float rstd = rsqrtf(ss * (1.f / 128.f) + EPS);
#pragma unroll
            for (int e = 0; e < 4; ++e)
#pragma unroll
                for (int q = 0; q < 4; ++q) { const int d = dq * 32 + 8 * e + 2 * q;
                    const float a = bflo(z[e][q]) * rstd * sgn_l[col0 + d], b = bfhi(z[e][q]) * rstd * sgn_l[col0 + d + 1];
                    const unsigned pk = cvt_pk_bf16(a, b);
                    *(LAS unsigned short*)(VGT + d * 272 + s * 2) = (unsigned short)(pk & 0xffffu);
                    *(LAS unsigned short*)(VGT + (d + 1) * 272 + s * 2) = (unsigned short)(pk >> 16); }
            const int t = tid >> 2, sq = tid & 3; const float* wrow = ws_l + (size_t)gq * 16384 + t * 128 + sq * 32;
#pragma unroll
            for (int e = 0; e < 4; ++e) { const f32x4 a = *(const f32x4*)(wrow + 8 * e), b = *(const f32x4*)(wrow + 8 * e + 4);
                v4u o; o.x = cvt_pk_bf16(a.x, a.y); o.y = cvt_pk_bf16(a.z, a.w); o.z = cvt_pk_bf16(b.x, b.y); o.w = cvt_pk_bf16(b.z, b.w);
                *(LAS v4u*)(WSL + t * 272 + (sq * 32 + 8 * e) * 2) = o; }
        }
        __syncthreads();
        {
            bf16x8 bw[4];
#pragma unroll
            for (int ks = 0; ks < 4; ++ks) bw[ks] = *(const LAS bf16x8*)(WSL + (16 * w + r16) * 272 + (32 * ks + 8 * g) * 2);
            const int row = row0 + 16 * w + r16; const float bias = bs_l[gq * 128 + 16 * w + r16];
#pragma unroll
            for (int dt = 0; dt < 8; ++dt) { f32x4 acc = (f32x4){0.f, 0.f, 0.f, 0.f};
#pragma unroll
                for (int ks = 0; ks < 4; ++ks) { const bf16x8 a = *(const LAS bf16x8*)(VGT + (16 * dt + r16) * 272 + (32 * ks + 8 * g) * 2); acc = __builtin_amdgcn_mfma_f32_16x16x32_bf16(a, bw[ks], acc, 0, 0, 0); }
                v2u* p = (v2u*)(ZU + (size_t)row * 1024 + col0 + 16 * dt + 4 * g); const v2u zu = *p; v2u o;
                o.x = cvt_pk_bf16(bflo(zu.x) * (acc[0] + bias), bfhi(zu.x) * (acc[1] + bias)); o.y = cvt_pk_bf16(bflo(zu.y) * (acc[2] + bias), bfhi(zu.y) * (acc[3] + bias)); *p = o; }
        }
        __syncthreads();
    }
}

constexpr int HG_QH = 0, HG_KH = 17408, HG_KT = 34816, HG_VT = 53248, HG_EBM = 62464, HG_EBL = 62976, HG_IMG = 63488;
__device__ __forceinline__ bf16x8 hg_ld2(const LAS unsigned char* p) {
    const v2u lo = *(const LAS v2u*)p, hi = *(const LAS v2u*)(p + 32); return __builtin_bit_cast(bf16x8, (v4u){lo.x, lo.y, hi.x, hi.y});
}
__device__ __forceinline__ bf16x8 hg_ld2s(const LAS unsigned char* row, int e0) {
    const v2u lo = *(const LAS v2u*)(row + 2 * e0), hi = *(const LAS v2u*)(row + 2 * (e0 ^ 16)); return __builtin_bit_cast(bf16x8, (v4u){lo.x, lo.y, hi.x, hi.y});
}
__device__ __forceinline__ void hg_phase(LAS unsigned char* lds, const bf16* Qb, const bf16* LFfw, const bf16* LFbw, const bf16* IVb, bf16* Ofw, bf16* Obw, int bid, int G) {
    int tid_l = threadIdx.x; asm volatile("" : "+v"(tid_l));
    const int tid = tid_l, lane = tid & 63, w = __builtin_amdgcn_readfirstlane(tid >> 6), g = lane >> 4, r16 = lane & 15;
    const int vs = tid >> 3, vc = tid & 7;
    const int kp = lane & 7, tg = lane >> 3, ek = 16 * w + 2 * kp, et0 = 8 * tg, ekz = ek ^ (16 * (tg >> 1));
    for (int item = bid; item < 256; item += G) {
        const int vh = (item >> 3) & 1, chain = (item & 7) | ((item >> 4) << 3), dir = chain & 1, h = (chain >> 1) & 7, b = chain >> 4;
        const bf16* LF = dir ? LFbw : LFfw; bf16* O = dir ? Obw : Ofw;
        const size_t colq = (size_t)h * 128 + ek, colv = (size_t)h * 128 + vh * 64;
#define HG_ROW(c, tau) ((size_t)(b * SEQ + (dir ? (SEQ - 1 - (64 * (c) + (tau))) : (64 * (c) + (tau)))))
        f32x4 S[8];
#pragma unroll
        for (int kt = 0; kt < 8; ++kt) S[kt] = (f32x4){0.f, 0.f, 0.f, 0.f};
        unsigned lfr[8], qr[8]; v4u vr;
#define HG_LOAD(c) do { _Pragma("unroll") for (int j = 0; j < 8; ++j) { const size_t ro = HG_ROW(c, et0 + j) * 1024 + colq; lfr[j] = *(const unsigned*)(LF + ro); qr[j] = *(const unsigned*)(Qb + ro); } \
        vr = *(const v4u*)(IVb + HG_ROW(c, vs) * 1024 + colv + vc * 8); } while (0)
#define HG_EW(img) do { LAS unsigned char* I_ = lds + (img) * HG_IMG; float f0_[8], f1_[8]; float a0_ = 0.f, a1_ = 0.f; \
        _Pragma("unroll") for (int j = 0; j < 8; ++j) { const float l0_ = bflo(lfr[j]), l1_ = bfhi(lfr[j]); a0_ += l0_; a1_ += l1_; f0_[j] = __builtin_amdgcn_exp2f(l0_); f1_[j] = __builtin_amdgcn_exp2f(l1_); } \
        float i0_ = a0_, i1_ = a1_; { float u0_ = __shfl_up(i0_, 8), u1_ = __shfl_up(i1_, 8); if (tg >= 1) { i0_ += u0_; i1_ += u1_; } \
            u0_ = __shfl_up(i0_, 16); u1_ = __shfl_up(i1_, 16); if (tg >= 2) { i0_ += u0_; i1_ += u1_; } u0_ = __shfl_up(i0_, 32); u1_ = __shfl_up(i1_, 32); if (tg >= 4) { i0_ += u0_; i1_ += u1_; } } \
        const float bm0_ = __shfl(i0_, kp + 24), bm1_ = __shfl(i1_, kp + 24), bl0_ = __shfl(i0_, kp + 56), bl1_ = __shfl(i1_, kp + 56); \
        const float off0_ = i0_ - a0_ - bm0_, off1_ = i1_ - a1_ - bm1_; \
        float ek0_ = __builtin_amdgcn_exp2f(fminf(-(off0_ + a0_), 115.f)), ek1_ = __builtin_amdgcn_exp2f(fminf(-(off1_ + a1_), 115.f)); \
        unsigned kw_[8]; \
        _Pragma("unroll") for (int j = 7; j >= 0; --j) { const float k0_ = (1.f - f0_[j]) * ek0_, k1_ = (1.f - f1_[j]) * ek1_; ek0_ *= f0_[j]; ek1_ *= f1_[j]; kw_[j] = cvt_pk_bf16(k0_, k1_); } \
        float eq0_ = __builtin_amdgcn_exp2f(fminf(off0_ + bflo(lfr[0]), 115.f)), eq1_ = __builtin_amdgcn_exp2f(fminf(off1_ + bfhi(lfr[0]), 115.f)); \
        _Pragma("unroll") for (int j = 0; j < 8; ++j) { if (j > 0) { eq0_ *= f0_[j]; eq1_ *= f1_[j]; } \
            *(LAS unsigned*)(I_ + HG_QH + (et0 + j) * 272 + 2 * ekz) = cvt_pk_bf16(bflo(qr[j]) * eq0_, bfhi(qr[j]) * eq1_); \
            *(LAS unsigned*)(I_ + HG_KH + (et0 + j) * 272 + 2 * ekz) = kw_[j]; } \
        *(LAS v4u*)(I_ + HG_KT + ek * 144 + 2 * et0) = (v4u){(kw_[0] & 0xffffu) | (kw_[1] << 16), (kw_[2] & 0xffffu) | (kw_[3] << 16), (kw_[4] & 0xffffu) | (kw_[5] << 16), (kw_[6] & 0xffffu) | (kw_[7] << 16)}; \
        *(LAS v4u*)(I_ + HG_KT + (ek + 1) * 144 + 2 * et0) = (v4u){(kw_[0] >> 16) | (kw_[1] & 0xffff0000u), (kw_[2] >> 16) | (kw_[3] & 0xffff0000u), (kw_[4] >> 16) | (kw_[5] & 0xffff0000u), (kw_[6] >> 16) | (kw_[7] & 0xffff0000u)}; \
        if (tg == 0) { *(LAS f32x2*)(I_ + HG_EBM + 4 * ek) = (f32x2){__builtin_amdgcn_exp2f(bm0_), __builtin_amdgcn_exp2f(bm1_)}; *(LAS f32x2*)(I_ + HG_EBL + 4 * ek) = (f32x2){__builtin_amdgcn_exp2f(bl0_ - bm0_), __builtin_amdgcn_exp2f(bl1_ - bm1_)}; } \
        _Pragma("unroll") for (int e = 0; e < 4; ++e) { const unsigned u_ = vr[e]; \
            *(LAS unsigned short*)(I_ + HG_VT + (vc * 8 + 2 * e) * 144 + vs * 2) = (unsigned short)(u_ & 0xffffu); \
            *(LAS unsigned short*)(I_ + HG_VT + (vc * 8 + 2 * e + 1) * 144 + vs * 2) = (unsigned short)(u_ >> 16); } } while (0)
        HG_LOAD(0);
        HG_EW(0);
        HG_LOAD(1);
        __syncthreads();
        const int vt = w & 3, th = w >> 2;
        for (int c = 0; c < 32; ++c) {
#ifndef HG_SKIP_EW
            if (c + 1 < 32) { HG_EW((c + 1) & 1); if (c + 2 < 32) HG_LOAD(c + 2); }
#else
            if (c + 2 < 32) HG_LOAD(c + 2);
#endif
#ifndef HG_SKIP_MM
            {
                const LAS unsigned char* I = lds + (c & 1) * HG_IMG;
                const LAS unsigned char* QH = I + HG_QH; const LAS unsigned char* KH = I + HG_KH; const LAS unsigned char* KT = I + HG_KT; const LAS unsigned char* VT = I + HG_VT;
                const LAS float* EBM = (const LAS float*)(I + HG_EBM); const LAS float* EBL = (const LAS float*)(I + HG_EBL);
                bf16x8 As[4];
#pragma unroll
                for (int kt = 0; kt < 8; ++kt) S[kt] = S[kt] * *(const LAS f32x4*)(EBM + 16 * kt + 4 * g);
#pragma unroll
                for (int ks = 0; ks < 4; ++ks) { const unsigned x0 = cvt_pk_bf16(S[2 * ks][0], S[2 * ks][1]), x1 = cvt_pk_bf16(S[2 * ks][2], S[2 * ks][3]), x2 = cvt_pk_bf16(S[2 * ks + 1][0], S[2 * ks + 1][1]), x3 = cvt_pk_bf16(S[2 * ks + 1][2], S[2 * ks + 1][3]);
                    As[ks] = __builtin_bit_cast(bf16x8, (v4u){x0, x1, x2, x3}); }
                bf16x8 avp[2], avn[2];
#pragma unroll
                for (int ks = 0; ks < 2; ++ks) { avp[ks] = hg_ld2(VT + (16 * vt + r16) * 144 + (32 * ks + 4 * g) * 2); avn[ks] = *(const LAS bf16x8*)(VT + (16 * vt + r16) * 144 + (32 * ks + 8 * g) * 2); }
#pragma unroll
                for (int ttl = 0; ttl < 2; ++ttl) { const int tt = th ? (1 + ttl) : (3 * ttl), trow = 16 * tt + r16; const LAS unsigned char* qrow = QH + trow * 272;
                    f32x4 oacc = (f32x4){0.f, 0.f, 0.f, 0.f};
#pragma unroll
                    for (int ks = 0; ks < 4; ++ks) oacc = __builtin_amdgcn_mfma_f32_16x16x32_bf16(As[ks], hg_ld2s(qrow, (32 * ks + 4 * g) ^ (16 * tt)), oacc, 0, 0, 0);
                    bf16x8 bq[4];
#pragma unroll
                    for (int ks = 0; ks < 4; ++ks) bq[ks] = *(const LAS bf16x8*)(qrow + 2 * ((32 * ks + 8 * g) ^ (16 * tt)));
#pragma unroll
                    for (int kp2 = 0; kp2 < 2; ++kp2) if (kp2 <= (tt >> 1)) {
                        unsigned pw[4] = {0u, 0u, 0u, 0u};
#pragma unroll
                        for (int si = 0; si < 2; ++si) { const int st = 2 * kp2 + si; if (st <= tt) { f32x4 p = (f32x4){0.f, 0.f, 0.f, 0.f};
#pragma unroll
                                for (int ks = 0; ks < 4; ++ks) p = __builtin_amdgcn_mfma_f32_16x16x32_bf16(*(const LAS bf16x8*)(KH + (16 * st + r16) * 272 + 2 * ((32 * ks + 8 * g) ^ (16 * st))), bq[ks], p, 0, 0, 0);
                                if (st == tt) {
#pragma unroll
                                    for (int i = 0; i < 4; ++i) if (4 * g + i > r16) p[i] = 0.f; }
                                pw[2 * si] = cvt_pk_bf16(p[0], p[1]); pw[2 * si + 1] = cvt_pk_bf16(p[2], p[3]); } }
                        oacc = __builtin_amdgcn_mfma_f32_16x16x32_bf16(avp[kp2], __builtin_bit_cast(bf16x8, (v4u){pw[0], pw[1], pw[2], pw[3]}), oacc, 0, 0, 0);
                    }
                    *(v2u*)(O + HG_ROW(c, trow) * 1024 + colv + vt * 16 + 4 * g) = (v2u){cvt_pk_bf16(oacc[0], oacc[1]), cvt_pk_bf16(oacc[2], oacc[3])};
                }
#pragma unroll
                for (int kt = 0; kt < 8; ++kt) {
#pragma unroll
                    for (int ks = 0; ks < 2; ++ks) S[kt] = __builtin_amdgcn_mfma_f32_16x16x32_bf16(*(const LAS bf16x8*)(KT + (16 * kt + r16) * 144 + (32 * ks + 8 * g) * 2), avn[ks], S[kt], 0, 0, 0);
                    S[kt] = S[kt] * *(const LAS f32x4*)(EBL + 16 * kt + 4 * g); }
            }
#endif
            __syncthreads();
        }
#undef HG_ROW
#undef HG_LOAD
#undef HG_EW
    }
}

__device__ __forceinline__ void cb_row(bf16* Ofw, const bf16* Obw, const bf16* OG, const float* gain, size_t row, int lane) {
    const size_t o = row * 1024 + 16 * lane;
    v4u a[2], b[2], gq[2]; float s[16]; float ss = 0.f;
#pragma unroll
    for (int e = 0; e < 2; ++e) { a[e] = *(const v4u*)(Ofw + o + 8 * e); b[e] = *(const v4u*)(Obw + o + 8 * e); gq[e] = *(const v4u*)(OG + o + 8 * e); }
#pragma unroll
    for (int e = 0; e < 2; ++e)
#pragma unroll
        for (int q = 0; q < 4; ++q) { const float x = bflo(a[e][q]) + bflo(b[e][q]), y = bfhi(a[e][q]) + bfhi(b[e][q]); s[8 * e + 2 * q] = x; s[8 * e + 2 * q + 1] = y; ss += x * x + y * y; }
    ss += __shfl_xor(ss, 1); ss += __shfl_xor(ss, 2); ss += __shfl_xor(ss, 4);
    const float rstd = rsqrtf(ss * (1.f / 128.f) + EPS);
#pragma unroll
    for (int e = 0; e < 2; ++e) { v4u ov;
#pragma unroll
        for (int q = 0; q < 4; ++q) { const f32x2 gn = *(const f32x2*)(gain + 16 * lane + 8 * e + 2 * q);
            ov[q] = cvt_pk_bf16(s[8 * e + 2 * q] * rstd * gn.x * bflo(gq[e][q]), s[8 * e + 2 * q + 1] * rstd * gn.y * bfhi(gq[e][q])); }
        *(v4u*)(Ofw + o + 8 * e) = ov; }
}

#define XB_TMO      128
#define XB_XCNT(j)  (256  + 64 * (j))
#define XB_XSUB(j)  (1280 + 64 * (j))
#define XB_XGEN(j)  (2304 + 64 * (j))
#define XB_TOP      3328
#define XB_TOPGEN   3392
#define XCD_BAR_WORDS 3456
#define XB_SPIN_CAP (1u << 18)

__device__ __forceinline__ unsigned xb_ld(unsigned* p)              { return __hip_atomic_load(p, __ATOMIC_RELAXED, __HIP_MEMORY_SCOPE_AGENT); }
__device__ __forceinline__ unsigned xb_add(unsigned* p, unsigned v) { return __hip_atomic_fetch_add(p, v, __ATOMIC_RELAXED, __HIP_MEMORY_SCOPE_AGENT); }
__device__ __forceinline__ unsigned xb_xcc_id() { return (unsigned)__builtin_amdgcn_s_getreg((3 << 11) | 20) & 0xFu; }
#define XB_SPIN(cond, bar) do { unsigned _sp = 0; while (cond) { __builtin_amdgcn_s_sleep(1); \
    if ((++_sp & 255u) == 0u) { if (xb_ld(&(bar)[XB_TMO])) break; if (_sp > XB_SPIN_CAP) { atomicAdd(&(bar)[XB_TMO], 1u); break; } } } } while (0)

struct XcdBarrier {
    unsigned* bar; unsigned x;
    volatile LAS unsigned* st;
};

__device__ __forceinline__ XcdBarrier xcd_barrier_post(unsigned* bar, volatile LAS unsigned* st) {
    XcdBarrier b; b.bar = bar; b.x = xb_xcc_id(); b.st = st;
    if (threadIdx.x == 0) (void)xb_add(&bar[XB_XCNT(b.x)], 1u);
    return b;
}
__device__ __forceinline__ void xcd_barrier_complete(unsigned* bar, unsigned x, unsigned& nloc, unsigned& nx) {
    const unsigned G = gridDim.x * gridDim.y * gridDim.z;
    unsigned sum, cnt, mine, sp = 0u;
    for (;;) {
        sum = 0u; cnt = 0u; mine = 0u;
#pragma unroll
        for (unsigned j = 0; j < 16; ++j) { const unsigned c = xb_ld(&bar[XB_XCNT(j)]); sum += c; cnt += (c > 0u) ? 1u : 0u; mine = (j == x) ? c : mine; }
        if (sum == G) break;
        __builtin_amdgcn_s_sleep(1);
        if ((++sp & 255u) == 0u) { if (xb_ld(&bar[XB_TMO])) break; if (sp > XB_SPIN_CAP) { atomicAdd(&bar[XB_TMO], 1u); break; } }
    }
    nloc = mine > 0u ? mine : 1u; nx = cnt > 0u ? cnt : 1u;
}

__device__ __forceinline__ void xcd_barrier(const XcdBarrier& b) {
    asm volatile("s_waitcnt vmcnt(0)" ::: "memory");
    __syncthreads();
    if (threadIdx.x == 0) {
        unsigned* bar = b.bar;
        __builtin_amdgcn_s_waitcnt(0);
        unsigned nloc = b.st[0], nx = b.st[1];
        if (nloc == 0u) { xcd_barrier_complete(bar, b.x, nloc, nx); b.st[0] = nloc; b.st[1] = nx; }
        const unsigned old = xb_add(&bar[XB_XSUB(b.x)], 1u);
        const unsigned gen = old / nloc;
        if (old + 1u == (gen + 1u) * nloc) {
            __builtin_amdgcn_fence(__ATOMIC_RELEASE, "agent");
            asm volatile("s_waitcnt vmcnt(0)" ::: "memory");
            const unsigned og = xb_add(&bar[XB_TOP], 1u);
            const unsigned tg = og / nx;
            if (og + 1u == (tg + 1u) * nx) xb_add(&bar[XB_TOPGEN], 1u);
            else XB_SPIN(xb_ld(&bar[XB_TOPGEN]) == tg, bar);
            __builtin_amdgcn_fence(__ATOMIC_ACQUIRE, "agent");
            xb_add(&bar[XB_XGEN(b.x)], 1u);
            asm volatile("s_waitcnt vmcnt(0)" ::: "memory");
        } else {
            XB_SPIN(xb_ld(&bar[XB_XGEN(b.x)]) == gen, bar);
            __builtin_amdgcn_fence(__ATOMIC_ACQUIRE, "agent");
            asm volatile("s_waitcnt vmcnt(0)" ::: "memory");
        }
    }
    __syncthreads();
}

struct Args { const float* in[15]; float* out; unsigned char* ws; int ph_lo, ph_hi; };

__global__ void __launch_bounds__(NTHR, 2) fwd(Args a) {
    extern __shared__ __attribute__((aligned(16))) unsigned char lds_raw[];
    LAS unsigned char* lds = (LAS unsigned char*)lds_raw;
    const int G = gridDim.x, bid = blockIdx.x, NGW = G * NWAVES;
    volatile LAS unsigned* MISC = (volatile LAS unsigned*)(lds + LDS_RING);
    if (threadIdx.x < 16) MISC[threadIdx.x] = 0u;
    __syncthreads();
    XcdBarrier xbar; xbar.bar = (unsigned*)a.ws; xbar.x = 0; xbar.st = nullptr;
    if (a.ph_hi - a.ph_lo > 1) xbar = xcd_barrier_post((unsigned*)a.ws, MISC);
    const float* x = a.in[0]; const float* w_in = a.in[1]; const float* ln_mix = a.in[2]; const float* ln_mlp = a.in[3]; const float* sg_norm = a.in[4];
    const float* w_s = a.in[5]; const float* b_s = a.in[6]; const float* lb_logits = a.in[7]; const float* rec_norm = a.in[8];
    const float* w_pa = a.in[9]; const float* w_pb = a.in[10]; const float* w_out = a.in[11]; const float* w_up = a.in[12]; const float* w_down = a.in[13]; const float* ln_final = a.in[14];
#define BUF(i) ((bf16*)(ws + WS_BUF(i)))
    for (int p = a.ph_lo; p < a.ph_hi; ++p) {
        if (p > a.ph_lo) { asm volatile("s_waitcnt vmcnt(0)" ::: "memory");
#ifdef PROBE_SYNC
            const unsigned long long ts0 = __builtin_amdgcn_s_memrealtime();
#endif
            if (p == a.ph_lo + 1) cg::this_grid().sync(); else xcd_barrier(xbar);
#ifdef PROBE_SYNC
            { const unsigned long long ts1 = __builtin_amdgcn_s_memrealtime(); if (blockIdx.x == PROBE_SYNC_BLK && threadIdx.x == 0) { float* pp = (float*)(a.ws + 32768); const float prev = (p == a.ph_lo + 1) ? 0.f : *(volatile float*)pp; *pp = prev + (float)(ts1 - ts0) * (1.0f / PROBE_DIV); } }
#endif
            }
        int tid = threadIdx.x; asm volatile("" : "+v"(tid));
        const int lane = tid & 63, wave = __builtin_amdgcn_readfirstlane(tid >> 6), gw = bid * NWAVES + wave;
        unsigned char* ws = a.ws; asm volatile("" : "+s"(ws));
        float* out = a.out; asm volatile("" : "+s"(out));
        float* LB = (float*)(ws + WS_LB); float* RSQ = (float*)(ws + WS_RSQ);
        bf16* WIN = (bf16*)(ws + WS_WIN); bf16* WPA = (bf16*)(ws + WS_WPA); bf16* WPB = (bf16*)(ws + WS_WPB); bf16* WOUT = (bf16*)(ws + WS_WOUT);
        bf16* WUP = (bf16*)(ws + WS_WUP); bf16* WDN = (bf16*)(ws + WS_WDN);
#ifdef DBG_NRUN
        if (p == DBG_NRUN) {
            for (size_t i = (size_t)bid * NTHR + tid; i < (size_t)M * DM; i += (size_t)G * NTHR) { float s = (DBG_NRUN >= 8) ? out[i] : 0.f;
                for (int k = 0; k < 8; ++k) s += bflo((unsigned)((const bf16*)(ws + WS_BUF(k)))[i]); out[i] = s; }
            continue;
        }
        if (p > DBG_NRUN) continue;
#endif
        if (p == NPH - 1) {
            for (int m = gw; m < M; m += NGW) rms_row_f32(out + (size_t)m * DM, ln_final, out + (size_t)m * DM, lane);
            continue;
        }
        const int l = p / PH_PER_LAYER, j = p % PH_PER_LAYER;
#ifdef PROBE_PH
        unsigned long long t0p = 0; if ((PROBE_PH >> j) & 1) t0p = __builtin_amdgcn_s_memrealtime();
#endif
        const float* hin = (l == 0) ? x : out;
#ifndef PHASE_MASK
#define PHASE_MASK 0x7ff
#endif
        if (!((PHASE_MASK >> j) & 1)) continue;
        switch (j) {
        case 0: {
#ifdef DBG_FILL
            if (l == 0) { v4u* fp = (v4u*)(ws + WS_BUF(1)); const size_t n16 = (size_t)7 * BUFB / 16; for (size_t i = (size_t)bid * NTHR + tid; i < n16; i += (size_t)G * NTHR) fp[i] = (v4u){DBG_FILL, DBG_FILL, DBG_FILL, DBG_FILL}; }
#endif
            convert_weight(w_in + (size_t)l * DM * NIN, DM, NIN, WIN, lds, gw, NGW, wave, lane);
            convert_weight(w_pa + (size_t)l * DM * DM, DM, DM, WPA, lds, gw, NGW, wave, lane);
            convert_weight(w_pb + (size_t)l * DM * DM, DM, DM, WPB, lds, gw, NGW, wave, lane);
            convert_weight(w_out + (size_t)l * DM * DM, DM, DM, WOUT, lds, gw, NGW, wave, lane);
            for (int i = bid * NTHR + tid; i < 2 * DM; i += G * NTHR) { LB[i] = 0.f; LB[2 * DM + i] = 1.f / (1.f + __expf(lb_logits[i] - lb_logits[2 * DM + i])); }
            if (l == 0) {
                for (int i = bid * NTHR + tid; i < 3 * M; i += G * NTHR) RSQ[i] = 0.f;
                for (int m = gw; m < M; m += NGW) rms_row_bf16(hin + (size_t)m * DM, ln_mix + l * DM, BUF(0) + (size_t)m * DM, lane);
            }
            __syncthreads();
        } break;
        case 1: {
#define PROJ(MA, MB, split, sec0, bufi, lbp) { pg8::Gemm g{BUF(0), WIN + (size_t)(sec0) * DM * DM, M, 3 * DM, DM}; pg8::StaticOrder S; S.init(M, 3 * DM, G, bid); \
            pg8::EpiProj<MA, MB> E{BUF(bufi), (size_t)M * DM, lbp, (l == 0) ? (const float*)nullptr : (const float*)(RSQ + M), split}; pg8::gemm_phase<pg8::EpiProj<MA, MB>, pg8::StaticOrder, PROJ_ALIGN, true>(lds, g, S, E); }
            PROJ(0, 1, 2, 0, 1, LB) PROJ(2, 3, 2, 3, 4, LB + (size_t)l * 2 * DM)
        } break;
        case 2: sg_phase(lds, BUF(1), BUF(2), w_s + (size_t)l * 8 * 16384, b_s + (size_t)l * 1024, sg_norm + (size_t)l * DM, bid, G); break;
        case 3: hg_phase(lds, BUF(3), BUF(4), BUF(5), BUF(6), BUF(2), BUF(7), bid, G); break;
        case 4: {
            PROJ(3, 4, 1, 6, 3, LB)
        } break;
        case 5: {
            convert_weight(w_up + (size_t)l * DM * DFF, DM, DFF, WUP, lds, gw, NGW, wave, lane);
            convert_weight(w_down + (size_t)l * DFF * DM, DFF, DM, WDN, lds, gw, NGW, wave, lane);
            for (int m = gw; m < M; m += NGW) cb_row(BUF(2), BUF(7), BUF(3), rec_norm + (size_t)l * DM, (size_t)m, lane);
            __syncthreads();
        } break;
        case 6: {
            pg8::Gemm g{BUF(1), WPA, 2 * M, 2 * DM, DM}; pg8::PairOrder S; S.init(M, DM, G, bid); pg8::EpiGate E{BUF(4), BUF(5)};
            pg8::gemm_phase<pg8::EpiGate, pg8::PairOrder, true, true>(lds, g, S, E);
        } break;
        case 7: {
            pg8::Gemm g{BUF(4), WOUT, M, DM, DM}; pg8::StaticOrder S; S.init(M, DM, G, bid); pg8::EpiResid E{hin, out, BUF(0), ln_mlp + l * DM, RSQ + (size_t)(l == 0 ? 0 : 2) * M};

            pg8::gemm_phase<pg8::EpiResid, pg8::StaticOrder, false, true>(lds, g, S, E);
        } break;
        case 8: {
            pg8::Gemm g{BUF(0), WUP, M, DFF, DM}; pg8::StaticOrder S; S.init(M, DFF, G, bid); pg8::EpiRelu2 E{BUF(1), DFF, RSQ + (size_t)(l == 0 ? 0 : 2) * M};
            pg8::gemm_phase<pg8::EpiRelu2, pg8::StaticOrder, true, true>(lds, g, S, E);
        } break;
        case 9: {
            pg8::Gemm g{BUF(1), WDN, M, DM, DFF}; pg8::StaticOrder S; S.init(M, DM, G, bid); pg8::EpiResid E{out, out, (l == 0) ? BUF(0) : (bf16*)nullptr, ln_mix + DM, RSQ + M};
            pg8::gemm_phase<pg8::EpiResid, pg8::StaticOrder, false, true>(lds, g, S, E);
        } break;
        }
#ifdef PROBE_PH
        if ((PROBE_PH >> j) & 1) { asm volatile("s_waitcnt vmcnt(0)" ::: "memory"); __syncthreads(); const unsigned long long t1p = __builtin_amdgcn_s_memrealtime();
#ifdef PROBE_MAX
            if (tid == 0) atomicMax((unsigned*)(ws + 32768) + 1 + p, (unsigned)(t1p - t0p));
#else
            if (bid == 0 && tid == 0) atomicAdd((unsigned*)(ws + 32768) + 1 + p, (unsigned)(t1p - t0p));
#endif
        }
#endif
    }
#if defined(PROBE_PH)
    if (bid == 0 && threadIdx.x == 0) { asm volatile("s_waitcnt vmcnt(0)" ::: "memory"); unsigned s = 0; for (int q = 0; q < NPH; ++q) s += __hip_atomic_load((unsigned*)(a.ws + 32768) + 1 + q, __ATOMIC_RELAXED, __HIP_MEMORY_SCOPE_AGENT); a.out[0] = (float)s * (1.0f / PROBE_DIV); }
#elif defined(PROBE_SYNC)
    if (bid == 0 && threadIdx.x == 0) { asm volatile("s_waitcnt vmcnt(0)" ::: "memory"); a.out[0] = *(volatile float*)(a.ws + 32768); }
#endif
#undef BUF
}

extern "C" void kernel_launch(void* const* d_in, const int* in_sizes, int n_in, void* d_out, int out_size, void* d_ws, size_t ws_size, hipStream_t stream) {
    static int grid = 0;
    if (grid == 0) {
        if (n_in != 15 || out_size != M * DM || ws_size < WS_END) { fprintf(stderr, "kernel_launch: unexpected problem (n_in %d, out %d, ws %zu < %zu)\n", n_in, out_size, ws_size, (size_t)WS_END); grid = -1; return; }
        int dev = 0, cus = 0, per_cu = 0;
        hipGetDevice(&dev); hipDeviceGetAttribute(&cus, hipDeviceAttributeMultiprocessorCount, dev);
        if (hipFuncSetAttribute((const void*)fwd, hipFuncAttributeMaxDynamicSharedMemorySize, LDS_BYTES) != hipSuccess) { fprintf(stderr, "kernel_launch: hipFuncSetAttribute failed\n"); grid = -1; return; }
        if (hipOccupancyMaxActiveBlocksPerMultiprocessor(&per_cu, (const void*)fwd, NTHR, LDS_BYTES) != hipSuccess || per_cu < 1) { fprintf(stderr, "kernel_launch: occupancy query says %d\n", per_cu); per_cu = 1; }
        (void)hipGetLastError();
        grid = cus;
    }
    if (grid < 0) return;
#if defined(PROBE_PH)
    (void)hipMemsetAsync((char*)d_ws + 32768, 0, 512, stream);
#endif
    (void)hipMemsetAsync(d_ws, 0, 16384, stream);
    Args a{};
    for (int i = 0; i < 15; ++i) a.in[i] = (const float*)d_in[i];
    a.out = (float*)d_out; a.ws = (unsigned char*)d_ws;
#if ONE_LAUNCH
    a.ph_lo = 0; a.ph_hi = NPH;
    void* args[] = {&a};
    hipError_t e = hipLaunchCooperativeKernel((const void*)fwd, dim3(grid), dim3(NTHR), args, LDS_BYTES, stream);
    if (e != hipSuccess) fprintf(stderr, "cooperative launch failed: %s (grid %d)\n", hipGetErrorString(e), grid);
#else
    for (int p = 0; p < NPH; ++p) { a.ph_lo = p; a.ph_hi = p + 1; hipLaunchKernelGGL(fwd, dim3(grid), dim3(NTHR), LDS_BYTES, stream, a); }
#endif
}
```

```cpp
#define ONE_LAUNCH 1
#include <hip/hip_runtime.h>
#include <hip/hip_cooperative_groups.h>
#include <cstdio>
#include <cstdint>
namespace cg = cooperative_groups;
namespace pg8 {
#define PG8_LAS __attribute__((address_space(3)))
typedef unsigned short bf16_t;
typedef short bf16x8 __attribute__((ext_vector_type(8)));
typedef float f32x4 __attribute__((ext_vector_type(4)));
typedef unsigned u32x4 __attribute__((ext_vector_type(4)));
constexpr int BM = 256, BK = 64, HALF = 128, HTB = HALF * BK * 2  , STAGE_BYTES = 8 * HTB, NXCD = 8, WGM = 8;

__host__ __device__ __forceinline__ int lds_byte(int r, int c) { const int st = (r >> 4) * 2 + (c >> 5), rr = r & 15, cc = c & 31, ob = rr * 64 + cc * 2; return st * 1024 + (ob ^ (((ob >> 9) & 1) << 5)); }
__host__ __device__ __forceinline__ void stage_rc(int b, int& R, int& C) { const int st = b / 1024, sb = b % 1024, swz = sb ^ (((sb >> 9) & 1) << 5); R = (st >> 1) * 16 + swz / 64; C = (st & 1) * 32 + (swz % 64) / 2; }
__host__ __device__ __forceinline__ int perm32(int rho) { const int n = rho >> 4, i = rho & 15; return 8 * (i >> 2) + 4 * n + (i & 3); }

struct Unit { int pm, pn; };
struct Gemm { const bf16_t* A; const bf16_t* Bt; int M, N, K; };

struct StaticOrder {
    int nM, nN, nwg, G, c;
    __host__ __device__ void init(int M, int N, int G_, int c_) { nM = M / BM; nN = N / BM; nwg = nM * nN; G = G_; c = c_; }
    __host__ __device__ bool next(int i, Unit& u) const {
        const long L = (long)i * G + c; if (L >= nwg) return false;
        int wgid = (int)L; { const int q = nwg / NXCD, r = nwg % NXCD, xcd = wgid % NXCD, off = wgid / NXCD; wgid = (xcd < r ? xcd * (q + 1) : r * (q + 1) + (xcd - r) * q) + off; }
        const int nig = WGM * nN, gid = wgid / nig, fm = gid * WGM, gsz = (nM - fm) < WGM ? (nM - fm) : WGM;
        u.pm = fm + ((wgid % nig) % gsz); u.pn = (wgid % nig) / gsz; return true;
    }
    __device__ __forceinline__ void a_ready(const Unit&) const {}
    __device__ __forceinline__ void done(const Unit&) const {}
};

typedef float cvt_f32x2_t __attribute__((ext_vector_type(2)));
typedef __bf16 cvt_bf16x2_t __attribute__((ext_vector_type(2)));
__device__ __forceinline__ unsigned cvt_pk_bf16(float lo, float hi) { cvt_f32x2_t v = {lo, hi}; cvt_bf16x2_t b = __builtin_convertvector(v, cvt_bf16x2_t); return __builtin_bit_cast(unsigned, b); }
typedef float f32x2 __attribute__((ext_vector_type(2)));
__device__ __forceinline__ f32x2 gelu_pk(f32x2 v) {
    const f32x2 av = __builtin_elementwise_abs(v), d = av * 0.2316418882f + 1.0f;
    f32x2 t; t.x = __builtin_amdgcn_rcpf(d.x); t.y = __builtin_amdgcn_rcpf(d.y);
    f32x2 q = t * 0.5307027145f + (-0.7265760135f); q = q * t + 0.7107068705f; q = q * t + (-0.142248368f); q = q * t + 0.127414796f; q = q * t;
    const f32x2 s = (v * v) * (-0.72134752044f);
    f32x2 e; e.x = __builtin_amdgcn_exp2f(s.x); e.y = __builtin_amdgcn_exp2f(s.y);
    const f32x2 m = v * (q * e), r = v - m;
    f32x2 o; o.x = v.x < 0.f ? m.x : r.x; o.y = v.y < 0.f ? m.y : r.y; return o;
}
__device__ __forceinline__ float bflo(unsigned u) { return __builtin_bit_cast(float, u << 16); }
__device__ __forceinline__ float bfhi(unsigned u) { return __builtin_bit_cast(float, u & 0xffff0000u); }
__device__ __forceinline__ float sigm(float z) { return __builtin_amdgcn_rcpf(1.0f + __expf(-z)); }
template <int MA, int MB> struct EpiProj {
    static constexpr bool PERM = true, AFTER_DRAIN = false;
    bf16_t* out0; size_t sec_stride; const float* lb; const float* rowsq; int split;
    template <int MODE> __device__ __forceinline__ void run(const f32x4 (&acc)[2][2][4][2], bf16_t* base, const float* lbrow, int row0, int col0) const {
#pragma unroll
        for (int ai = 0; ai < 2; ++ai)
#pragma unroll
            for (int m = 0; m < 4; ++m) { bf16_t* rowp = base + (size_t)(row0 + ai * HALF + m * 16) * 1024 + col0;
                const float rs = rowsq ? rsqrtf(rowsq[row0 + ai * HALF + m * 16] * (1.0f / 1024.0f) + 1e-6f) : 1.0f;
#pragma unroll
                for (int bj = 0; bj < 2; ++bj) { f32x4 v[2] = {acc[ai][bj][m][0] * rs, acc[ai][bj][m][1] * rs};
#pragma unroll
                    for (int n = 0; n < 2; ++n) {
                        if (MODE == 0) { f32x2 a = gelu_pk((f32x2){v[n][0], v[n][1]}), b = gelu_pk((f32x2){v[n][2], v[n][3]}); v[n] = (f32x4){a.x, a.y, b.x, b.y}; }
                        else if (MODE == 2) { const f32x4 lbv = *(const f32x4*)(lbrow + bj * HALF + 4 * n);
#pragma unroll
                            for (int e = 0; e < 4; ++e) { const float l = lbv[e]; const float f = l + (1.0f - l) * sigm(v[n][e]); v[n][e] = __log2f(f); }
                        } else if (MODE == 3) {
#pragma unroll
                            for (int e = 0; e < 4; ++e) v[n][e] = v[n][e] * sigm(v[n][e]);
                        } else if (MODE == 4) {
#pragma unroll
                            for (int e = 0; e < 4; ++e) v[n][e] = sigm(v[n][e]);
                        }
                    }
                    u32x4 w; w.x = cvt_pk_bf16(v[0][0], v[0][1]); w.y = cvt_pk_bf16(v[0][2], v[0][3]); w.z = cvt_pk_bf16(v[1][0], v[1][1]); w.w = cvt_pk_bf16(v[1][2], v[1][3]);
                    *(u32x4*)(rowp + bj * HALF) = w; } }
    }
    __device__ __forceinline__ void operator()(const f32x4 (&acc)[2][2][4][2], const Unit& u, int wr, int wc, int fr, int fq) const {
        const int colt = u.pn * BM, sec = colt >> 10;
        bf16_t* base = out0 + (size_t)sec * sec_stride;
        const int col0 = (colt & 1023) + wc * 32 + 8 * fq, row0 = u.pm * BM + wr * 64 + fr;
        const float* lbrow = lb + sec * 1024 + col0;
        if (sec < split) run<MA>(acc, base, lbrow, row0, col0); else run<MB>(acc, base, lbrow, row0, col0);
    }
};
struct EpiGate {
    static constexpr bool PERM = true, AFTER_DRAIN = false;
    bf16_t* T; const bf16_t* gate2;
    __device__ __forceinline__ void operator()(const f32x4 (&acc)[2][2][4][2], const Unit& u, int wr, int wc, int fr, int fq) const {
        const bool second = u.pm >= 64;
        const int col0 = (u.pn & 3) * BM + wc * 32 + 8 * fq, row0 = (u.pm & 63) * BM + wr * 64 + fr;
        const bf16_t* gate = second ? gate2 : T;
#pragma unroll
        for (int ai = 0; ai < 2; ++ai)
#pragma unroll
            for (int m = 0; m < 4; ++m) { asm volatile("" ::: "memory"); __builtin_amdgcn_sched_barrier(0); const size_t ro = (size_t)(row0 + ai * HALF + m * 16) * 1024 + col0;
#pragma unroll
                for (int bj = 0; bj < 2; ++bj) {
                    const u32x4 gv = *(const u32x4*)(gate + ro + bj * HALF);
                    u32x4 av = (u32x4){0u, 0u, 0u, 0u}; if (second) av = *(const u32x4*)(T + ro + bj * HALF);
                    const f32x4 v0 = acc[ai][bj][m][0], v1 = acc[ai][bj][m][1];
                    u32x4 w;
                    w.x = cvt_pk_bf16(bflo(av.x) + bflo(gv.x) * v0[0], bfhi(av.x) + bfhi(gv.x) * v0[1]);
                    w.y = cvt_pk_bf16(bflo(av.y) + bflo(gv.y) * v0[2], bfhi(av.y) + bfhi(gv.y) * v0[3]);
                    w.z = cvt_pk_bf16(bflo(av.z) + bflo(gv.z) * v1[0], bfhi(av.z) + bfhi(gv.z) * v1[1]);
                    w.w = cvt_pk_bf16(bflo(av.w) + bflo(gv.w) * v1[2], bfhi(av.w) + bfhi(gv.w) * v1[3]);
                    *(u32x4*)(T + ro + bj * HALF) = w; } }
    }
};
struct PairOrder {
    StaticOrder S;
    __device__ void init(int M_, int N_, int G_, int c_) { S.init(M_, N_, G_, c_); }
    __device__ bool next(int i, Unit& u) const { if (!S.next(i >> 1, u)) return false; if (i & 1) { u.pm += 64; u.pn += 4; } return true; }
    __device__ __forceinline__ void a_ready(const Unit&) const {}
    __device__ __forceinline__ void done(const Unit&) const {}
};
struct EpiResid {
    static constexpr bool PERM = true, AFTER_DRAIN = false;
    const float* base32; const bf16_t* xg_in; const float* gain_in; float* out32; bf16_t* xg_out; const float* gain_out; float* rowsq;
    __device__ __forceinline__ void operator()(const f32x4 (&acc)[2][2][4][2], const Unit& u, int wr, int wc, int fr, int fq) const {
        const int col0 = u.pn * BM + wc * 32 + 8 * fq, row0 = u.pm * BM + wr * 64 + fr;
#pragma unroll
        for (int ai = 0; ai < 2; ++ai)
#pragma unroll
            for (int m = 0; m < 4; ++m) { asm volatile("" ::: "memory"); __builtin_amdgcn_sched_barrier(0); const int row = row0 + ai * HALF + m * 16; const size_t ro = (size_t)row * 1024 + col0; float ss = 0.f;
#pragma unroll
                for (int bj = 0; bj < 2; ++bj) { f32x4 h[2];
                    if (base32) { h[0] = *(const f32x4*)(base32 + ro + bj * HALF); h[1] = *(const f32x4*)(base32 + ro + bj * HALF + 4); }
                    else { const u32x4 xv = *(const u32x4*)(xg_in + ro + bj * HALF); const f32x4 g0 = *(const f32x4*)(gain_in + col0 + bj * HALF), g1 = *(const f32x4*)(gain_in + col0 + bj * HALF + 4);
                        h[0] = (f32x4){bflo(xv.x) * __builtin_amdgcn_rcpf(g0[0]), bfhi(xv.x) * __builtin_amdgcn_rcpf(g0[1]), bflo(xv.y) * __builtin_amdgcn_rcpf(g0[2]), bfhi(xv.y) * __builtin_amdgcn_rcpf(g0[3])};
                        h[1] = (f32x4){bflo(xv.z) * __builtin_amdgcn_rcpf(g1[0]), bfhi(xv.z) * __builtin_amdgcn_rcpf(g1[1]), bflo(xv.w) * __builtin_amdgcn_rcpf(g1[2]), bfhi(xv.w) * __builtin_amdgcn_rcpf(g1[3])}; }
#pragma unroll
                    for (int n = 0; n < 2; ++n) { h[n] = h[n] + acc[ai][bj][m][n]; if (out32) *(f32x4*)(out32 + ro + bj * HALF + 4 * n) = h[n];
                        ss += (h[n][0] * h[n][0] + h[n][1] * h[n][1]) + (h[n][2] * h[n][2] + h[n][3] * h[n][3]); }
                    if (xg_out) { const f32x4 g0 = *(const f32x4*)(gain_out + col0 + bj * HALF), g1 = *(const f32x4*)(gain_out + col0 + bj * HALF + 4);
                        u32x4 w; w.x = cvt_pk_bf16(h[0][0] * g0[0], h[0][1] * g0[1]); w.y = cvt_pk_bf16(h[0][2] * g0[2], h[0][3] * g0[3]); w.z = cvt_pk_bf16(h[1][0] * g1[0], h[1][1] * g1[1]); w.w = cvt_pk_bf16(h[1][2] * g1[2], h[1][3] * g1[3]);
                        *(u32x4*)(xg_out + ro + bj * HALF) = w; } }
                if (xg_out) { ss += __shfl_xor(ss, 16); ss += __shfl_xor(ss, 32); if (fq == 0) atomicAdd(rowsq + row, ss); } }
    }
};
struct EpiRelu2 {
    static constexpr bool PERM = true, AFTER_DRAIN = false;
    bf16_t* out; int ldc; const float* rowsq;
    __device__ __forceinline__ void operator()(const f32x4 (&acc)[2][2][4][2], const Unit& u, int wr, int wc, int fr, int fq) const {
        const int col0 = u.pn * BM + wc * 32 + 8 * fq, row0 = u.pm * BM + wr * 64 + fr;
#pragma unroll
        for (int ai = 0; ai < 2; ++ai)
#pragma unroll
            for (int m = 0; m < 4; ++m) { asm volatile("" ::: "memory"); __builtin_amdgcn_sched_barrier(0); bf16_t* rowp = out + (size_t)(row0 + ai * HALF + m * 16) * ldc + col0;
                const float rs = rsqrtf(rowsq[row0 + ai * HALF + m * 16] * (1.0f / 1024.0f) + 1e-6f);
#pragma unroll
                for (int bj = 0; bj < 2; ++bj) { f32x4 v0 = acc[ai][bj][m][0] * rs, v1 = acc[ai][bj][m][1] * rs;
#pragma unroll
                    for (int e = 0; e < 4; ++e) { const float a = fmaxf(v0[e], 0.f), b = fmaxf(v1[e], 0.f); v0[e] = a * a; v1[e] = b * b; }
                    u32x4 w; w.x = cvt_pk_bf16(v0[0], v0[1]); w.y = cvt_pk_bf16(v0[2], v0[3]); w.z = cvt_pk_bf16(v1[0], v1[1]); w.w = cvt_pk_bf16(v1[2], v1[3]);
                    *(u32x4*)(rowp + bj * HALF) = w; } }
    }
};
template <class Epi, class Sched, bool ALIGN_EPI = false, bool SP2 = false>
__device__ __forceinline__ void gemm_phase(PG8_LAS unsigned char* lds, const Gemm g, const Sched& S, const Epi& E) {
    int tid_l = threadIdx.x; asm volatile("" : "+v"(tid_l));
    const int tid = tid_l, wid = __builtin_amdgcn_readfirstlane(tid >> 6), lane = tid & 63, wr = wid >> 2, wc = wid & 3, fr = lane & 15, fq = lane >> 4;
    const int K = g.K, nt = K / BK;
    unsigned voffA[2], voffB[2];
#pragma unroll
    for (int i = 0; i < 2; ++i) { int R, C; stage_rc(tid * 16 + i * 8192, R, C); const int Rb = Epi::PERM ? ((R & ~31) + perm32(R & 31)) : R;
        voffA[i] = (unsigned)(R * K + C) * 2u; voffB[i] = (unsigned)(Rb * K + C) * 2u; }
    const size_t kstep = (size_t)(BK * 2);
    const size_t hstep = (size_t)HALF * K * 2;
    const size_t tstep = 2 * hstep;
    const unsigned ldsw = (unsigned)wid * 1024u;
    const int aoff = lds_byte(wr * 64 + fr, fq * 8), boff = lds_byte(wc * 32 + fr, fq * 8);
#define PG8_SA(b, h) (((b) * 2 + (h)) * HTB)
#define PG8_SB(b, h) ((4 + (b) * 2 + (h)) * HTB)
#define PG8_STAGE(bufoff, gbase, voff) do { _Pragma("unroll") for (int _i = 0; _i < 2; ++_i) \
        __builtin_amdgcn_global_load_lds((const unsigned*)((const char*)(gbase) + (voff)[_i]), (PG8_LAS unsigned*)(lds + (bufoff) + ldsw + _i * 8192), 16, 0, 0); } while (0)
#define PG8_LDA(dst, b, h) do { _Pragma("unroll") for (int m = 0; m < 4; ++m) _Pragma("unroll") for (int k = 0; k < 2; ++k) dst[m][k] = *(const PG8_LAS bf16x8*)(lds + PG8_SA(b, h) + aoff + m * 2048 + k * 1024); } while (0)
#define PG8_LDB(dst, b, h) do { _Pragma("unroll") for (int n = 0; n < 2; ++n) _Pragma("unroll") for (int k = 0; k < 2; ++k) dst[n][k] = *(const PG8_LAS bf16x8*)(lds + PG8_SB(b, h) + boff + n * 2048 + k * 1024); } while (0)
#define PG8_MMA(ai, bj, At, Bt) do { __builtin_amdgcn_s_setprio(1); _Pragma("unroll") for (int m = 0; m < 4; ++m) _Pragma("unroll") for (int n = 0; n < 2; ++n) _Pragma("unroll") for (int k = 0; k < 2; ++k) \
        acc[ai][bj][m][n] = __builtin_amdgcn_mfma_f32_16x16x32_bf16(Bt[n][k], At[m][k], acc[ai][bj][m][n], 0, 0, 0); __builtin_amdgcn_s_setprio(0); } while (0)
#define PG8_WAIT_V(n) asm volatile("s_waitcnt vmcnt(" #n ")" ::: "memory")
#define PG8_WAIT_L(n) asm volatile("s_waitcnt lgkmcnt(" #n ")" ::: "memory")
#define PG8_BAR __builtin_amdgcn_s_barrier()
#define PG8_SCHED __builtin_amdgcn_sched_barrier(0)
    Unit cur, nxt; int ui = 0;
    if (!S.next(0, cur)) return;
    f32x4 acc[2][2][4][2];
#pragma unroll
    for (int a = 0; a < 2; ++a)
#pragma unroll
        for (int b = 0; b < 2; ++b)
#pragma unroll
            for (int m = 0; m < 4; ++m)
#pragma unroll
                for (int n = 0; n < 2; ++n) acc[a][b][m][n] = (f32x4){0.f, 0.f, 0.f, 0.f};
    bf16x8 At[4][2], B0[2][2], B1[2][2];
    const char* cA = (const char*)g.A + (size_t)cur.pm * tstep; const char* cB = (const char*)g.Bt + (size_t)cur.pn * tstep;
    S.a_ready(cur);
    if constexpr (SP2) {
        PG8_STAGE(PG8_SB(0, 0), cB, voffB); PG8_STAGE(PG8_SB(0, 1), cB + hstep, voffB); PG8_STAGE(PG8_SA(0, 0), cA, voffA); PG8_STAGE(PG8_SA(0, 1), cA + hstep, voffA);
        if (wr == 1) PG8_BAR;
        PG8_WAIT_V(2); PG8_BAR;
        PG8_STAGE(PG8_SB(1, 0), cB + kstep, voffB); PG8_STAGE(PG8_SA(1, 0), cA + kstep, voffA); PG8_STAGE(PG8_SB(1, 1), cB + hstep + kstep, voffB);
        PG8_WAIT_V(6); PG8_BAR;
    } else {
        PG8_STAGE(PG8_SB(0, 0), cB, voffB); PG8_STAGE(PG8_SA(0, 0), cA, voffA); PG8_STAGE(PG8_SB(0, 1), cB + hstep, voffB); PG8_STAGE(PG8_SA(0, 1), cA + hstep, voffA);
        if (wr == 1) PG8_BAR;
        PG8_WAIT_V(4); PG8_BAR;
        PG8_STAGE(PG8_SB(1, 0), cB + kstep, voffB); PG8_STAGE(PG8_SA(1, 0), cA + kstep, voffA); PG8_STAGE(PG8_SB(1, 1), cB + hstep + kstep, voffB);
        PG8_WAIT_V(6); PG8_BAR;
    }
    for (;;) {
        const bool has_next = S.next(ui + 1, nxt);
        const char* nA = has_next ? (const char*)g.A + (size_t)nxt.pm * tstep : cA; const char* nB = has_next ? (const char*)g.Bt + (size_t)nxt.pn * tstep : cB;
        for (int t = 0; t < nt; t += 2) {
            const bool last = (t == nt - 2);
            const char* a1 = cA + (size_t)(t + 1) * kstep;
            const char* a2 = last ? nA : cA + (size_t)(t + 2) * kstep; const char* b2 = last ? nB : cB + (size_t)(t + 2) * kstep;
            const char* a3 = a2 + kstep; const char* b3 = b2 + kstep;
            if (last && has_next) S.a_ready(nxt);
            if constexpr (SP2) {
            PG8_LDB(B0, 0, 0); PG8_LDB(B1, 0, 1); PG8_SCHED; PG8_LDA(At, 0, 0); PG8_STAGE(PG8_SA(1, 1), a1 + hstep, voffA);
            PG8_WAIT_V(8); PG8_WAIT_L(0); PG8_BAR; PG8_MMA(0, 0, At, B0); PG8_MMA(0, 1, At, B1); PG8_BAR; PG8_SCHED;
            PG8_LDA(At, 0, 1); PG8_STAGE(PG8_SB(0, 0), b2, voffB); PG8_STAGE(PG8_SB(0, 1), b2 + hstep, voffB); PG8_STAGE(PG8_SA(0, 0), a2, voffA);
            PG8_WAIT_V(8); PG8_WAIT_L(0); PG8_BAR; PG8_MMA(1, 0, At, B0); PG8_MMA(1, 1, At, B1); PG8_BAR; PG8_SCHED;
            PG8_LDB(B0, 1, 0); PG8_LDB(B1, 1, 1); PG8_SCHED; PG8_LDA(At, 1, 0); PG8_STAGE(PG8_SA(0, 1), a2 + hstep, voffA);
            PG8_WAIT_V(8); PG8_WAIT_L(0); PG8_BAR; PG8_MMA(0, 0, At, B0); PG8_MMA(0, 1, At, B1); PG8_BAR; PG8_SCHED;
            PG8_LDA(At, 1, 1); PG8_STAGE(PG8_SB(1, 0), b3, voffB); PG8_STAGE(PG8_SB(1, 1), b3 + hstep, voffB); PG8_STAGE(PG8_SA(1, 0), a3, voffA);
            PG8_WAIT_V(8); PG8_WAIT_L(0); PG8_BAR; PG8_MMA(1, 0, At, B0); PG8_MMA(1, 1, At, B1); PG8_BAR; PG8_SCHED;
            } else {
            PG8_LDB(B0, 0, 0); PG8_SCHED; PG8_LDA(At, 0, 0); PG8_STAGE(PG8_SA(1, 1), a1 + hstep, voffA);
            PG8_WAIT_L(8); PG8_BAR; PG8_WAIT_L(0); PG8_MMA(0, 0, At, B0); PG8_BAR; PG8_SCHED;
            PG8_LDB(B1, 0, 1); PG8_STAGE(PG8_SB(0, 0), b2, voffB);
            PG8_BAR; PG8_WAIT_L(0); PG8_MMA(0, 1, At, B1); PG8_BAR;
            PG8_LDA(At, 0, 1); PG8_STAGE(PG8_SA(0, 0), a2, voffA);
            PG8_BAR; PG8_WAIT_L(0); PG8_MMA(1, 0, At, B0); PG8_BAR; PG8_SCHED;
            PG8_STAGE(PG8_SB(0, 1), b2 + hstep, voffB);
            PG8_WAIT_V(6); PG8_BAR; PG8_MMA(1, 1, At, B1); PG8_BAR;
            PG8_LDB(B0, 1, 0); PG8_SCHED; PG8_LDA(At, 1, 0); PG8_STAGE(PG8_SA(0, 1), a2 + hstep, voffA);
            PG8_WAIT_L(8); PG8_BAR; PG8_WAIT_L(0); PG8_MMA(0, 0, At, B0); PG8_BAR; PG8_SCHED;
            PG8_LDB(B1, 1, 1); PG8_STAGE(PG8_SB(1, 0), b3, voffB);
            PG8_BAR; PG8_WAIT_L(0); PG8_MMA(0, 1, At, B1); PG8_BAR;
            PG8_LDA(At, 1, 1); PG8_STAGE(PG8_SA(1, 0), a3, voffA);
            PG8_BAR; PG8_WAIT_L(0); PG8_MMA(1, 0, At, B0); PG8_BAR; PG8_SCHED;
            PG8_STAGE(PG8_SB(1, 1), b3 + hstep, voffB);
            PG8_WAIT_V(6); PG8_BAR; PG8_MMA(1, 1, At, B1); PG8_BAR;
            }
        }
        if constexpr (ALIGN_EPI) { if (wr == 0) PG8_BAR; }
        if constexpr (!Epi::AFTER_DRAIN) { E(acc, cur, wr, wc, fr, fq); S.done(cur); }
        if (!has_next) break;
#pragma unroll
        for (int a = 0; a < 2; ++a)
#pragma unroll
            for (int b = 0; b < 2; ++b)
#pragma unroll
                for (int m = 0; m < 4; ++m)
#pragma unroll
                    for (int n = 0; n < 2; ++n) acc[a][b][m][n] = (f32x4){0.f, 0.f, 0.f, 0.f};
        cur = nxt; cA = nA; cB = nB; ++ui;
        if constexpr (ALIGN_EPI) { if (wr == 1) PG8_BAR; }
    }
    PG8_WAIT_V(0);
    if constexpr (!ALIGN_EPI) { if (wr == 0) PG8_BAR; }
    PG8_BAR;
    if constexpr (Epi::AFTER_DRAIN) { E.fused(acc, cur, wr, wc, fr, fq, lds, wid, lane); S.done(cur); }
#undef PG8_SA
#undef PG8_SB
#undef PG8_STAGE
#undef PG8_LDA
#undef PG8_LDB
#undef PG8_MMA
#undef PG8_WAIT_V
#undef PG8_WAIT_L
#undef PG8_BAR
#undef PG8_SCHED
}
}

#define LAS __attribute__((address_space(3)))
typedef unsigned short bf16;
typedef unsigned v4u __attribute__((ext_vector_type(4)));
typedef unsigned v2u __attribute__((ext_vector_type(2)));
typedef float f32x4 __attribute__((ext_vector_type(4)));
typedef float f32x2 __attribute__((ext_vector_type(2)));
typedef short bf16x8 __attribute__((ext_vector_type(8)));
typedef short s16x4 __attribute__((ext_vector_type(4)));
using pg8::bflo; using pg8::bfhi; using pg8::cvt_pk_bf16;

#ifndef PROJ_ALIGN
#define PROJ_ALIGN true
#endif
#ifndef ONE_LAUNCH
#define ONE_LAUNCH 1
#endif
constexpr int DM = 1024, BATCH = 8, SEQ = 2048, M = BATCH * SEQ, NIN = 9216, DFF = 4096, DEPTH = 2;
constexpr float EPS = 1e-6f;
constexpr int NTHR = 512, NWAVES = 8;
constexpr int LDS_RING = 131072, LDS_BYTES = LDS_RING + 64;
constexpr size_t MiB = 1u << 20;
constexpr size_t WS_RSQ = 256 * 1024;
constexpr size_t WS_LB = 64 * 1024;
constexpr size_t WS_WIN = 1 * MiB, WS_WPA = 19 * MiB, WS_WPB = 21 * MiB, WS_WOUT = 23 * MiB;
constexpr size_t WS_B0 = 25 * MiB, BUFB = 32 * MiB;
constexpr size_t WS_END = WS_B0 + 8 * BUFB;
#define WS_BUF(i) (WS_B0 + (size_t)(i) * BUFB)
constexpr size_t WS_WUP = WS_BUF(6), WS_WDN = WS_BUF(6) + 8 * MiB;
constexpr int PH_PER_LAYER = 10, NPH = DEPTH * PH_PER_LAYER + 1;

__device__ __forceinline__ float wave_sum(float v) {
#pragma unroll
    for (int o = 1; o < 64; o <<= 1) v += __shfl_xor(v, o);
    return v;
}
__device__ __forceinline__ void transpose_item(const float* W, int K, int N, bf16* WT, LAS float* scr, int item, int lane) {
    const int nblk = N / 32, kb = item / nblk, nb = item % nblk, k0 = 64 * kb, n0 = 32 * nb;
#pragma unroll 8
    for (int i = 0; i < 32; ++i) { const int kk = 2 * i + (lane >> 5); scr[kk * 33 + (lane & 31)] = W[(size_t)(k0 + kk) * N + n0 + (lane & 31)]; }
    asm volatile("s_waitcnt lgkmcnt(0)" ::: "memory");
    const int c = lane & 7;
#pragma unroll
    for (int j = 0; j < 4; ++j) { const int n = (lane >> 3) + 8 * j; const LAS float* s = scr + (8 * c) * 33 + n;
        v4u o; o.x = cvt_pk_bf16(s[0 * 33], s[1 * 33]); o.y = cvt_pk_bf16(s[2 * 33], s[3 * 33]); o.z = cvt_pk_bf16(s[4 * 33], s[5 * 33]); o.w = cvt_pk_bf16(s[6 * 33], s[7 * 33]);
        *(v4u*)(WT + (size_t)(n0 + n) * K + k0 + 8 * c) = o; }
    asm volatile("s_waitcnt lgkmcnt(0)" ::: "memory");
}
__device__ __forceinline__ void convert_weight(const float* W, int K, int N, bf16* WT, LAS unsigned char* lds, int gw, int NGW, int wave, int lane) {
    LAS float* scr = (LAS float*)(lds + wave * 16384);
    const int nitems = (K / 64) * (N / 32);
    for (int it = gw; it < nitems; it += NGW) transpose_item(W, K, N, WT, scr, it, lane);
}
__device__ __forceinline__ void rms_row_bf16(const float* xrow, const float* gain, bf16* orow, int lane) {
    const f32x4* xr = (const f32x4*)xrow + lane; const f32x4* gr = (const f32x4*)gain + lane;
    f32x4 v[4]; float s = 0.f;
#pragma unroll
    for (int j = 0; j < 4; ++j) { v[j] = xr[64 * j]; s += (v[j].x * v[j].x + v[j].y * v[j].y) + (v[j].z * v[j].z + v[j].w * v[j].w); }
    const float rstd = rsqrtf(wave_sum(s) * (1.f / DM) + EPS);
    v2u* o8 = (v2u*)orow + lane;
#pragma unroll
    for (int j = 0; j < 4; ++j) { const f32x4 gg = gr[64 * j]; v2u o; o.x = cvt_pk_bf16(v[j].x * rstd * gg.x, v[j].y * rstd * gg.y); o.y = cvt_pk_bf16(v[j].z * rstd * gg.z, v[j].w * rstd * gg.w); o8[64 * j] = o; }
}
__device__ __forceinline__ void rms_row_f32(const float* xrow, const float* gain, float* orow, int lane) {
    const f32x4* xr = (const f32x4*)xrow + lane; const f32x4* gr = (const f32x4*)gain + lane;
    f32x4 v[4]; float s = 0.f;
#pragma unroll
    for (int j = 0; j < 4; ++j) { v[j] = xr[64 * j]; s += (v[j].x * v[j].x + v[j].y * v[j].y) + (v[j].z * v[j].z + v[j].w * v[j].w); }
    const float rstd = rsqrtf(wave_sum(s) * (1.f / DM) + EPS);
    f32x4* o = (f32x4*)orow + lane;
#pragma unroll
    for (int j = 0; j < 4; ++j) { const f32x4 gg = gr[64 * j]; o[64 * j] = v[j] * rstd * gg; }
}

__device__ __forceinline__ void sg_phase(LAS unsigned char* lds, bf16* ZU, const bf16* ZV, const float* ws_l, const float* bs_l, const float* sgn_l, int bid, int G) {
    int tid_l = threadIdx.x; asm volatile("" : "+v"(tid_l));
    const int tid = tid_l, lane = tid & 63, w = __builtin_amdgcn_readfirstlane(tid >> 6), g = lane >> 4, r16 = lane & 15;
    LAS unsigned char* VGT = lds; LAS unsigned char* WSL = lds + 34816;
    for (int item = bid; item < 1024; item += G) {
        const int gq = item & 7, bc = item >> 3, row0 = bc * 128, col0 = gq * 128;
        {
            const int s = tid >> 2, dq = tid & 3;
            v4u z[4]; float ss = 0.f;
#pragma unroll
            for (int e = 0; e < 4; ++e) { z[e] = *(const v4u*)(ZV + (size_t)(row0 + s) * 1024 + col0 + dq * 32 + 8 * e);
#pragma unroll
                for (int q = 0; q < 4; ++q) { const float a = bflo(z[e][q]), b = bfhi(z[e][q]); ss += a * a + b * b; } }
            ss += __shfl_xor(ss, 1); ss += __shfl_xor(ss, 2);
            const float rstd = rsqrtf(ss * (1.f / 128.f) + EPS);
#pragma unroll
            for (int e = 0; e < 4; ++e)
#pragma unroll
                for (int q = 0; q < 4; ++q) { const int d = dq * 32 + 8 * e + 2 * q;
                    const float a = bflo(z[e][q]) * rstd * sgn_l[col0 + d], b = bfhi(z[e][q]) * rstd * sgn_l[col0 + d + 1];
                    const unsigned pk = cvt_pk_bf16(a, b);
                    *(LAS unsigned short*)(VGT + d * 272 + s * 2) = (unsigned short)(pk & 0xffffu);
                    *(LAS unsigned short*)(VGT + (d + 1) * 272 + s * 2) = (unsigned short)(pk >> 16); }
            const int t = tid >> 2, sq = tid & 3; const float* wrow = ws_l + (size_t)gq * 16384 + t * 128 + sq * 32;
#pragma unroll
            for (int e = 0; e < 4; ++e) { const f32x4 a = *(const f32x4*)(wrow + 8 * e), b = *(const f32x4*)(wrow + 8 * e + 4);
                v4u o; o.x = cvt_pk_bf16(a.x, a.y); o.y = cvt_pk_bf16(a.z, a.w); o.z = cvt_pk_bf16(b.x, b.y); o.w = cvt_pk_bf16(b.z, b.w);
                *(LAS v4u*)(WSL + t * 272 + (sq * 32 + 8 * e) * 2) = o; }
        }
        __syncthreads();
        {
            bf16x8 bw[4];
#pragma unroll
            for (int ks = 0; ks < 4; ++ks) bw[ks] = *(const LAS bf16x8*)(WSL + (16 * w + r16) * 272 + (32 * ks + 8 * g) * 2);
            const int row = row0 + 16 * w + r16; const float bias = bs_l[gq * 128 + 16 * w + r16];
#pragma unroll
            for (int dt = 0; dt < 8; ++dt) { f32x4 acc = (f32x4){0.f, 0.f, 0.f, 0.f};
#pragma unroll
                for (int ks = 0; ks < 4; ++ks) { const bf16x8 a = *(const LAS bf16x8*)(VGT + (16 * dt + r16) * 272 + (32 * ks + 8 * g) * 2); acc = __builtin_amdgcn_mfma_f32_16x16x32_bf16(a, bw[ks], acc, 0, 0, 0); }
                v2u* p = (v2u*)(ZU + (size_t)row * 1024 + col0 + 16 * dt + 4 * g); const v2u zu = *p; v2u o;
                o.x = cvt_pk_bf16(bflo(zu.x) * (acc[0] + bias), bfhi(zu.x) * (acc[1] + bias)); o.y = cvt_pk_bf16(bflo(zu.y) * (acc[2] + bias), bfhi(zu.y) * (acc[3] + bias)); *p = o; }
        }
        __syncthreads();
    }
}

constexpr int HG_QH = 0, HG_KH = 17408, HG_KT = 34816, HG_VT = 53248, HG_EBM = 62464, HG_EBL = 62976, HG_IMG = 63488;
__device__ __forceinline__ bf16x8 hg_ld2(const LAS unsigned char* p) {
    const v2u lo = *(const LAS v2u*)p, hi = *(const LAS v2u*)(p + 32); return __builtin_bit_cast(bf16x8, (v4u){lo.x, lo.y, hi.x, hi.y});
}
__device__ __forceinline__ bf16x8 hg_ld2s(const LAS unsigned char* row, int e0) {
    const v2u lo = *(const LAS v2u*)(row + 2 * e0), hi = *(const LAS v2u*)(row + 2 * (e0 ^ 16)); return __builtin_bit_cast(bf16x8, (v4u){lo.x, lo.y, hi.x, hi.y});
}
__device__ __forceinline__ void hg_phase(LAS unsigned char* lds, const bf16* Qb, const bf16* LFfw, const bf16* LFbw, const bf16* IVb, bf16* Ofw, bf16* Obw, int bid, int G) {
    int tid_l = threadIdx.x; asm volatile("" : "+v"(tid_l));
    const int tid = tid_l, lane = tid & 63, w = __builtin_amdgcn_readfirstlane(tid >> 6), g = lane >> 4, r16 = lane & 15;
    const int vs = tid >> 3, vc = tid & 7;
    const int kp = lane & 7, tg = lane >> 3, ek = 16 * w + 2 * kp, et0 = 8 * tg, ekz = ek ^ (16 * (tg >> 1));
    for (int item = bid; item < 256; item += G) {
        const int vh = (item >> 3) & 1, chain = (item & 7) | ((item >> 4) << 3), dir = chain & 1, h = (chain >> 1) & 7, b = chain >> 4;
        const bf16* LF = dir ? LFbw : LFfw; bf16* O = dir ? Obw : Ofw;
        const size_t colq = (size_t)h * 128 + ek, colv = (size_t)h * 128 + vh * 64;
#define HG_ROW(c, tau) ((size_t)(b * SEQ + (dir ? (SEQ - 1 - (64 * (c) + (tau))) : (64 * (c) + (tau)))))
        f32x4 S[8];
#pragma unroll
        for (int kt = 0; kt < 8; ++kt) S[kt] = (f32x4){0.f, 0.f, 0.f, 0.f};
        unsigned lfr[8], qr[8]; v4u vr;
#define HG_LOAD(c) do { _Pragma("unroll") for (int j = 0; j < 8; ++j) { const size_t ro = HG_ROW(c, et0 + j) * 1024 + colq; lfr[j] = *(const unsigned*)(LF + ro); qr[j] = *(const unsigned*)(Qb + ro); } \
        vr = *(const v4u*)(IVb + HG_ROW(c, vs) * 1024 + colv + vc * 8); } while (0)
#define HG_EW(img) do { LAS unsigned char* I_ = lds + (img) * HG_IMG; float f0_[8], f1_[8]; float a0_ = 0.f, a1_ = 0.f; \
        _Pragma("unroll") for (int j = 0; j < 8; ++j) { const float l0_ = bflo(lfr[j]), l1_ = bfhi(lfr[j]); a0_ += l0_; a1_ += l1_; f0_[j] = __builtin_amdgcn_exp2f(l0_); f1_[j] = __builtin_amdgcn_exp2f(l1_); } \
        float i0_ = a0_, i1_ = a1_; { float u0_ = __shfl_up(i0_, 8), u1_ = __shfl_up(i1_, 8); if (tg >= 1) { i0_ += u0_; i1_ += u1_; } \
            u0_ = __shfl_up(i0_, 16); u1_ = __shfl_up(i1_, 16); if (tg >= 2) { i0_ += u0_; i1_ += u1_; } u0_ = __shfl_up(i0_, 32); u1_ = __shfl_up(i1_, 32); if (tg >= 4) { i0_ += u0_; i1_ += u1_; } } \
        const float bm0_ = __shfl(i0_, kp + 24), bm1_ = __shfl(i1_, kp + 24), bl0_ = __shfl(i0_, kp + 56), bl1_ = __shfl(i1_, kp + 56); \
        const float off0_ = i0_ - a0_ - bm0_, off1_ = i1_ - a1_ - bm1_; \
        float ek0_ = __builtin_amdgcn_exp2f(fminf(-(off0_ + a0_), 115.f)), ek1_ = __builtin_amdgcn_exp2f(fminf(-(off1_ + a1_), 115.f)); \
        unsigned kw_[8]; \
        _Pragma("unroll") for (int j = 7; j >= 0; --j) { const float k0_ = (1.f - f0_[j]) * ek0_, k1_ = (1.f - f1_[j]) * ek1_; ek0_ *= f0_[j]; ek1_ *= f1_[j]; kw_[j] = cvt_pk_bf16(k0_, k1_); } \
        float eq0_ = __builtin_amdgcn_exp2f(fminf(off0_ + bflo(lfr[0]), 115.f)), eq1_ = __builtin_amdgcn_exp2f(fminf(off1_ + bfhi(lfr[0]), 115.f)); \
        _Pragma("unroll") for (int j = 0; j < 8; ++j) { if (j > 0) { eq0_ *= f0_[j]; eq1_ *= f1_[j]; } \
            *(LAS unsigned*)(I_ + HG_QH + (et0 + j) * 272 + 2 * ekz) = cvt_pk_bf16(bflo(qr[j]) * eq0_, bfhi(qr[j]) * eq1_); \
            *(LAS unsigned*)(I_ + HG_KH + (et0 + j) * 272 + 2 * ekz) = kw_[j]; } \
        *(LAS v4u*)(I_ + HG_KT + ek * 144 + 2 * et0) = (v4u){(kw_[0] & 0xffffu) | (kw_[1] << 16), (kw_[2] & 0xffffu) | (kw_[3] << 16), (kw_[4] & 0xffffu) | (kw_[5] << 16), (kw_[6] & 0xffffu) | (kw_[7] << 16)}; \
        *(LAS v4u*)(I_ + HG_KT + (ek + 1) * 144 + 2 * et0) = (v4u){(kw_[0] >> 16) | (kw_[1] & 0xffff0000u), (kw_[2] >> 16) | (kw_[3] & 0xffff0000u), (kw_[4] >> 16) | (kw_[5] & 0xffff0000u), (kw_[6] >> 16) | (kw_[7] & 0xffff0000u)}; \
        if (tg == 0) { *(LAS f32x2*)(I_ + HG_EBM + 4 * ek) = (f32x2){__builtin_amdgcn_exp2f(bm0_), __builtin_amdgcn_exp2f(bm1_)}; *(LAS f32x2*)(I_ + HG_EBL + 4 * ek) = (f32x2){__builtin_amdgcn_exp2f(bl0_ - bm0_), __builtin_amdgcn_exp2f(bl1_ - bm1_)}; } \
        _Pragma("unroll") for (int e = 0; e < 4; ++e) { const unsigned u_ = vr[e]; \
            *(LAS unsigned short*)(I_ + HG_VT + (vc * 8 + 2 * e) * 144 + vs * 2) = (unsigned short)(u_ & 0xffffu); \
            *(LAS unsigned short*)(I_ + HG_VT + (vc * 8 + 2 * e + 1) * 144 + vs * 2) = (unsigned short)(u_ >> 16); } } while (0)
        HG_LOAD(0);
        HG_EW(0);
        HG_LOAD(1);
        __syncthreads();
        const int vt = w & 3, th = w >> 2;
        for (int c = 0; c < 32; ++c) {
#ifndef HG_SKIP_EW
            if (c + 1 < 32) { HG_EW((c + 1) & 1); if (c + 2 < 32) HG_LOAD(c + 2); }
#else
            if (c + 2 < 32) HG_LOAD(c + 2);
#endif
#ifndef HG_SKIP_MM
            {
                const LAS unsigned char* I = lds + (c & 1) * HG_IMG;
                const LAS unsigned char* QH = I + HG_QH; const LAS unsigned char* KH = I + HG_KH; const LAS unsigned char* KT = I + HG_KT; const LAS unsigned char* VT = I + HG_VT;
                const LAS float* EBM = (const LAS float*)(I + HG_EBM); const LAS float* EBL = (const LAS float*)(I + HG_EBL);
                bf16x8 As[4];
#pragma unroll
                for (int kt = 0; kt < 8; ++kt) S[kt] = S[kt] * *(const LAS f32x4*)(EBM + 16 * kt + 4 * g);
#pragma unroll
                for (int ks = 0; ks < 4; ++ks) { const unsigned x0 = cvt_pk_bf16(S[2 * ks][0], S[2 * ks][1]), x1 = cvt_pk_bf16(S[2 * ks][2], S[2 * ks][3]), x2 = cvt_pk_bf16(S[2 * ks + 1][0], S[2 * ks + 1][1]), x3 = cvt_pk_bf16(S[2 * ks + 1][2], S[2 * ks + 1][3]);
                    As[ks] = __builtin_bit_cast(bf16x8, (v4u){x0, x1, x2, x3}); }
                bf16x8 avp[2], avn[2];
#pragma unroll
                for (int ks = 0; ks < 2; ++ks) { avp[ks] = hg_ld2(VT + (16 * vt + r16) * 144 + (32 * ks + 4 * g) * 2); avn[ks] = *(const LAS bf16x8*)(VT + (16 * vt + r16) * 144 + (32 * ks + 8 * g) * 2); }
#pragma unroll
                for (int ttl = 0; ttl < 2; ++ttl) { const int tt = th ? (1 + ttl) : (3 * ttl), trow = 16 * tt + r16; const LAS unsigned char* qrow = QH + trow * 272;
                    f32x4 oacc = (f32x4){0.f, 0.f, 0.f, 0.f};
#pragma unroll
                    for (int ks = 0; ks < 4; ++ks) oacc = __builtin_amdgcn_mfma_f32_16x16x32_bf16(As[ks], hg_ld2s(qrow, (32 * ks + 4 * g) ^ (16 * tt)), oacc, 0, 0, 0);
                    bf16x8 bq[4];
#pragma unroll
                    for (int ks = 0; ks < 4; ++ks) bq[ks] = *(const LAS bf16x8*)(qrow + 2 * ((32 * ks + 8 * g) ^ (16 * tt)));
#pragma unroll
                    for (int kp2 = 0; kp2 < 2; ++kp2) if (kp2 <= (tt >> 1)) {
                        unsigned pw[4] = {0u, 0u, 0u, 0u};
#pragma unroll
                        for (int si = 0; si < 2; ++si) { const int st = 2 * kp2 + si; if (st <= tt) { f32x4 p = (f32x4){0.f, 0.f, 0.f, 0.f};
#pragma unroll
                                for (int ks = 0; ks < 4; ++ks) p = __builtin_amdgcn_mfma_f32_16x16x32_bf16(*(const LAS bf16x8*)(KH + (16 * st + r16) * 272 + 2 * ((32 * ks + 8 * g) ^ (16 * st))), bq[ks], p, 0, 0, 0);
                                if (st == tt) {
#pragma unroll
                                    for (int i = 0; i < 4; ++i) if (4 * g + i > r16) p[i] = 0.f; }
                                pw[2 * si] = cvt_pk_bf16(p[0], p[1]); pw[2 * si + 1] = cvt_pk_bf16(p[2], p[3]); } }
                        oacc = __builtin_amdgcn_mfma_f32_16x16x32_bf16(avp[kp2], __builtin_bit_cast(bf16x8, (v4u){pw[0], pw[1], pw[2], pw[3]}), oacc, 0, 0, 0);
                    }
                    *(v2u*)(O + HG_ROW(c, trow) * 1024 + colv + vt * 16 + 4 * g) = (v2u){cvt_pk_bf16(oacc[0], oacc[1]), cvt_pk_bf16(oacc[2], oacc[3])};
                }
#pragma unroll
                for (int kt = 0; kt < 8; ++kt) {
#pragma unroll
                    for (int ks = 0; ks < 2; ++ks) S[kt] = __builtin_amdgcn_mfma_f32_16x16x32_bf16(*(const LAS bf16x8*)(KT + (16 * kt + r16) * 144 + (32 * ks + 8 * g) * 2), avn[ks], S[kt], 0, 0, 0);
                    S[kt] = S[kt] * *(const LAS f32x4*)(EBL + 16 * kt + 4 * g); }
            }
#endif
            __syncthreads();
        }
#undef HG_ROW
#undef HG_LOAD
#undef HG_EW
    }
}

__device__ __forceinline__ void cb_row(bf16* Ofw, const bf16* Obw, const bf16* OG, const float* gain, size_t row, int lane) {
    const size_t o = row * 1024 + 16 * lane;
    v4u a[2], b[2], gq[2]; float s[16]; float ss = 0.f;
#pragma unroll
    for (int e = 0; e < 2; ++e) { a[e] = *(const v4u*)(Ofw + o + 8 * e); b[e] = *(const v4u*)(Obw + o + 8 * e); gq[e] = *(const v4u*)(OG + o + 8 * e); }
#pragma unroll
    for (int e = 0; e < 2; ++e)
#pragma unroll
        for (int q = 0; q < 4; ++q) { const float x = bflo(a[e][q]) + bflo(b[e][q]), y = bfhi(a[e][q]) + bfhi(b[e][q]); s[8 * e + 2 * q] = x; s[8 * e + 2 * q + 1] = y; ss += x * x + y * y; }
    ss += __shfl_xor(ss, 1); ss += __shfl_xor(ss, 2); ss += __shfl_xor(ss, 4);
    const float rstd = rsqrtf(ss * (1.f / 128.f) + EPS);
#pragma unroll
    for (int e = 0; e < 2; ++e) { v4u ov;
#pragma unroll
        for (int q = 0; q < 4; ++q) { const f32x2 gn = *(const f32x2*)(gain + 16 * lane + 8 * e + 2 * q);
            ov[q] = cvt_pk_bf16(s[8 * e + 2 * q] * rstd * gn.x * bflo(gq[e][q]), s[8 * e + 2 * q + 1] * rstd * gn.y * bfhi(gq[e][q])); }
        *(v4u*)(Ofw + o + 8 * e) = ov; }
}

#define XB_TMO      128
#define XB_XCNT(j)  (256  + 64 * (j))
#define XB_XSUB(j)  (1280 + 64 * (j))
#define XB_XGEN(j)  (2304 + 64 * (j))
#define XB_TOP      3328
#define XB_TOPGEN   3392
#define XCD_BAR_WORDS 3456
#define XB_SPIN_CAP (1u << 18)

__device__ __forceinline__ unsigned xb_ld(unsigned* p)              { return __hip_atomic_load(p, __ATOMIC_RELAXED, __HIP_MEMORY_SCOPE_AGENT); }
__device__ __forceinline__ unsigned xb_add(unsigned* p, unsigned v) { return __hip_atomic_fetch_add(p, v, __ATOMIC_RELAXED, __HIP_MEMORY_SCOPE_AGENT); }
__device__ __forceinline__ unsigned xb_xcc_id() { return (unsigned)__builtin_amdgcn_s_getreg((3 << 11) | 20) & 0xFu; }
#define XB_SPIN(cond, bar) do { unsigned _sp = 0; while (cond) { __builtin_amdgcn_s_sleep(1); \
    if ((++_sp & 255u) == 0u) { if (xb_ld(&(bar)[XB_TMO])) break; if (_sp > XB_SPIN_CAP) { atomicAdd(&(bar)[XB_TMO], 1u); break; } } } } while (0)

struct XcdBarrier {
    unsigned* bar; unsigned x;
    volatile LAS unsigned* st;
};

__device__ __forceinline__ XcdBarrier xcd_barrier_post(unsigned* bar, volatile LAS unsigned* st) {
    XcdBarrier b; b.bar = bar; b.x = xb_xcc_id(); b.st = st;
    if (threadIdx.x == 0) (void)xb_add(&bar[XB_XCNT(b.x)], 1u);
    return b;
}
__device__ __forceinline__ void xcd_barrier_complete(unsigned* bar, unsigned x, unsigned& nloc, unsigned& nx) {
    const unsigned G = gridDim.x * gridDim.y * gridDim.z;
    unsigned sum, cnt, mine, sp = 0u;
    for (;;) {
        sum = 0u; cnt = 0u; mine = 0u;
#pragma unroll
        for (unsigned j = 0; j < 16; ++j) { const unsigned c = xb_ld(&bar[XB_XCNT(j)]); sum += c; cnt += (c > 0u) ? 1u : 0u; mine = (j == x) ? c : mine; }
        if (sum == G) break;
        __builtin_amdgcn_s_sleep(1);
        if ((++sp & 255u) == 0u) { if (xb_ld(&bar[XB_TMO])) break; if (sp > XB_SPIN_CAP) { atomicAdd(&bar[XB_TMO], 1u); break; } }
    }
    nloc = mine > 0u ? mine : 1u; nx = cnt > 0u ? cnt : 1u;
}

__device__ __forceinline__ void xcd_barrier(const XcdBarrier& b) {
    asm volatile("s_waitcnt vmcnt(0)" ::: "memory");
    __syncthreads();
    if (threadIdx.x == 0) {
        unsigned* bar = b.bar;
        __builtin_amdgcn_s_waitcnt(0);
        unsigned nloc = b.st[0], nx = b.st[1];
        if (nloc == 0u) { xcd_barrier_complete(bar, b.x, nloc, nx); b.st[0] = nloc; b.st[1] = nx; }
        const unsigned old = xb_add(&bar[XB_XSUB(b.x)], 1u);
        const unsigned gen = old / nloc;
        if (old + 1u == (gen + 1u) * nloc) {
            __builtin_amdgcn_fence(__ATOMIC_RELEASE, "agent");
            asm volatile("s_waitcnt vmcnt(0)" ::: "memory");
            const unsigned og = xb_add(&bar[XB_TOP], 1u);
            const unsigned tg = og / nx;
            if (og + 1u == (tg + 1u) * nx) xb_add(&bar[XB_TOPGEN], 1u);
            else XB_SPIN(xb_ld(&bar[XB_TOPGEN]) == tg, bar);
            __builtin_amdgcn_fence(__ATOMIC_ACQUIRE, "agent");
            xb_add(&bar[XB_XGEN(b.x)], 1u);
            asm volatile("s_waitcnt vmcnt(0)" ::: "memory");
        } else {
            XB_SPIN(xb_ld(&bar[XB_XGEN(b.x)]) == gen, bar);
            __builtin_amdgcn_fence(__ATOMIC_ACQUIRE, "agent");
            asm volatile("s_waitcnt vmcnt(0)" ::: "memory");
        }
    }
    __syncthreads();
}

struct Args { const float* in[15]; float* out; unsigned char* ws; int ph_lo, ph_hi; };

__global__ void __launch_bounds__(NTHR, 2) fwd(Args a) {
    extern __shared__ __attribute__((aligned(16))) unsigned char lds_raw[];
    LAS unsigned char* lds = (LAS unsigned char*)lds_raw;
    const int G = gridDim.x, bid = blockIdx.x, NGW = G * NWAVES;
    volatile LAS unsigned* MISC = (volatile LAS unsigned*)(lds + LDS_RING);
    if (threadIdx.x < 16) MISC[threadIdx.x] = 0u;
    __syncthreads();
    XcdBarrier xbar; xbar.bar = (unsigned*)a.ws; xbar.x = 0; xbar.st = nullptr;
    if (a.ph_hi - a.ph_lo > 1) xbar = xcd_barrier_post((unsigned*)a.ws, MISC);
    const float* x = a.in[0]; const float* w_in = a.in[1]; const float* ln_mix = a.in[2]; const float* ln_mlp = a.in[3]; const float* sg_norm = a.in[4];
    const float* w_s = a.in[5]; const float* b_s = a.in[6]; const float* lb_logits = a.in[7]; const float* rec_norm = a.in[8];
    const float* w_pa = a.in[9]; const float* w_pb = a.in[10]; const float* w_out = a.in[11]; const float* w_up = a.in[12]; const float* w_down = a.in[13]; const float* ln_final = a.in[14];
#define BUF(i) ((bf16*)(ws + WS_BUF(i)))
    for (int p = a.ph_lo; p < a.ph_hi; ++p) {
        if (p > a.ph_lo) { asm volatile("s_waitcnt vmcnt(0)" ::: "memory");
#ifdef PROBE_SYNC
            const unsigned long long ts0 = __builtin_amdgcn_s_memrealtime();
#endif
            if (p == a.ph_lo + 1) cg::this_grid().sync(); else xcd_barrier(xbar);
#ifdef PROBE_SYNC
            { const unsigned long long ts1 = __builtin_amdgcn_s_memrealtime(); if (blockIdx.x == PROBE_SYNC_BLK && threadIdx.x == 0) { float* pp = (float*)(a.ws + 32768); const float prev = (p == a.ph_lo + 1) ? 0.f : *(volatile float*)pp; *pp = prev + (float)(ts1 - ts0) * (1.0f / PROBE_DIV); } }
#endif
            }
        int tid = threadIdx.x; asm volatile("" : "+v"(tid));
        const int lane = tid & 63, wave = __builtin_amdgcn_readfirstlane(tid >> 6), gw = bid * NWAVES + wave;
        unsigned char* ws = a.ws; asm volatile("" : "+s"(ws));
        float* out = a.out; asm volatile("" : "+s"(out));
        float* LB = (float*)(ws + WS_LB); float* RSQ = (float*)(ws + WS_RSQ);
        bf16* WIN = (bf16*)(ws + WS_WIN); bf16* WPA = (bf16*)(ws + WS_WPA); bf16* WPB = (bf16*)(ws + WS_WPB); bf16* WOUT = (bf16*)(ws + WS_WOUT);
        bf16* WUP = (bf16*)(ws + WS_WUP); bf16* WDN = (bf16*)(ws + WS_WDN);
#ifdef DBG_NRUN
        if (p == DBG_NRUN) {
            for (size_t i = (size_t)bid * NTHR + tid; i < (size_t)M * DM; i += (size_t)G * NTHR) { float s = (DBG_NRUN >= 8) ? out[i] : 0.f;
                for (int k = 0; k < 8; ++k) s += bflo((unsigned)((const bf16*)(ws + WS_BUF(k)))[i]); out[i] = s; }
            continue;
        }
        if (p > DBG_NRUN) continue;
#endif
        if (p == NPH - 1) {
            for (int m = gw; m < M; m += NGW) rms_row_f32(out + (size_t)m * DM, ln_final, out + (size_t)m * DM, lane);
            continue;
        }
        const int l = p / PH_PER_LAYER, j = p % PH_PER_LAYER;
#ifdef PROBE_PH
        unsigned long long t0p = 0; if ((PROBE_PH >> j) & 1) t0p = __builtin_amdgcn_s_memrealtime();
#endif
        const float* hin = (l == 0) ? x : out;
#ifndef PHASE_MASK
#define PHASE_MASK 0x7ff
#endif
        if (!((PHASE_MASK >> j) & 1)) continue;
        switch (j) {
        case 0: {
#ifdef DBG_FILL
            if (l == 0) { v4u* fp = (v4u*)(ws + WS_BUF(1)); const size_t n16 = (size_t)7 * BUFB / 16; for (size_t i = (size_t)bid * NTHR + tid; i < n16; i += (size_t)G * NTHR) fp[i] = (v4u){DBG_FILL, DBG_FILL, DBG_FILL, DBG_FILL}; }
#endif
            convert_weight(w_in + (size_t)l * DM * NIN, DM, NIN, WIN, lds, gw, NGW, wave, lane);
            convert_weight(w_pa + (size_t)l * DM * DM, DM, DM, WPA, lds, gw, NGW, wave, lane);
            convert_weight(w_pb + (size_t)l * DM * DM, DM, DM, WPB, lds, gw, NGW, wave, lane);
            convert_weight(w_out + (size_t)l * DM * DM, DM, DM, WOUT, lds, gw, NGW, wave, lane);
            for (int i = bid * NTHR + tid; i < 2 * DM; i += G * NTHR) { LB[i] = 0.f; LB[2 * DM + i] = 1.f / (1.f + __expf(lb_logits[i] - lb_logits[2 * DM + i])); }
            if (l == 0) {
                for (int i = bid * NTHR + tid; i < 3 * M; i += G * NTHR) RSQ[i] = 0.f;
                for (int m = gw; m < M; m += NGW) rms_row_bf16(hin + (size_t)m * DM, ln_mix + l * DM, BUF(0) + (size_t)m * DM, lane);
            }
            __syncthreads();
        } break;
        case 1: {
#define PROJ(MA, MB, split, sec0, bufi, lbp) { pg8::Gemm g{BUF(0), WIN + (size_t)(sec0) * DM * DM, M, 3 * DM, DM}; pg8::StaticOrder S; S.init(M, 3 * DM, G, bid); \
            pg8::EpiProj<MA, MB> E{BUF(bufi), (size_t)M * DM, lbp, (l == 0) ? (const float*)nullptr : (const float*)(RSQ + M), split}; pg8::gemm_phase<pg8::EpiProj<MA, MB>, pg8::StaticOrder, PROJ_ALIGN, true>(lds, g, S, E); }
            PROJ(0, 1, 2, 0, 1, LB) PROJ(2, 3, 2, 3, 4, LB + (size_t)l * 2 * DM)
        } break;
        case 2: sg_phase(lds, BUF(1), BUF(2), w_s + (size_t)l * 8 * 16384, b_s + (size_t)l * 1024, sg_norm + (size_t)l * DM, bid, G); break;
        case 3: hg_phase(lds, BUF(3), BUF(4), BUF(5), BUF(6), BUF(2), BUF(7), bid, G); break;
        case 4: {
            PROJ(3, 4, 1, 6, 3, LB)
        } break;
        case 5: {
            convert_weight(w_up + (size_t)l * DM * DFF, DM, DFF, WUP, lds, gw, NGW, wave, lane);
            convert_weight(w_down + (size_t)l * DFF * DM, DFF, DM, WDN, lds, gw, NGW, wave, lane);
            for (int m = gw; m < M; m += NGW) cb_row(BUF(2), BUF(7), BUF(3), rec_norm + (size_t)l * DM, (size_t)m, lane);
            __syncthreads();
        } break;
        case 6: {
            pg8::Gemm g{BUF(1), WPA, 2 * M, 2 * DM, DM}; pg8::PairOrder S; S.init(M, DM, G, bid); pg8::EpiGate E{BUF(4), BUF(5)};
            pg8::gemm_phase<pg8::EpiGate, pg8::PairOrder, true, true>(lds, g, S, E);
        } break;
        case 7: {
            pg8::Gemm g{BUF(4), WOUT, M, DM, DM}; pg8::StaticOrder S; S.init(M, DM, G, bid); pg8::EpiResid E{(l == 0) ? x : (const float*)nullptr, BUF(0), ln_mix + DM, (float*)nullptr, BUF(0), ln_mlp + l * DM, RSQ + (size_t)(l == 0 ? 0 : 2) * M};

            pg8::gemm_phase<pg8::EpiResid, pg8::StaticOrder, false, true>(lds, g, S, E);
        } break;
        case 8: {
            pg8::Gemm g{BUF(0), WUP, M, DFF, DM}; pg8::StaticOrder S; S.init(M, DFF, G, bid); pg8::EpiRelu2 E{BUF(1), DFF, RSQ + (size_t)(l == 0 ? 0 : 2) * M};
            pg8::gemm_phase<pg8::EpiRelu2, pg8::StaticOrder, true, true>(lds, g, S, E);
        } break;
        case 9: {
            pg8::Gemm g{BUF(1), WDN, M, DM, DFF}; pg8::StaticOrder S; S.init(M, DM, G, bid); pg8::EpiResid E{(const float*)nullptr, BUF(0), ln_mlp + l * DM, (l == 0) ? (float*)nullptr : out, (l == 0) ? BUF(0) : (bf16*)nullptr, ln_mix + DM, RSQ + M};
            pg8::gemm_phase<pg8::EpiResid, pg8::StaticOrder, false, true>(lds, g, S, E);
        } break;
        }
#ifdef PROBE_PH
        if ((PROBE_PH >> j) & 1) { asm volatile("s_waitcnt vmcnt(0)" ::: "memory"); __syncthreads(); const unsigned long long t1p = __builtin_amdgcn_s_memrealtime();
#ifdef PROBE_MAX
            if (tid == 0) atomicMax((unsigned*)(ws + 32768) + 1 + p, (unsigned)(t1p - t0p));
#else
            if (bid == 0 && tid == 0) atomicAdd((unsigned*)(ws + 32768) + 1 + p, (unsigned)(t1p - t0p));
#endif
        }
#endif
    }
#if defined(PROBE_PH)
    if (bid == 0 && threadIdx.x == 0) { asm volatile("s_waitcnt vmcnt(0)" ::: "memory"); unsigned s = 0; for (int q = 0; q < NPH; ++q) s += __hip_atomic_load((unsigned*)(a.ws + 32768) + 1 + q, __ATOMIC_RELAXED, __HIP_MEMORY_SCOPE_AGENT); a.out[0] = (float)s * (1.0f / PROBE_DIV); }
#elif defined(PROBE_SYNC)
    if (bid == 0 && threadIdx.x == 0) { asm volatile("s_waitcnt vmcnt(0)" ::: "memory"); a.out[0] = *(volatile float*)(a.ws + 32768); }
#endif
#undef BUF
}

extern "C" void kernel_launch(void* const* d_in, const int* in_sizes, int n_in, void* d_out, int out_size, void* d_ws, size_t ws_size, hipStream_t stream) {
    static int grid = 0;
    if (grid == 0) {
        if (n_in != 15 || out_size != M * DM || ws_size < WS_END) { fprintf(stderr, "kernel_launch: unexpected problem (n_in %d, out %d, ws %zu < %zu)\n", n_in, out_size, ws_size, (size_t)WS_END); grid = -1; return; }
        int dev = 0, cus = 0, per_cu = 0;
        hipGetDevice(&dev); hipDeviceGetAttribute(&cus, hipDeviceAttributeMultiprocessorCount, dev);
        if (hipFuncSetAttribute((const void*)fwd, hipFuncAttributeMaxDynamicSharedMemorySize, LDS_BYTES) != hipSuccess) { fprintf(stderr, "kernel_launch: hipFuncSetAttribute failed\n"); grid = -1; return; }
        if (hipOccupancyMaxActiveBlocksPerMultiprocessor(&per_cu, (const void*)fwd, NTHR, LDS_BYTES) != hipSuccess || per_cu < 1) { fprintf(stderr, "kernel_launch: occupancy query says %d\n", per_cu); per_cu = 1; }
        (void)hipGetLastError();
        grid = cus;
    }
    if (grid < 0) return;
#if defined(PROBE_PH)
    (void)hipMemsetAsync((char*)d_ws + 32768, 0, 512, stream);
#endif
    (void)hipMemsetAsync(d_ws, 0, 16384, stream);
    Args a{};
    for (int i = 0; i < 15; ++i) a.in[i] = (const float*)d_in[i];
    a.out = (float*)d_out; a.ws = (unsigned char*)d_ws;
#if ONE_LAUNCH
    a.ph_lo = 0; a.ph_hi = NPH;
    void* args[] = {&a};
    hipError_t e = hipLaunchCooperativeKernel((const void*)fwd, dim3(grid), dim3(NTHR), args, LDS_BYTES, stream);
    if (e != hipSuccess) fprintf(stderr, "cooperative launch failed: %s (grid %d)\n", hipGetErrorString(e), grid);
#else
    for (int p = 0; p < NPH; ++p) { a.ph_lo = p; a.ph_hi = p + 1; hipLaunchKernelGGL(fwd, dim3(grid), dim3(NTHR), LDS_BYTES, stream, a); }
#endif
}
```

```cpp
#define ONE_LAUNCH 1
#include <hip/hip_runtime.h>
#include <hip/hip_cooperative_groups.h>
#include <cstdio>
#include <cstdint>
namespace cg = cooperative_groups;
namespace pg8 {
#define PG8_LAS __attribute__((address_space(3)))
typedef unsigned short bf16_t;
typedef short bf16x8 __attribute__((ext_vector_type(8)));
typedef float f32x4 __attribute__((ext_vector_type(4)));
typedef unsigned u32x4 __attribute__((ext_vector_type(4)));
constexpr int BM = 256, BK = 64, HALF = 128, HTB = HALF * BK * 2  , STAGE_BYTES = 8 * HTB, NXCD = 8, WGM = 8;

__host__ __device__ __forceinline__ int lds_byte(int r, int c) { const int st = (r >> 4) * 2 + (c >> 5), rr = r & 15, cc = c & 31, ob = rr * 64 + cc * 2; return st * 1024 + (ob ^ (((ob >> 9) & 1) << 5)); }
__host__ __device__ __forceinline__ void stage_rc(int b, int& R, int& C) { const int st = b / 1024, sb = b % 1024, swz = sb ^ (((sb >> 9) & 1) << 5); R = (st >> 1) * 16 + swz / 64; C = (st & 1) * 32 + (swz % 64) / 2; }
__host__ __device__ __forceinline__ int perm32(int rho) { const int n = rho >> 4, i = rho & 15; return 8 * (i >> 2) + 4 * n + (i & 3); }

struct Unit { int pm, pn; };
struct Gemm { const bf16_t* A; const bf16_t* Bt; int M, N, K; };

struct StaticOrder {
    int nM, nN, nwg, G, c;
    __host__ __device__ void init(int M, int N, int G_, int c_) { nM = M / BM; nN = N / BM; nwg = nM * nN; G = G_; c = c_; }
    __host__ __device__ bool next(int i, Unit& u) const {
        const long L = (long)i * G + c; if (L >= nwg) return false;
        int wgid = (int)L; { const int q = nwg / NXCD, r = nwg % NXCD, xcd = wgid % NXCD, off = wgid / NXCD; wgid = (xcd < r ? xcd * (q + 1) : r * (q + 1) + (xcd - r) * q) + off; }
        const int nig = WGM * nN, gid = wgid / nig, fm = gid * WGM, gsz = (nM - fm) < WGM ? (nM - fm) : WGM;
        u.pm = fm + ((wgid % nig) % gsz); u.pn = (wgid % nig) / gsz; return true;
    }
    __device__ __forceinline__ void a_ready(const Unit&) const {}
    __device__ __forceinline__ void done(const Unit&) const {}
};

typedef float cvt_f32x2_t __attribute__((ext_vector_type(2)));
typedef __bf16 cvt_bf16x2_t __attribute__((ext_vector_type(2)));
__device__ __forceinline__ unsigned cvt_pk_bf16(float lo, float hi) { cvt_f32x2_t v = {lo, hi}; cvt_bf16x2_t b = __builtin_convertvector(v, cvt_bf16x2_t); return __builtin_bit_cast(unsigned, b); }
typedef float f32x2 __attribute__((ext_vector_type(2)));
__device__ __forceinline__ f32x2 gelu_pk(f32x2 v) {
    const f32x2 av = __builtin_elementwise_abs(v), d = av * 0.2316418882f + 1.0f;
    f32x2 t; t.x = __builtin_amdgcn_rcpf(d.x); t.y = __builtin_amdgcn_rcpf(d.y);
    f32x2 q = t * 0.5307027145f + (-0.7265760135f); q = q * t + 0.7107068705f; q = q * t + (-0.142248368f); q = q * t + 0.127414796f; q = q * t;
    const f32x2 s = (v * v) * (-0.72134752044f);
    f32x2 e; e.x = __builtin_amdgcn_exp2f(s.x); e.y = __builtin_amdgcn_exp2f(s.y);
    const f32x2 m = v * (q * e), r = v - m;
    f32x2 o; o.x = v.x < 0.f ? m.x : r.x; o.y = v.y < 0.f ? m.y : r.y; return o;
}
__device__ __forceinline__ float bflo(unsigned u) { return __builtin_bit_cast(float, u << 16); }
__device__ __forceinline__ float bfhi(unsigned u) { return __builtin_bit_cast(float, u & 0xffff0000u); }
__device__ __forceinline__ float sigm(float z) { return __builtin_amdgcn_rcpf(1.0f + __expf(-z)); }
template <int MA, int MB> struct EpiProj {
    static constexpr bool PERM = true, AFTER_DRAIN = false;
    bf16_t* out0; size_t sec_stride; const float* lb; const float* rowsq; int split;
    template <int MODE> __device__ __forceinline__ void run(const f32x4 (&acc)[2][2][4][2], bf16_t* base, const float* lbrow, int row0, int col0) const {
#pragma unroll
        for (int ai = 0; ai < 2; ++ai)
#pragma unroll
            for (int m = 0; m < 4; ++m) { bf16_t* rowp = base + (size_t)(row0 + ai * HALF + m * 16) * 1024 + col0;
                const float rs = rowsq ? rsqrtf(rowsq[row0 + ai * HALF + m * 16] * (1.0f / 1024.0f) + 1e-6f) : 1.0f;
#pragma unroll
                for (int bj = 0; bj < 2; ++bj) { f32x4 v[2] = {acc[ai][bj][m][0] * rs, acc[ai][bj][m][1] * rs};
#pragma unroll
                    for (int n = 0; n < 2; ++n) {
                        if (MODE == 0) { f32x2 a = gelu_pk((f32x2){v[n][0], v[n][1]}), b = gelu_pk((f32x2){v[n][2], v[n][3]}); v[n] = (f32x4){a.x, a.y, b.x, b.y}; }
                        else if (MODE == 2) { const f32x4 lbv = *(const f32x4*)(lbrow + bj * HALF + 4 * n);
#pragma unroll
                            for (int e = 0; e < 4; ++e) { const float l = lbv[e]; const float f = l + (1.0f - l) * sigm(v[n][e]); v[n][e] = __log2f(f); }
                        } else if (MODE == 3) {
#pragma unroll
                            for (int e = 0; e < 4; ++e) v[n][e] = v[n][e] * sigm(v[n][e]);
                        } else if (MODE == 4) {
#pragma unroll
                            for (int e = 0; e < 4; ++e) v[n][e] = sigm(v[n][e]);
                        }
                    }
                    u32x4 w; w.x = cvt_pk_bf16(v[0][0], v[0][1]); w.y = cvt_pk_bf16(v[0][2], v[0][3]); w.z = cvt_pk_bf16(v[1][0], v[1][1]); w.w = cvt_pk_bf16(v[1][2], v[1][3]);
                    *(u32x4*)(rowp + bj * HALF) = w; } }
    }
    __device__ __forceinline__ void operator()(const f32x4 (&acc)[2][2][4][2], const Unit& u, int wr, int wc, int fr, int fq) const {
        const int colt = u.pn * BM, sec = colt >> 10;
        bf16_t* base = out0 + (size_t)sec * sec_stride;
        const int col0 = (colt & 1023) + wc * 32 + 8 * fq, row0 = u.pm * BM + wr * 64 + fr;
        const float* lbrow = lb + sec * 1024 + col0;
        if (sec < split) run<MA>(acc, base, lbrow, row0, col0); else run<MB>(acc, base, lbrow, row0, col0);
    }
};
struct EpiGate {
    static constexpr bool PERM = true, AFTER_DRAIN = false;
    bf16_t* T; const bf16_t* gate2;
    __device__ __forceinline__ void operator()(const f32x4 (&acc)[2][2][4][2], const Unit& u, int wr, int wc, int fr, int fq) const {
        const bool second = u.pm >= 64;
        const int col0 = (u.pn & 3) * BM + wc * 32 + 8 * fq, row0 = (u.pm & 63) * BM + wr * 64 + fr;
        const bf16_t* gate = second ? gate2 : T;
#pragma unroll
        for (int ai = 0; ai < 2; ++ai)
#pragma unroll
            for (int m = 0; m < 4; ++m) { asm volatile("" ::: "memory"); __builtin_amdgcn_sched_barrier(0); const size_t ro = (size_t)(row0 + ai * HALF + m * 16) * 1024 + col0;
#pragma unroll
                for (int bj = 0; bj < 2; ++bj) {
                    const u32x4 gv = *(const u32x4*)(gate + ro + bj * HALF);
                    u32x4 av = (u32x4){0u, 0u, 0u, 0u}; if (second) av = *(const u32x4*)(T + ro + bj * HALF);
                    const f32x4 v0 = acc[ai][bj][m][0], v1 = acc[ai][bj][m][1];
                    u32x4 w;
                    w.x = cvt_pk_bf16(bflo(av.x) + bflo(gv.x) * v0[0], bfhi(av.x) + bfhi(gv.x) * v0[1]);
                    w.y = cvt_pk_bf16(bflo(av.y) + bflo(gv.y) * v0[2], bfhi(av.y) + bfhi(gv.y) * v0[3]);
                    w.z = cvt_pk_bf16(bflo(av.z) + bflo(gv.z) * v1[0], bfhi(av.z) + bfhi(gv.z) * v1[1]);
                    w.w = cvt_pk_bf16(bflo(av.w) + bflo(gv.w) * v1[2], bfhi(av.w) + bfhi(gv.w) * v1[3]);
                    *(u32x4*)(T + ro + bj * HALF) = w; } }
    }
};
struct PairOrder {
    StaticOrder S;
    __device__ void init(int M_, int N_, int G_, int c_) { S.init(M_, N_, G_, c_); }
    __device__ bool next(int i, Unit& u) const { if (!S.next(i >> 1, u)) return false; if (i & 1) { u.pm += 64; u.pn += 4; } return true; }
    __device__ __forceinline__ void a_ready(const Unit&) const {}
    __device__ __forceinline__ void done(const Unit&) const {}
};
struct EpiResid {
    static constexpr bool PERM = true, AFTER_DRAIN = false;
    const float* base32; const bf16_t* xg_in; const float* gain_in; float* out32; bf16_t* xg_out; const float* gain_out; float* rowsq;
    __device__ __forceinline__ void operator()(const f32x4 (&acc)[2][2][4][2], const Unit& u, int wr, int wc, int fr, int fq) const {
        const int col0 = u.pn * BM + wc * 32 + 8 * fq, row0 = u.pm * BM + wr * 64 + fr;
#pragma unroll
        for (int ai = 0; ai < 2; ++ai)
#pragma unroll
            for (int m = 0; m < 4; ++m) { asm volatile("" ::: "memory"); __builtin_amdgcn_sched_barrier(0); const int row = row0 + ai * HALF + m * 16; const size_t ro = (size_t)row * 1024 + col0; float ss = 0.f;
#pragma unroll
                for (int bj = 0; bj < 2; ++bj) { f32x4 h[2];
                    if (base32) { h[0] = *(const f32x4*)(base32 + ro + bj * HALF); h[1] = *(const f32x4*)(base32 + ro + bj * HALF + 4); }
                    else { const u32x4 xv = *(const u32x4*)(xg_in + ro + bj * HALF); const f32x4 g0 = *(const f32x4*)(gain_in + col0 + bj * HALF), g1 = *(const f32x4*)(gain_in + col0 + bj * HALF + 4);
                        h[0] = (f32x4){bflo(xv.x) * __builtin_amdgcn_rcpf(g0[0]), bfhi(xv.x) * __builtin_amdgcn_rcpf(g0[1]), bflo(xv.y) * __builtin_amdgcn_rcpf(g0[2]), bfhi(xv.y) * __builtin_amdgcn_rcpf(g0[3])};
                        h[1] = (f32x4){bflo(xv.z) * __builtin_amdgcn_rcpf(g1[0]), bfhi(xv.z) * __builtin_amdgcn_rcpf(g1[1]), bflo(xv.w) * __builtin_amdgcn_rcpf(g1[2]), bfhi(xv.w) * __builtin_amdgcn_rcpf(g1[3])}; }
#pragma unroll
                    for (int n = 0; n < 2; ++n) { h[n] = h[n] + acc[ai][bj][m][n]; if (out32) *(f32x4*)(out32 + ro + bj * HALF + 4 * n) = h[n];
                        ss += (h[n][0] * h[n][0] + h[n][1] * h[n][1]) + (h[n][2] * h[n][2] + h[n][3] * h[n][3]); }
                    if (xg_out) { const f32x4 g0 = *(const f32x4*)(gain_out + col0 + bj * HALF), g1 = *(const f32x4*)(gain_out + col0 + bj * HALF + 4);
                        u32x4 w; w.x = cvt_pk_bf16(h[0][0] * g0[0], h[0][1] * g0[1]); w.y = cvt_pk_bf16(h[0][2] * g0[2], h[0][3] * g0[3]); w.z = cvt_pk_bf16(h[1][0] * g1[0], h[1][1] * g1[1]); w.w = cvt_pk_bf16(h[1][2] * g1[2], h[1][3] * g1[3]);
                        *(u32x4*)(xg_out + ro + bj * HALF) = w; } }
                if (xg_out) { ss += __shfl_xor(ss, 16); ss += __shfl_xor(ss, 32); if (fq == 0) atomicAdd(rowsq + row, ss); } }
    }
};
struct EpiRelu2 {
    static constexpr bool PERM = true, AFTER_DRAIN = false;
    bf16_t* out; int ldc; const float* rowsq;
    __device__ __forceinline__ void operator()(const f32x4 (&acc)[2][2][4][2], const Unit& u, int wr, int wc, int fr, int fq) const {
        const int col0 = u.pn * BM + wc * 32 + 8 * fq, row0 = u.pm * BM + wr * 64 + fr;
#pragma unroll
        for (int ai = 0; ai < 2; ++ai)
#pragma unroll
            for (int m = 0; m < 4; ++m) { asm volatile("" ::: "memory"); __builtin_amdgcn_sched_barrier(0); bf16_t* rowp = out + (size_t)(row0 + ai * HALF + m * 16) * ldc + col0;
                const float rs = rsqrtf(rowsq[row0 + ai * HALF + m * 16] * (1.0f / 1024.0f) + 1e-6f);
#pragma unroll
                for (int bj = 0; bj < 2; ++bj) { f32x4 v0 = acc[ai][bj][m][0] * rs, v1 = acc[ai][bj][m][1] * rs;
#pragma unroll
                    for (int e = 0; e < 4; ++e) { const float a = fmaxf(v0[e], 0.f), b = fmaxf(v1[e], 0.f); v0[e] = a * a; v1[e] = b * b; }
                    u32x4 w; w.x = cvt_pk_bf16(v0[0], v0[1]); w.y = cvt_pk_bf16(v0[2], v0[3]); w.z = cvt_pk_bf16(v1[0], v1[1]); w.w = cvt_pk_bf16(v1[2], v1[3]);
                    *(u32x4*)(rowp + bj * HALF) = w; } }
    }
};
template <class Epi, class Sched, bool ALIGN_EPI = false, bool SP2 = false>
__device__ __forceinline__ void gemm_phase(PG8_LAS unsigned char* lds, const Gemm g, const Sched& S, const Epi& E) {
    int tid_l = threadIdx.x; asm volatile("" : "+v"(tid_l));
    const int tid = tid_l, wid = __builtin_amdgcn_readfirstlane(tid >> 6), lane = tid & 63, wr = wid >> 2, wc = wid & 3, fr = lane & 15, fq = lane >> 4;
    const int K = g.K, nt = K / BK;
    unsigned voffA[2], voffB[2];
#pragma unroll
    for (int i = 0; i < 2; ++i) { int R, C; stage_rc(tid * 16 + i * 8192, R, C); const int Rb = Epi::PERM ? ((R & ~31) + perm32(R & 31)) : R;
        voffA[i] = (unsigned)(R * K + C) * 2u; voffB[i] = (unsigned)(Rb * K + C) * 2u; }
    const size_t kstep = (size_t)(BK * 2);
    const size_t hstep = (size_t)HALF * K * 2;
    const size_t tstep = 2 * hstep;
    const unsigned ldsw = (unsigned)wid * 1024u;
    const int aoff = lds_byte(wr * 64 + fr, fq * 8), boff = lds_byte(wc * 32 + fr, fq * 8);
#define PG8_SA(b, h) (((b) * 2 + (h)) * HTB)
#define PG8_SB(b, h) ((4 + (b) * 2 + (h)) * HTB)
#define PG8_STAGE(bufoff, gbase, voff) do { _Pragma("unroll") for (int _i = 0; _i < 2; ++_i) \
        __builtin_amdgcn_global_load_lds((const unsigned*)((const char*)(gbase) + (voff)[_i]), (PG8_LAS unsigned*)(lds + (bufoff) + ldsw + _i * 8192), 16, 0, 0); } while (0)
#define PG8_LDA(dst, b, h) do { _Pragma("unroll") for (int m = 0; m < 4; ++m) _Pragma("unroll") for (int k = 0; k < 2; ++k) dst[m][k] = *(const PG8_LAS bf16x8*)(lds + PG8_SA(b, h) + aoff + m * 2048 + k * 1024); } while (0)
#define PG8_LDB(dst, b, h) do { _Pragma("unroll") for (int n = 0; n < 2; ++n) _Pragma("unroll") for (int k = 0; k < 2; ++k) dst[n][k] = *(const PG8_LAS bf16x8*)(lds + PG8_SB(b, h) + boff + n * 2048 + k * 1024); } while (0)
#define PG8_MMA(ai, bj, At, Bt) do { __builtin_amdgcn_s_setprio(1); _Pragma("unroll") for (int m = 0; m < 4; ++m) _Pragma("unroll") for (int n = 0; n < 2; ++n) _Pragma("unroll") for (int k = 0; k < 2; ++k) \
        acc[ai][bj][m][n] = __builtin_amdgcn_mfma_f32_16x16x32_bf16(Bt[n][k], At[m][k], acc[ai][bj][m][n], 0, 0, 0); __builtin_amdgcn_s_setprio(0); } while (0)
#define PG8_WAIT_V(n) asm volatile("s_waitcnt vmcnt(" #n ")" ::: "memory")
#define PG8_WAIT_L(n) asm volatile("s_waitcnt lgkmcnt(" #n ")" ::: "memory")
#define PG8_BAR __builtin_amdgcn_s_barrier()
#define PG8_SCHED __builtin_amdgcn_sched_barrier(0)
    Unit cur, nxt; int ui = 0;
    if (!S.next(0, cur)) return;
    f32x4 acc[2][2][4][2];
#pragma unroll
    for (int a = 0; a < 2; ++a)
#pragma unroll
        for (int b = 0; b < 2; ++b)
#pragma unroll
            for (int m = 0; m < 4; ++m)
#pragma unroll
                for (int n = 0; n < 2; ++n) acc[a][b][m][n] = (f32x4){0.f, 0.f, 0.f, 0.f};
    bf16x8 At[4][2], B0[2][2], B1[2][2];
    const char* cA = (const char*)g.A + (size_t)cur.pm * tstep; const char* cB = (const char*)g.Bt + (size_t)cur.pn * tstep;
    S.a_ready(cur);
    if constexpr (SP2) {
        PG8_STAGE(PG8_SB(0, 0), cB, voffB); PG8_STAGE(PG8_SB(0, 1), cB + hstep, voffB); PG8_STAGE(PG8_SA(0, 0), cA, voffA); PG8_STAGE(PG8_SA(0, 1), cA + hstep, voffA);
        if (wr == 1) PG8_BAR;
        PG8_WAIT_V(2); PG8_BAR;
        PG8_STAGE(PG8_SB(1, 0), cB + kstep, voffB); PG8_STAGE(PG8_SA(1, 0), cA + kstep, voffA); PG8_STAGE(PG8_SB(1, 1), cB + hstep + kstep, voffB);
        PG8_WAIT_V(6); PG8_BAR;
    } else {
        PG8_STAGE(PG8_SB(0, 0), cB, voffB); PG8_STAGE(PG8_SA(0, 0), cA, voffA); PG8_STAGE(PG8_SB(0, 1), cB + hstep, voffB); PG8_STAGE(PG8_SA(0, 1), cA + hstep, voffA);
        if (wr == 1) PG8_BAR;
        PG8_WAIT_V(4); PG8_BAR;
        PG8_STAGE(PG8_SB(1, 0), cB + kstep, voffB); PG8_STAGE(PG8_SA(1, 0), cA + kstep, voffA); PG8_STAGE(PG8_SB(1, 1), cB + hstep + kstep, voffB);
        PG8_WAIT_V(6); PG8_BAR;
    }
    for (;;) {
        const bool has_next = S.next(ui + 1, nxt);
        const char* nA = has_next ? (const char*)g.A + (size_t)nxt.pm * tstep : cA; const char* nB = has_next ? (const char*)g.Bt + (size_t)nxt.pn * tstep : cB;
        for (int t = 0; t < nt; t += 2) {
            const bool last = (t == nt - 2);
            const char* a1 = cA + (size_t)(t + 1) * kstep;
            const char* a2 = last ? nA : cA + (size_t)(t + 2) * kstep; const char* b2 = last ? nB : cB + (size_t)(t + 2) * kstep;
            const char* a3 = a2 + kstep; const char* b3 = b2 + kstep;
            if (last && has_next) S.a_ready(nxt);
            if constexpr (SP2) {
            PG8_LDB(B0, 0, 0); PG8_LDB(B1, 0, 1); PG8_SCHED; PG8_LDA(At, 0, 0); PG8_STAGE(PG8_SA(1, 1), a1 + hstep, voffA);
            PG8_WAIT_V(8); PG8_WAIT_L(0); PG8_BAR; PG8_MMA(0, 0, At, B0); PG8_MMA(0, 1, At, B1); PG8_BAR; PG8_SCHED;
            PG8_LDA(At, 0, 1); PG8_STAGE(PG8_SB(0, 0), b2, voffB); PG8_STAGE(PG8_SB(0, 1), b2 + hstep, voffB); PG8_STAGE(PG8_SA(0, 0), a2, voffA);
            PG8_WAIT_V(8); PG8_WAIT_L(0); PG8_BAR; PG8_MMA(1, 0, At, B0); PG8_MMA(1, 1, At, B1); PG8_BAR; PG8_SCHED;
            PG8_LDB(B0, 1, 0); PG8_LDB(B1, 1, 1); PG8_SCHED; PG8_LDA(At, 1, 0); PG8_STAGE(PG8_SA(0, 1), a2 + hstep, voffA);
            PG8_WAIT_V(8); PG8_WAIT_L(0); PG8_BAR; PG8_MMA(0, 0, At, B0); PG8_MMA(0, 1, At, B1); PG8_BAR; PG8_SCHED;
            PG8_LDA(At, 1, 1); PG8_STAGE(PG8_SB(1, 0), b3, voffB); PG8_STAGE(PG8_SB(1, 1), b3 + hstep, voffB); PG8_STAGE(PG8_SA(1, 0), a3, voffA);
            PG8_WAIT_V(8); PG8_WAIT_L(0); PG8_BAR; PG8_MMA(1, 0, At, B0); PG8_MMA(1, 1, At, B1); PG8_BAR; PG8_SCHED;
            } else {
            PG8_LDB(B0, 0, 0); PG8_SCHED; PG8_LDA(At, 0, 0); PG8_STAGE(PG8_SA(1, 1), a1 + hstep, voffA);
            PG8_WAIT_L(8); PG8_BAR; PG8_WAIT_L(0); PG8_MMA(0, 0, At, B0); PG8_BAR; PG8_SCHED;
            PG8_LDB(B1, 0, 1); PG8_STAGE(PG8_SB(0, 0), b2, voffB);
            PG8_BAR; PG8_WAIT_L(0); PG8_MMA(0, 1, At, B1); PG8_BAR;
            PG8_LDA(At, 0, 1); PG8_STAGE(PG8_SA(0, 0), a2, voffA);
            PG8_BAR; PG8_WAIT_L(0); PG8_MMA(1, 0, At, B0); PG8_BAR; PG8_SCHED;
            PG8_STAGE(PG8_SB(0, 1), b2 + hstep, voffB);
            PG8_WAIT_V(6); PG8_BAR; PG8_MMA(1, 1, At, B1); PG8_BAR;
            PG8_LDB(B0, 1, 0); PG8_SCHED; PG8_LDA(At, 1, 0); PG8_STAGE(PG8_SA(0, 1), a2 + hstep, voffA);
            PG8_WAIT_L(8); PG8_BAR; PG8_WAIT_L(0); PG8_MMA(0, 0, At, B0); PG8_BAR; PG8_SCHED;
            PG8_LDB(B1, 1, 1); PG8_STAGE(PG8_SB(1, 0), b3, voffB);
            PG8_BAR; PG8_WAIT_L(0); PG8_MMA(0, 1, At, B1); PG8_BAR;
            PG8_LDA(At, 1, 1); PG8_STAGE(PG8_SA(1, 0), a3, voffA);
            PG8_BAR; PG8_WAIT_L(0); PG8_MMA(1, 0, At, B0); PG8_BAR; PG8_SCHED;
            PG8_STAGE(PG8_SB(1, 1), b3 + hstep, voffB);
            PG8_WAIT_V(6); PG8_BAR; PG8_MMA(1, 1, At, B1); PG8_BAR;
            }
        }
        if constexpr (ALIGN_EPI) { if (wr == 0) PG8_BAR; }
        if constexpr (!Epi::AFTER_DRAIN) { E(acc, cur, wr, wc, fr, fq); S.done(cur); }
        if (!has_next) break;
#pragma unroll
        for (int a = 0; a < 2; ++a)
#pragma unroll
            for (int b = 0; b < 2; ++b)
#pragma unroll
                for (int m = 0; m < 4; ++m)
#pragma unroll
                    for (int n = 0; n < 2; ++n) acc[a][b][m][n] = (f32x4){0.f, 0.f, 0.f, 0.f};
        cur = nxt; cA = nA; cB = nB; ++ui;
        if constexpr (ALIGN_EPI) { if (wr == 1) PG8_BAR; }
    }
    PG8_WAIT_V(0);
    if constexpr (!ALIGN_EPI) { if (wr == 0) PG8_BAR; }
    PG8_BAR;
    if constexpr (Epi::AFTER_DRAIN) { E.fused(acc, cur, wr, wc, fr, fq, lds, wid, lane); S.done(cur); }
#undef PG8_SA
#undef PG8_SB
#undef PG8_STAGE
#undef PG8_LDA
#undef PG8_LDB
#undef PG8_MMA
#undef PG8_WAIT_V
#undef PG8_WAIT_L
#undef PG8_BAR
#undef PG8_SCHED
}
}

#define LAS __attribute__((address_space(3)))
typedef unsigned short bf16;
typedef unsigned v4u __attribute__((ext_vector_type(4)));
typedef unsigned v2u __attribute__((ext_vector_type(2)));
typedef float f32x4 __attribute__((ext_vector_type(4)));
typedef float f32x2 __attribute__((ext_vector_type(2)));
typedef short bf16x8 __attribute__((ext_vector_type(8)));
typedef short s16x4 __attribute__((ext_vector_type(4)));
using pg8::bflo; using pg8::bfhi; using pg8::cvt_pk_bf16;

#ifndef PROJ_ALIGN
#define PROJ_ALIGN true
#endif
#ifndef ONE_LAUNCH
#define ONE_LAUNCH 1
#endif
constexpr int DM = 1024, BATCH = 8, SEQ = 2048, M = BATCH * SEQ, NIN = 9216, DFF = 4096, DEPTH = 2;
constexpr float EPS = 1e-6f;
constexpr int NTHR = 512, NWAVES = 8;
constexpr int LDS_RING = 131072, LDS_BYTES = LDS_RING + 64;
constexpr size_t MiB = 1u << 20;
constexpr size_t WS_RSQ = 256 * 1024;
constexpr size_t WS_WSB = 512 * 1024;
constexpr size_t WS_LB = 64 * 1024;
constexpr size_t WS_WIN = 1 * MiB, WS_WPA = 19 * MiB, WS_WPB = 21 * MiB, WS_WOUT = 23 * MiB;
constexpr size_t WS_B0 = 25 * MiB, BUFB = 32 * MiB;
constexpr size_t WS_END = WS_B0 + 8 * BUFB;
#define WS_BUF(i) (WS_B0 + (size_t)(i) * BUFB)
constexpr size_t WS_WUP = WS_BUF(6), WS_WDN = WS_BUF(6) + 8 * MiB;
constexpr int PH_PER_LAYER = 10, NPH = DEPTH * PH_PER_LAYER + 1;

__device__ __forceinline__ float wave_sum(float v) {
#pragma unroll
    for (int o = 1; o < 64; o <<= 1) v += __shfl_xor(v, o);
    return v;
}
__device__ __forceinline__ void transpose_item(const float* W, int K, int N, bf16* WT, LAS float* scr, int item, int lane) {
    const int nblk = N / 32, kb = item / nblk, nb = item % nblk, k0 = 64 * kb, n0 = 32 * nb;
#pragma unroll 8
    for (int i = 0; i < 32; ++i) { const int kk = 2 * i + (lane >> 5); scr[kk * 33 + (lane & 31)] = W[(size_t)(k0 + kk) * N + n0 + (lane & 31)]; }
    asm volatile("s_waitcnt lgkmcnt(0)" ::: "memory");
    const int c = lane & 7;
#pragma unroll
    for (int j = 0; j < 4; ++j) { const int n = (lane >> 3) + 8 * j; const LAS float* s = scr + (8 * c) * 33 + n;
        v4u o; o.x = cvt_pk_bf16(s[0 * 33], s[1 * 33]); o.y = cvt_pk_bf16(s[2 * 33], s[3 * 33]); o.z = cvt_pk_bf16(s[4 * 33], s[5 * 33]); o.w = cvt_pk_bf16(s[6 * 33], s[7 * 33]);
        *(v4u*)(WT + (size_t)(n0 + n) * K + k0 + 8 * c) = o; }
    asm volatile("s_waitcnt lgkmcnt(0)" ::: "memory");
}
__device__ __forceinline__ void convert_weight(const float* W, int K, int N, bf16* WT, LAS unsigned char* lds, int gw, int NGW, int wave, int lane) {
    LAS float* scr = (LAS float*)(lds + wave * 16384);
    const int nitems = (K / 64) * (N / 32);
    for (int it = gw; it < nitems; it += NGW) transpose_item(W, K, N, WT, scr, it, lane);
}
__device__ __forceinline__ void rms_row_bf16(const float* xrow, const float* gain, bf16* orow, int lane) {
    const f32x4* xr = (const f32x4*)xrow + lane; const f32x4* gr = (const f32x4*)gain + lane;
    f32x4 v[4]; float s = 0.f;
#pragma unroll
    for (int j = 0; j < 4; ++j) { v[j] = xr[64 * j]; s += (v[j].x * v[j].x + v[j].y * v[j].y) + (v[j].z * v[j].z + v[j].w * v[j].w); }
    const float rstd = rsqrtf(wave_sum(s) * (1.f / DM) + EPS);
    v2u* o8 = (v2u*)orow + lane;
#pragma unroll
    for (int j = 0; j < 4; ++j) { const f32x4 gg = gr[64 * j]; v2u o; o.x = cvt_pk_bf16(v[j].x * rstd * gg.x, v[j].y * rstd * gg.y); o.y = cvt_pk_bf16(v[j].z * rstd * gg.z, v[j].w * rstd * gg.w); o8[64 * j] = o; }
}
__device__ __forceinline__ void rms_row_f32(const float* xrow, const float* gain, float* orow, int lane) {
    const f32x4* xr = (const f32x4*)xrow + lane; const f32x4* gr = (const f32x4*)gain + lane;
    f32x4 v[4]; float s = 0.f;
#pragma unroll
    for (int j = 0; j < 4; ++j) { v[j] = xr[64 * j]; s += (v[j].x * v[j].x + v[j].y * v[j].y) + (v[j].z * v[j].z + v[j].w * v[j].w); }
    const float rstd = rsqrtf(wave_sum(s) * (1.f / DM) + EPS);
    f32x4* o = (f32x4*)orow + lane;
#pragma unroll
    for (int j = 0; j < 4; ++j) { const f32x4 gg = gr[64 * j]; o[64 * j] = v[j] * rstd * gg; }
}

__device__ __forceinline__ void sg_phase(LAS unsigned char* lds, bf16* ZU, const bf16* ZV, const bf16* WSB, const float* bs_l, const float* sgn_l, int bid, int G) {
    int tid_l = threadIdx.x; asm volatile("" : "+v"(tid_l));
    const int tid = tid_l, lane = tid & 63, w = __builtin_amdgcn_readfirstlane(tid >> 6), g = lane >> 4, r16 = lane & 15;
    LAS unsigned char* VGT = lds; LAS unsigned char* WSL = lds + 34816;
    const int s = tid >> 2, dq = tid & 3;
    v4u z[4], wv[4];
#define SG_LOAD(item) do { const int gq_ = (item) & 7, row0_ = ((item) >> 3) * 128; \
        _Pragma("unroll") for (int e = 0; e < 4; ++e) { z[e] = *(const v4u*)(ZV + (size_t)(row0_ + s) * 1024 + gq_ * 128 + dq * 32 + 8 * e); wv[e] = *(const v4u*)(WSB + (size_t)gq_ * 16384 + s * 128 + dq * 32 + 8 * e); } } while (0)
    if (bid < 1024) SG_LOAD(bid);
    for (int item = bid; item < 1024; item += G) {
        const int gq = item & 7, bc = item >> 3, row0 = bc * 128, col0 = gq * 128;
        {
            float ss = 0.f;
#pragma unroll
            for (int e = 0; e < 4; ++e)
#pragma unroll
                for (int q = 0; q < 4; ++q) { const float a = bflo(z[e][q]), b = bfhi(z[e][q]); ss += a * a + b * b; }
            ss += __shfl_xor(ss, 1); ss += __shfl_xor(ss, 2);
            const float rstd = rsqrtf(ss * (1.f / 128.f) + EPS);
#pragma unroll
            for (int e = 0; e < 4; ++e) {
                const f32x4 n0 = *(const f32x4*)(sgn_l + col0 + dq * 32 + 8 * e), n1 = *(const f32x4*)(sgn_l + col0 + dq * 32 + 8 * e + 4);
#pragma unroll
                for (int q = 0; q < 4; ++q) { const int d = dq * 32 + 8 * e + 2 * q; const float na = q < 2 ? n0[2 * q] : n1[2 * q - 4], nb = q < 2 ? n0[2 * q + 1] : n1[2 * q - 3];
                    const unsigned pk = cvt_pk_bf16(bflo(z[e][q]) * rstd * na, bfhi(z[e][q]) * rstd * nb);
                    *(LAS unsigned short*)(VGT + d * 272 + s * 2) = (unsigned short)(pk & 0xffffu);
                    *(LAS unsigned short*)(VGT + (d + 1) * 272 + s * 2) = (unsigned short)(pk >> 16); }
                *(LAS v4u*)(WSL + s * 272 + (dq * 32 + 8 * e) * 2) = wv[e]; }
        }
        __syncthreads();
        if (item + G < 1024) SG_LOAD(item + G);
        {
            bf16x8 bw[4];
#pragma unroll
            for (int ks = 0; ks < 4; ++ks) bw[ks] = *(const LAS bf16x8*)(WSL + (16 * w + r16) * 272 + (32 * ks + 8 * g) * 2);
            const int row = row0 + 16 * w + r16; const float bias = bs_l[gq * 128 + 16 * w + r16];
            v2u zu[8];
#pragma unroll
            for (int dt = 0; dt < 8; ++dt) zu[dt] = *(const v2u*)(ZU + (size_t)row * 1024 + col0 + 16 * dt + 4 * g);
#pragma unroll
            for (int dt = 0; dt < 8; ++dt) { f32x4 acc = (f32x4){0.f, 0.f, 0.f, 0.f};
#pragma unroll
                for (int ks = 0; ks < 4; ++ks) { const bf16x8 a = *(const LAS bf16x8*)(VGT + (16 * dt + r16) * 272 + (32 * ks + 8 * g) * 2); acc = __builtin_amdgcn_mfma_f32_16x16x32_bf16(a, bw[ks], acc, 0, 0, 0); }
                v2u o; o.x = cvt_pk_bf16(bflo(zu[dt].x) * (acc[0] + bias), bfhi(zu[dt].x) * (acc[1] + bias)); o.y = cvt_pk_bf16(bflo(zu[dt].y) * (acc[2] + bias), bfhi(zu[dt].y) * (acc[3] + bias));
                *(v2u*)(ZU + (size_t)row * 1024 + col0 + 16 * dt + 4 * g) = o; }
        }
        __syncthreads();
    }
#undef SG_LOAD
}

constexpr int HG_QH = 0, HG_KH = 17408, HG_KT = 34816, HG_VT = 53248, HG_EBM = 62464, HG_EBL = 62976, HG_IMG = 63488;
__device__ __forceinline__ bf16x8 hg_ld2(const LAS unsigned char* p) {
    const v2u lo = *(const LAS v2u*)p, hi = *(const LAS v2u*)(p + 32); return __builtin_bit_cast(bf16x8, (v4u){lo.x, lo.y, hi.x, hi.y});
}
__device__ __forceinline__ bf16x8 hg_ld2s(const LAS unsigned char* row, int e0) {
    const v2u lo = *(const LAS v2u*)(row + 2 * e0), hi = *(const LAS v2u*)(row + 2 * (e0 ^ 16)); return __builtin_bit_cast(bf16x8, (v4u){lo.x, lo.y, hi.x, hi.y});
}
__device__ __forceinline__ void hg_phase(LAS unsigned char* lds, const bf16* Qb, const bf16* LFfw, const bf16* LFbw, const bf16* IVb, bf16* Ofw, bf16* Obw, int bid, int G) {
    int tid_l = threadIdx.x; asm volatile("" : "+v"(tid_l));
    const int tid = tid_l, lane = tid & 63, w = __builtin_amdgcn_readfirstlane(tid >> 6), g = lane >> 4, r16 = lane & 15;
    const int vs = tid >> 3, vc = tid & 7;
    const int kp = lane & 7, tg = lane >> 3, ek = 16 * w + 2 * kp, et0 = 8 * tg, ekz = ek ^ (16 * (tg >> 1));
    for (int item = bid; item < 256; item += G) {
        const int vh = (item >> 3) & 1, chain = (item & 7) | ((item >> 4) << 3), dir = chain & 1, h = (chain >> 1) & 7, b = chain >> 4;
        const bf16* LF = dir ? LFbw : LFfw; bf16* O = dir ? Obw : Ofw;
        const size_t colq = (size_t)h * 128 + ek, colv = (size_t)h * 128 + vh * 64;
#define HG_ROW(c, tau) ((size_t)(b * SEQ + (dir ? (SEQ - 1 - (64 * (c) + (tau))) : (64 * (c) + (tau)))))
        f32x4 S[8];
#pragma unroll
        for (int kt = 0; kt < 8; ++kt) S[kt] = (f32x4){0.f, 0.f, 0.f, 0.f};
        unsigned lfr[8], qr[8]; v4u vr;
#define HG_LOAD(c) do { _Pragma("unroll") for (int j = 0; j < 8; ++j) { const size_t ro = HG_ROW(c, et0 + j) * 1024 + colq; lfr[j] = *(const unsigned*)(LF + ro); qr[j] = *(const unsigned*)(Qb + ro); } \
        vr = *(const v4u*)(IVb + HG_ROW(c, vs) * 1024 + colv + vc * 8); } while (0)
#define HG_EW(img) do { LAS unsigned char* I_ = lds + (img) * HG_IMG; float f0_[8], f1_[8]; float a0_ = 0.f, a1_ = 0.f; \
        _Pragma("unroll") for (int j = 0; j < 8; ++j) { const float l0_ = bflo(lfr[j]), l1_ = bfhi(lfr[j]); a0_ += l0_; a1_ += l1_; f0_[j] = __builtin_amdgcn_exp2f(l0_); f1_[j] = __builtin_amdgcn_exp2f(l1_); } \
        float i0_ = a0_, i1_ = a1_; { float u0_ = __shfl_up(i0_, 8), u1_ = __shfl_up(i1_, 8); if (tg >= 1) { i0_ += u0_; i1_ += u1_; } \
            u0_ = __shfl_up(i0_, 16); u1_ = __shfl_up(i1_, 16); if (tg >= 2) { i0_ += u0_; i1_ += u1_; } u0_ = __shfl_up(i0_, 32); u1_ = __shfl_up(i1_, 32); if (tg >= 4) { i0_ += u0_; i1_ += u1_; } } \
        const float bm0_ = __shfl(i0_, kp + 24), bm1_ = __shfl(i1_, kp + 24), bl0_ = __shfl(i0_, kp + 56), bl1_ = __shfl(i1_, kp + 56); \
        const float off0_ = i0_ - a0_ - bm0_, off1_ = i1_ - a1_ - bm1_; \
        float ek0_ = __builtin_amdgcn_exp2f(fminf(-(off0_ + a0_), 115.f)), ek1_ = __builtin_amdgcn_exp2f(fminf(-(off1_ + a1_), 115.f)); \
        unsigned kw_[8]; \
        _Pragma("unroll") for (int j = 7; j >= 0; --j) { const float k0_ = (1.f - f0_[j]) * ek0_, k1_ = (1.f - f1_[j]) * ek1_; ek0_ *= f0_[j]; ek1_ *= f1_[j]; kw_[j] = cvt_pk_bf16(k0_, k1_); } \
        float eq0_ = __builtin_amdgcn_exp2f(fminf(off0_ + bflo(lfr[0]), 115.f)), eq1_ = __builtin_amdgcn_exp2f(fminf(off1_ + bfhi(lfr[0]), 115.f)); \
        _Pragma("unroll") for (int j = 0; j < 8; ++j) { if (j > 0) { eq0_ *= f0_[j]; eq1_ *= f1_[j]; } \
            *(LAS unsigned*)(I_ + HG_QH + (et0 + j) * 272 + 2 * ekz) = cvt_pk_bf16(bflo(qr[j]) * eq0_, bfhi(qr[j]) * eq1_); \
            *(LAS unsigned*)(I_ + HG_KH + (et0 + j) * 272 + 2 * ekz) = kw_[j]; } \
        *(LAS v4u*)(I_ + HG_KT + ek * 144 + 2 * et0) = (v4u){(kw_[0] & 0xffffu) | (kw_[1] << 16), (kw_[2] & 0xffffu) | (kw_[3] << 16), (kw_[4] & 0xffffu) | (kw_[5] << 16), (kw_[6] & 0xffffu) | (kw_[7] << 16)}; \
        *(LAS v4u*)(I_ + HG_KT + (ek + 1) * 144 + 2 * et0) = (v4u){(kw_[0] >> 16) | (kw_[1] & 0xffff0000u), (kw_[2] >> 16) | (kw_[3] & 0xffff0000u), (kw_[4] >> 16) | (kw_[5] & 0xffff0000u), (kw_[6] >> 16) | (kw_[7] & 0xffff0000u)}; \
        if (tg == 0) { *(LAS f32x2*)(I_ + HG_EBM + 4 * ek) = (f32x2){__builtin_amdgcn_exp2f(bm0_), __builtin_amdgcn_exp2f(bm1_)}; *(LAS f32x2*)(I_ + HG_EBL + 4 * ek) = (f32x2){__builtin_amdgcn_exp2f(bl0_ - bm0_), __builtin_amdgcn_exp2f(bl1_ - bm1_)}; } \
        _Pragma("unroll") for (int e = 0; e < 4; ++e) { const unsigned u_ = vr[e]; \
            *(LAS unsigned short*)(I_ + HG_VT + (vc * 8 + 2 * e) * 144 + vs * 2) = (unsigned short)(u_ & 0xffffu); \
            *(LAS unsigned short*)(I_ + HG_VT + (vc * 8 + 2 * e + 1) * 144 + vs * 2) = (unsigned short)(u_ >> 16); } } while (0)
        HG_LOAD(0);
        HG_EW(0);
        HG_LOAD(1);
        __syncthreads();
        const int vt = w & 3, th = w >> 2;
        for (int c = 0; c < 32; ++c) {
#ifndef HG_SKIP_EW
            if (c + 1 < 32) { HG_EW((c + 1) & 1); if (c + 2 < 32) HG_LOAD(c + 2); }
#else
            if (c + 2 < 32) HG_LOAD(c + 2);
#endif
#ifndef HG_SKIP_MM
            {
                const LAS unsigned char* I = lds + (c & 1) * HG_IMG;
                const LAS unsigned char* QH = I + HG_QH; const LAS unsigned char* KH = I + HG_KH; const LAS unsigned char* KT = I + HG_KT; const LAS unsigned char* VT = I + HG_VT;
                const LAS float* EBM = (const LAS float*)(I + HG_EBM); const LAS float* EBL = (const LAS float*)(I + HG_EBL);
                bf16x8 As[4];
#pragma unroll
                for (int kt = 0; kt < 8; ++kt) S[kt] = S[kt] * *(const LAS f32x4*)(EBM + 16 * kt + 4 * g);
#pragma unroll
                for (int ks = 0; ks < 4; ++ks) { const unsigned x0 = cvt_pk_bf16(S[2 * ks][0], S[2 * ks][1]), x1 = cvt_pk_bf16(S[2 * ks][2], S[2 * ks][3]), x2 = cvt_pk_bf16(S[2 * ks + 1][0], S[2 * ks + 1][1]), x3 = cvt_pk_bf16(S[2 * ks + 1][2], S[2 * ks + 1][3]);
                    As[ks] = __builtin_bit_cast(bf16x8, (v4u){x0, x1, x2, x3}); }
                bf16x8 avp[2], avn[2];
#pragma unroll
                for (int ks = 0; ks < 2; ++ks) { avp[ks] = hg_ld2(VT + (16 * vt + r16) * 144 + (32 * ks + 4 * g) * 2); avn[ks] = *(const LAS bf16x8*)(VT + (16 * vt + r16) * 144 + (32 * ks + 8 * g) * 2); }
#pragma unroll
                for (int ttl = 0; ttl < 2; ++ttl) { const int tt = th ? (1 + ttl) : (3 * ttl), trow = 16 * tt + r16; const LAS unsigned char* qrow = QH + trow * 272;
                    f32x4 oacc = (f32x4){0.f, 0.f, 0.f, 0.f};
#pragma unroll
                    for (int ks = 0; ks < 4; ++ks) oacc = __builtin_amdgcn_mfma_f32_16x16x32_bf16(As[ks], hg_ld2s(qrow, (32 * ks + 4 * g) ^ (16 * tt)), oacc, 0, 0, 0);
                    bf16x8 bq[4];
#pragma unroll
                    for (int ks = 0; ks < 4; ++ks) bq[ks] = *(const LAS bf16x8*)(qrow + 2 * ((32 * ks + 8 * g) ^ (16 * tt)));
#pragma unroll
                    for (int kp2 = 0; kp2 < 2; ++kp2) if (kp2 <= (tt >> 1)) {
                        unsigned pw[4] = {0u, 0u, 0u, 0u};
#pragma unroll
                        for (int si = 0; si < 2; ++si) { const int st = 2 * kp2 + si; if (st <= tt) { f32x4 p = (f32x4){0.f, 0.f, 0.f, 0.f};
#pragma unroll
                                for (int ks = 0; ks < 4; ++ks) p = __builtin_amdgcn_mfma_f32_16x16x32_bf16(*(const LAS bf16x8*)(KH + (16 * st + r16) * 272 + 2 * ((32 * ks + 8 * g) ^ (16 * st))), bq[ks], p, 0, 0, 0);
                                if (st == tt) {
#pragma unroll
                                    for (int i = 0; i < 4; ++i) if (4 * g + i > r16) p[i] = 0.f; }
                                pw[2 * si] = cvt_pk_bf16(p[0], p[1]); pw[2 * si + 1] = cvt_pk_bf16(p[2], p[3]); } }
                        oacc = __builtin_amdgcn_mfma_f32_16x16x32_bf16(avp[kp2], __builtin_bit_cast(bf16x8, (v4u){pw[0], pw[1], pw[2], pw[3]}), oacc, 0, 0, 0);
                    }
                    *(v2u*)(O + HG_ROW(c, trow) * 1024 + colv + vt * 16 + 4 * g) = (v2u){cvt_pk_bf16(oacc[0], oacc[1]), cvt_pk_bf16(oacc[2], oacc[3])};
                }
#pragma unroll
                for (int kt = 0; kt < 8; ++kt) {
#pragma unroll
                    for (int ks = 0; ks < 2; ++ks) S[kt] = __builtin_amdgcn_mfma_f32_16x16x32_bf16(*(const LAS bf16x8*)(KT + (16 * kt + r16) * 144 + (32 * ks + 8 * g) * 2), avn[ks], S[kt], 0, 0, 0);
                    S[kt] = S[kt] * *(const LAS f32x4*)(EBL + 16 * kt + 4 * g); }
            }
#endif
            __syncthreads();
        }
#undef HG_ROW
#undef HG_LOAD
#undef HG_EW
    }
}

__device__ __forceinline__ void cb_row(bf16* Ofw, const bf16* Obw, const bf16* OG, const float* gain, size_t row, int lane) {
    const size_t o = row * 1024 + 16 * lane;
    v4u a[2], b[2], gq[2]; float s[16]; float ss = 0.f;
#pragma unroll
    for (int e = 0; e < 2; ++e) { a[e] = *(const v4u*)(Ofw + o + 8 * e); b[e] = *(const v4u*)(Obw + o + 8 * e); gq[e] = *(const v4u*)(OG + o + 8 * e); }
#pragma unroll
    for (int e = 0; e < 2; ++e)
#pragma unroll
        for (int q = 0; q < 4; ++q) { const float x = bflo(a[e][q]) + bflo(b[e][q]), y = bfhi(a[e][q]) + bfhi(b[e][q]); s[8 * e + 2 * q] = x; s[8 * e + 2 * q + 1] = y; ss += x * x + y * y; }
    ss += __shfl_xor(ss, 1); ss += __shfl_xor(ss, 2); ss += __shfl_xor(ss, 4);
    const float rstd = rsqrtf(ss * (1.f / 128.f) + EPS);
#pragma unroll
    for (int e = 0; e < 2; ++e) { v4u ov;
#pragma unroll
        for (int q = 0; q < 4; ++q) { const f32x2 gn = *(const f32x2*)(gain + 16 * lane + 8 * e + 2 * q);
            ov[q] = cvt_pk_bf16(s[8 * e + 2 * q] * rstd * gn.x * bflo(gq[e][q]), s[8 * e + 2 * q + 1] * rstd * gn.y * bfhi(gq[e][q])); }
        *(v4u*)(Ofw + o + 8 * e) = ov; }
}

#define XB_TMO      128
#define XB_XCNT(j)  (256  + 64 * (j))
#define XB_XSUB(j)  (1280 + 64 * (j))
#define XB_XGEN(j)  (2304 + 64 * (j))
#define XB_TOP      3328
#define XB_TOPGEN   3392
#define XCD_BAR_WORDS 3456
#define XB_SPIN_CAP (1u << 18)

__device__ __forceinline__ unsigned xb_ld(unsigned* p)              { return __hip_atomic_load(p, __ATOMIC_RELAXED, __HIP_MEMORY_SCOPE_AGENT); }
__device__ __forceinline__ unsigned xb_add(unsigned* p, unsigned v) { return __hip_atomic_fetch_add(p, v, __ATOMIC_RELAXED, __HIP_MEMORY_SCOPE_AGENT); }
__device__ __forceinline__ unsigned xb_xcc_id() { return (unsigned)__builtin_amdgcn_s_getreg((3 << 11) | 20) & 0xFu; }
#define XB_SPIN(cond, bar) do { unsigned _sp = 0; while (cond) { __builtin_amdgcn_s_sleep(1); \
    if ((++_sp & 255u) == 0u) { if (xb_ld(&(bar)[XB_TMO])) break; if (_sp > XB_SPIN_CAP) { atomicAdd(&(bar)[XB_TMO], 1u); break; } } } } while (0)

struct XcdBarrier {
    unsigned* bar; unsigned x;
    volatile LAS unsigned* st;
};

__device__ __forceinline__ XcdBarrier xcd_barrier_post(unsigned* bar, volatile LAS unsigned* st) {
    XcdBarrier b; b.bar = bar; b.x = xb_xcc_id(); b.st = st;
    if (threadIdx.x == 0) (void)xb_add(&bar[XB_XCNT(b.x)], 1u);
    return b;
}
__device__ __forceinline__ void xcd_barrier_complete(unsigned* bar, unsigned x, unsigned& nloc, unsigned& nx) {
    const unsigned G = gridDim.x * gridDim.y * gridDim.z;
    unsigned sum, cnt, mine, sp = 0u;
    for (;;) {
        sum = 0u; cnt = 0u; mine = 0u;
#pragma unroll
        for (unsigned j = 0; j < 16; ++j) { const unsigned c = xb_ld(&bar[XB_XCNT(j)]); sum += c; cnt += (c > 0u) ? 1u : 0u; mine = (j == x) ? c : mine; }
        if (sum == G) break;
        __builtin_amdgcn_s_sleep(1);
        if ((++sp & 255u) == 0u) { if (xb_ld(&bar[XB_TMO])) break; if (sp > XB_SPIN_CAP) { atomicAdd(&bar[XB_TMO], 1u); break; } }
    }
    nloc = mine > 0u ? mine : 1u; nx = cnt > 0u ? cnt : 1u;
}

__device__ __forceinline__ void xcd_barrier(const XcdBarrier& b) {
    asm volatile("s_waitcnt vmcnt(0)" ::: "memory");
    __syncthreads();
    if (threadIdx.x == 0) {
        unsigned* bar = b.bar;
        __builtin_amdgcn_s_waitcnt(0);
        unsigned nloc = b.st[0], nx = b.st[1];
        if (nloc == 0u) { xcd_barrier_complete(bar, b.x, nloc, nx); b.st[0] = nloc; b.st[1] = nx; }
        const unsigned old = xb_add(&bar[XB_XSUB(b.x)], 1u);
        const unsigned gen = old / nloc;
        if (old + 1u == (gen + 1u) * nloc) {
            __builtin_amdgcn_fence(__ATOMIC_RELEASE, "agent");
            asm volatile("s_waitcnt vmcnt(0)" ::: "memory");
            const unsigned og = xb_add(&bar[XB_TOP], 1u);
            const unsigned tg = og / nx;
            if (og + 1u == (tg + 1u) * nx) xb_add(&bar[XB_TOPGEN], 1u);
            else XB_SPIN(xb_ld(&bar[XB_TOPGEN]) == tg, bar);
            __builtin_amdgcn_fence(__ATOMIC_ACQUIRE, "agent");
            xb_add(&bar[XB_XGEN(b.x)], 1u);
            asm volatile("s_waitcnt vmcnt(0)" ::: "memory");
        } else {
            XB_SPIN(xb_ld(&bar[XB_XGEN(b.x)]) == gen, bar);
            __builtin_amdgcn_fence(__ATOMIC_ACQUIRE, "agent");
            asm volatile("s_waitcnt vmcnt(0)" ::: "memory");
        }
    }
    __syncthreads();
}

struct Args { const float* in[15]; float* out; unsigned char* ws; int ph_lo, ph_hi; };

__global__ void __launch_bounds__(NTHR, 2) fwd(Args a) {
    extern __shared__ __attribute__((aligned(16))) unsigned char lds_raw[];
    LAS unsigned char* lds = (LAS unsigned char*)lds_raw;
    const int G = gridDim.x, bid = blockIdx.x, NGW = G * NWAVES;
    volatile LAS unsigned* MISC = (volatile LAS unsigned*)(lds + LDS_RING);
    if (threadIdx.x < 16) MISC[threadIdx.x] = 0u;
    __syncthreads();
    XcdBarrier xbar; xbar.bar = (unsigned*)a.ws; xbar.x = 0; xbar.st = nullptr;
    if (a.ph_hi - a.ph_lo > 1) xbar = xcd_barrier_post((unsigned*)a.ws, MISC);
    const float* x = a.in[0]; const float* w_in = a.in[1]; const float* ln_mix = a.in[2]; const float* ln_mlp = a.in[3]; const float* sg_norm = a.in[4];
    const float* w_s = a.in[5]; const float* b_s = a.in[6]; const float* lb_logits = a.in[7]; const float* rec_norm = a.in[8];
    const float* w_pa = a.in[9]; const float* w_pb = a.in[10]; const float* w_out = a.in[11]; const float* w_up = a.in[12]; const float* w_down = a.in[13]; const float* ln_final = a.in[14];
#define BUF(i) ((bf16*)(ws + WS_BUF(i)))
    for (int p = a.ph_lo; p < a.ph_hi; ++p) {
        if (p > a.ph_lo) { asm volatile("s_waitcnt vmcnt(0)" ::: "memory");
#ifdef PROBE_SYNC
            const unsigned long long ts0 = __builtin_amdgcn_s_memrealtime();
#endif
            if (p == a.ph_lo + 1) cg::this_grid().sync(); else xcd_barrier(xbar);
#ifdef PROBE_SYNC
            { const unsigned long long ts1 = __builtin_amdgcn_s_memrealtime(); if (blockIdx.x == PROBE_SYNC_BLK && threadIdx.x == 0) { float* pp = (float*)(a.ws + 32768); const float prev = (p == a.ph_lo + 1) ? 0.f : *(volatile float*)pp; *pp = prev + (float)(ts1 - ts0) * (1.0f / PROBE_DIV); } }
#endif
            }
        int tid = threadIdx.x; asm volatile("" : "+v"(tid));
        const int lane = tid & 63, wave = __builtin_amdgcn_readfirstlane(tid >> 6), gw = bid * NWAVES + wave;
        unsigned char* ws = a.ws; asm volatile("" : "+s"(ws));
        float* out = a.out; asm volatile("" : "+s"(out));
        float* LB = (float*)(ws + WS_LB); float* RSQ = (float*)(ws + WS_RSQ);
        bf16* WIN = (bf16*)(ws + WS_WIN); bf16* WPA = (bf16*)(ws + WS_WPA); bf16* WPB = (bf16*)(ws + WS_WPB); bf16* WOUT = (bf16*)(ws + WS_WOUT);
        bf16* WUP = (bf16*)(ws + WS_WUP); bf16* WDN = (bf16*)(ws + WS_WDN);
#ifdef DBG_NRUN
        if (p == DBG_NRUN) {
            for (size_t i = (size_t)bid * NTHR + tid; i < (size_t)M * DM; i += (size_t)G * NTHR) { float s = (DBG_NRUN >= 8) ? out[i] : 0.f;
                for (int k = 0; k < 8; ++k) s += bflo((unsigned)((const bf16*)(ws + WS_BUF(k)))[i]); out[i] = s; }
            continue;
        }
        if (p > DBG_NRUN) continue;
#endif
        if (p == NPH - 1) {
            for (int m = gw; m < M; m += NGW) rms_row_f32(out + (size_t)m * DM, ln_final, out + (size_t)m * DM, lane);
            continue;
        }
        const int l = p / PH_PER_LAYER, j = p % PH_PER_LAYER;
#ifdef PROBE_PH
        unsigned long long t0p = 0; if ((PROBE_PH >> j) & 1) t0p = __builtin_amdgcn_s_memrealtime();
#endif
        const float* hin = (l == 0) ? x : out;
#ifndef PHASE_MASK
#define PHASE_MASK 0x7ff
#endif
        if (!((PHASE_MASK >> j) & 1)) continue;
        switch (j) {
        case 0: {
#ifdef DBG_FILL
            if (l == 0) { v4u* fp = (v4u*)(ws + WS_BUF(1)); const size_t n16 = (size_t)7 * BUFB / 16; for (size_t i = (size_t)bid * NTHR + tid; i < n16; i += (size_t)G * NTHR) fp[i] = (v4u){DBG_FILL, DBG_FILL, DBG_FILL, DBG_FILL}; }
#endif
            convert_weight(w_in + (size_t)l * DM * NIN, DM, NIN, WIN, lds, gw, NGW, wave, lane);
            convert_weight(w_pa + (size_t)l * DM * DM, DM, DM, WPA, lds, gw, NGW, wave, lane);
            convert_weight(w_pb + (size_t)l * DM * DM, DM, DM, WPB, lds, gw, NGW, wave, lane);
            convert_weight(w_out + (size_t)l * DM * DM, DM, DM, WOUT, lds, gw, NGW, wave, lane);
            { const float* wsrc = w_s + (size_t)l * 8 * 16384; unsigned* wdst = (unsigned*)(ws + WS_WSB); for (int i = bid * NTHR + tid; i < 8 * 16384 / 2; i += G * NTHR) { const f32x2 v = *(const f32x2*)(wsrc + 2 * i); wdst[i] = cvt_pk_bf16(v.x, v.y); } }
            for (int i = bid * NTHR + tid; i < 2 * DM; i += G * NTHR) { LB[i] = 0.f; LB[2 * DM + i] = 1.f / (1.f + __expf(lb_logits[i] - lb_logits[2 * DM + i])); }
            if (l == 0) {
                for (int i = bid * NTHR + tid; i < 3 * M; i += G * NTHR) RSQ[i] = 0.f;
                for (int m = gw; m < M; m += NGW) rms_row_bf16(hin + (size_t)m * DM, ln_mix + l * DM, BUF(0) + (size_t)m * DM, lane);
            }
            __syncthreads();
        } break;
        case 1: {
#define PROJ(MA, MB, split, sec0, bufi, lbp) { pg8::Gemm g{BUF(0), WIN + (size_t)(sec0) * DM * DM, M, 3 * DM, DM}; pg8::StaticOrder S; S.init(M, 3 * DM, G, bid); \
            pg8::EpiProj<MA, MB> E{BUF(bufi), (size_t)M * DM, lbp, (l == 0) ? (const float*)nullptr : (const float*)(RSQ + M), split}; pg8::gemm_phase<pg8::EpiProj<MA, MB>, pg8::StaticOrder, PROJ_ALIGN, true>(lds, g, S, E); }
            PROJ(0, 1, 2, 0, 1, LB) PROJ(2, 3, 2, 3, 4, LB + (size_t)l * 2 * DM)
        } break;
        case 2: sg_phase(lds, BUF(1), BUF(2), (const bf16*)(ws + WS_WSB), b_s + (size_t)l * 1024, sg_norm + (size_t)l * DM, bid, G); break;
        case 3: hg_phase(lds, BUF(3), BUF(4), BUF(5), BUF(6), BUF(2), BUF(7), bid, G); break;
        case 4: {
            PROJ(3, 4, 1, 6, 3, LB)
        } break;
        case 5: {
            convert_weight(w_up + (size_t)l * DM * DFF, DM, DFF, WUP, lds, gw, NGW, wave, lane);
            convert_weight(w_down + (size_t)l * DFF * DM, DFF, DM, WDN, lds, gw, NGW, wave, lane);
            for (int m = gw; m < M; m += NGW) cb_row(BUF(2), BUF(7), BUF(3), rec_norm + (size_t)l * DM, (size_t)m, lane);
            __syncthreads();
        } break;
        case 6: {
            pg8::Gemm g{BUF(1), WPA, 2 * M, 2 * DM, DM}; pg8::PairOrder S; S.init(M, DM, G, bid); pg8::EpiGate E{BUF(4), BUF(5)};
            pg8::gemm_phase<pg8::EpiGate, pg8::PairOrder, true, true>(lds, g, S, E);
        } break;
        case 7: {
            pg8::Gemm g{BUF(4), WOUT, M, DM, DM}; pg8::StaticOrder S; S.init(M, DM, G, bid); pg8::EpiResid E{(l == 0) ? x : (const float*)nullptr, BUF(0), ln_mix + DM, (float*)nullptr, BUF(0), ln_mlp + l * DM, RSQ + (size_t)(l == 0 ? 0 : 2) * M};

            pg8::gemm_phase<pg8::EpiResid, pg8::StaticOrder, false, true>(lds, g, S, E);
        } break;
        case 8: {
            pg8::Gemm g{BUF(0), WUP, M, DFF, DM}; pg8::StaticOrder S; S.init(M, DFF, G, bid); pg8::EpiRelu2 E{BUF(1), DFF, RSQ + (size_t)(l == 0 ? 0 : 2) * M};
            pg8::gemm_phase<pg8::EpiRelu2, pg8::StaticOrder, true, true>(lds, g, S, E);
        } break;
        case 9: {
            pg8::Gemm g{BUF(1), WDN, M, DM, DFF}; pg8::StaticOrder S; S.init(M, DM, G, bid);
            pg8::EpiResid E{(const float*)nullptr, BUF(0), ln_mlp + l * DM, (l == 0) ? (float*)nullptr : out, (l == 0) ? BUF(0) : (bf16*)nullptr, ln_mix + DM, RSQ + M};
            pg8::gemm_phase<pg8::EpiResid, pg8::StaticOrder, false, true>(lds, g, S, E);
        } break;
        }
#ifdef PROBE_PH
        if ((PROBE_PH >> j) & 1) { asm volatile("s_waitcnt vmcnt(0)" ::: "memory"); __syncthreads(); const unsigned long long t1p = __builtin_amdgcn_s_memrealtime();
#ifdef PROBE_MAX
            if (tid == 0) atomicMax((unsigned*)(ws + 32768) + 1 + p, (unsigned)(t1p - t0p));
#else
            if (bid == 0 && tid == 0) atomicAdd((unsigned*)(ws + 32768) + 1 + p, (unsigned)(t1p - t0p));
#endif
        }
#endif
    }
#if defined(PROBE_PH)
    if (bid == 0 && threadIdx.x == 0) { asm volatile("s_waitcnt vmcnt(0)" ::: "memory"); unsigned s = 0; for (int q = 0; q < NPH; ++q) s += __hip_atomic_load((unsigned*)(a.ws + 32768) + 1 + q, __ATOMIC_RELAXED, __HIP_MEMORY_SCOPE_AGENT); a.out[0] = (float)s * (1.0f / PROBE_DIV); }
#elif defined(PROBE_SYNC)
    if (bid == 0 && threadIdx.x == 0) { asm volatile("s_waitcnt vmcnt(0)" ::: "memory"); a.out[0] = *(volatile float*)(a.ws + 32768); }
#endif
#undef BUF
}

extern "C" void kernel_launch(void* const* d_in, const int* in_sizes, int n_in, void* d_out, int out_size, void* d_ws, size_t ws_size, hipStream_t stream) {
    static int grid = 0;
    if (grid == 0) {
        if (n_in != 15 || out_size != M * DM || ws_size < WS_END) { fprintf(stderr, "kernel_launch: unexpected problem (n_in %d, out %d, ws %zu < %zu)\n", n_in, out_size, ws_size, (size_t)WS_END); grid = -1; return; }
        int dev = 0, cus = 0, per_cu = 0;
        hipGetDevice(&dev); hipDeviceGetAttribute(&cus, hipDeviceAttributeMultiprocessorCount, dev);
        if (hipFuncSetAttribute((const void*)fwd, hipFuncAttributeMaxDynamicSharedMemorySize, LDS_BYTES) != hipSuccess) { fprintf(stderr, "kernel_launch: hipFuncSetAttribute failed\n"); grid = -1; return; }
        if (hipOccupancyMaxActiveBlocksPerMultiprocessor(&per_cu, (const void*)fwd, NTHR, LDS_BYTES) != hipSuccess || per_cu < 1) { fprintf(stderr, "kernel_launch: occupancy query says %d\n", per_cu); per_cu = 1; }
        (void)hipGetLastError();
        grid = cus;
    }
    if (grid < 0) return;
#if defined(PROBE_PH)
    (void)hipMemsetAsync((char*)d_ws + 32768, 0, 512, stream);
#endif
    (void)hipMemsetAsync(d_ws, 0, 16384, stream);
    Args a{};
    for (int i = 0; i < 15; ++i) a.in[i] = (const float*)d_in[i];
    a.out = (float*)d_out; a.ws = (unsigned char*)d_ws;
#if ONE_LAUNCH
    a.ph_lo = 0; a.ph_hi = NPH;
    void* args[] = {&a};
    hipError_t e = hipLaunchCooperativeKernel((const void*)fwd, dim3(grid), dim3(NTHR), args, LDS_BYTES, stream);
    if (e != hipSuccess) fprintf(stderr, "cooperative launch failed: %s (grid %d)\n", hipGetErrorString(e), grid);
#else
    for (int p = 0; p < NPH; ++p) { a.ph_lo = p; a.ph_hi = p + 1; hipLaunchKernelGGL(fwd, dim3(grid), dim3(NTHR), LDS_BYTES, stream, a); }
#endif
}
```

```cpp
#define ONE_LAUNCH 1
#include <hip/hip_runtime.h>
#include <hip/hip_cooperative_groups.h>
#include <cstdio>
#include <cstdint>
namespace cg = cooperative_groups;
namespace pg8 {
#define PG8_LAS __attribute__((address_space(3)))
typedef unsigned short bf16_t;
typedef short bf16x8 __attribute__((ext_vector_type(8)));
typedef float f32x4 __attribute__((ext_vector_type(4)));
typedef unsigned u32x4 __attribute__((ext_vector_type(4)));
constexpr int BM = 256, BK = 64, HALF = 128, HTB = HALF * BK * 2  , STAGE_BYTES = 8 * HTB, NXCD = 8, WGM = 8;

__host__ __device__ __forceinline__ int lds_byte(int r, int c) { const int st = (r >> 4) * 2 + (c >> 5), rr = r & 15, cc = c & 31, ob = rr * 64 + cc * 2; return st * 1024 + (ob ^ (((ob >> 9) & 1) << 5)); }
__host__ __device__ __forceinline__ void stage_rc(int b, int& R, int& C) { const int st = b / 1024, sb = b % 1024, swz = sb ^ (((sb >> 9) & 1) << 5); R = (st >> 1) * 16 + swz / 64; C = (st & 1) * 32 + (swz % 64) / 2; }
__host__ __device__ __forceinline__ int perm32(int rho) { const int n = rho >> 4, i = rho & 15; return 8 * (i >> 2) + 4 * n + (i & 3); }

struct Unit { int pm, pn; };
struct Gemm { const bf16_t* A; const bf16_t* Bt; int M, N, K; };

struct StaticOrder {
    int nM, nN, nwg, G, c;
    __host__ __device__ void init(int M, int N, int G_, int c_) { nM = M / BM; nN = N / BM; nwg = nM * nN; G = G_; c = c_; }
    __host__ __device__ bool next(int i, Unit& u) const {
        const long L = (long)i * G + c; if (L >= nwg) return false;
        int wgid = (int)L; { const int q = nwg / NXCD, r = nwg % NXCD, xcd = wgid % NXCD, off = wgid / NXCD; wgid = (xcd < r ? xcd * (q + 1) : r * (q + 1) + (xcd - r) * q) + off; }
        const int nig = WGM * nN, gid = wgid / nig, fm = gid * WGM, gsz = (nM - fm) < WGM ? (nM - fm) : WGM;
        u.pm = fm + ((wgid % nig) % gsz); u.pn = (wgid % nig) / gsz; return true;
    }
    __device__ __forceinline__ void a_ready(const Unit&) const {}
    __device__ __forceinline__ void done(const Unit&) const {}
};

typedef float cvt_f32x2_t __attribute__((ext_vector_type(2)));
typedef __bf16 cvt_bf16x2_t __attribute__((ext_vector_type(2)));
__device__ __forceinline__ unsigned cvt_pk_bf16(float lo, float hi) { cvt_f32x2_t v = {lo, hi}; cvt_bf16x2_t b = __builtin_convertvector(v, cvt_bf16x2_t); return __builtin_bit_cast(unsigned, b); }
typedef float f32x2 __attribute__((ext_vector_type(2)));
__device__ __forceinline__ f32x2 gelu_pk(f32x2 v) {
    const f32x2 av = __builtin_elementwise_abs(v), d = av * 0.2316418882f + 1.0f;
    f32x2 t; t.x = __builtin_amdgcn_rcpf(d.x); t.y = __builtin_amdgcn_rcpf(d.y);
    f32x2 q = t * 0.5307027145f + (-0.7265760135f); q = q * t + 0.7107068705f; q = q * t + (-0.142248368f); q = q * t + 0.127414796f; q = q * t;
    const f32x2 s = (v * v) * (-0.72134752044f);
    f32x2 e; e.x = __builtin_amdgcn_exp2f(s.x); e.y = __builtin_amdgcn_exp2f(s.y);
    const f32x2 m = v * (q * e), r = v - m;
    f32x2 o; o.x = v.x < 0.f ? m.x : r.x; o.y = v.y < 0.f ? m.y : r.y; return o;
}
__device__ __forceinline__ float bflo(unsigned u) { return __builtin_bit_cast(float, u << 16); }
__device__ __forceinline__ float bfhi(unsigned u) { return __builtin_bit_cast(float, u & 0xffff0000u); }
__device__ __forceinline__ float sigm(float z) { return __builtin_amdgcn_rcpf(1.0f + __expf(-z)); }
template <int MA, int MB> struct EpiProj {
    static constexpr bool PERM = true, AFTER_DRAIN = false;
    bf16_t* out0; size_t sec_stride; const float* lb; const float* rowsq; int split;
    template <int MODE> __device__ __forceinline__ void run(const f32x4 (&acc)[2][2][4][2], bf16_t* base, const float* lbrow, int row0, int col0) const {
#pragma unroll
        for (int ai = 0; ai < 2; ++ai)
#pragma unroll
            for (int m = 0; m < 4; ++m) { bf16_t* rowp = base + (size_t)(row0 + ai * HALF + m * 16) * 1024 + col0;
                const float rs = rowsq ? rsqrtf(rowsq[row0 + ai * HALF + m * 16] * (1.0f / 1024.0f) + 1e-6f) : 1.0f;
#pragma unroll
                for (int bj = 0; bj < 2; ++bj) { f32x4 v[2] = {acc[ai][bj][m][0] * rs, acc[ai][bj][m][1] * rs};
#pragma unroll
                    for (int n = 0; n < 2; ++n) {
                        if (MODE == 0) { f32x2 a = gelu_pk((f32x2){v[n][0], v[n][1]}), b = gelu_pk((f32x2){v[n][2], v[n][3]}); v[n] = (f32x4){a.x, a.y, b.x, b.y}; }
                        else if (MODE == 2) { const f32x4 lbv = *(const f32x4*)(lbrow + bj * HALF + 4 * n);
#pragma unroll
                            for (int e = 0; e < 4; ++e) { const float l = lbv[e]; const float f = l + (1.0f - l) * sigm(v[n][e]); v[n][e] = __log2f(f); }
                        } else if (MODE == 3) {
#pragma unroll
                            for (int e = 0; e < 4; ++e) v[n][e] = v[n][e] * sigm(v[n][e]);
                        } else if (MODE == 4) {
#pragma unroll
                            for (int e = 0; e < 4; ++e) v[n][e] = sigm(v[n][e]);
                        }
                    }
                    u32x4 w; w.x = cvt_pk_bf16(v[0][0], v[0][1]); w.y = cvt_pk_bf16(v[0][2], v[0][3]); w.z = cvt_pk_bf16(v[1][0], v[1][1]); w.w = cvt_pk_bf16(v[1][2], v[1][3]);
                    *(u32x4*)(rowp + bj * HALF) = w; } }
    }
    __device__ __forceinline__ void operator()(const f32x4 (&acc)[2][2][4][2], const Unit& u, int wr, int wc, int fr, int fq) const {
        const int colt = u.pn * BM, sec = colt >> 10;
        bf16_t* base = out0 + (size_t)sec * sec_stride;
        const int col0 = (colt & 1023) + wc * 32 + 8 * fq, row0 = u.pm * BM + wr * 64 + fr;
        const float* lbrow = lb + sec * 1024 + col0;
        if (sec < split) run<MA>(acc, base, lbrow, row0, col0); else run<MB>(acc, base, lbrow, row0, col0);
    }
};
struct EpiGate {
    static constexpr bool PERM = true, AFTER_DRAIN = false;
    bf16_t* T; const bf16_t* gate2;
    __device__ __forceinline__ void operator()(const f32x4 (&acc)[2][2][4][2], const Unit& u, int wr, int wc, int fr, int fq) const {
        const bool second = u.pm >= 64;
        const int col0 = (u.pn & 3) * BM + wc * 32 + 8 * fq, row0 = (u.pm & 63) * BM + wr * 64 + fr;
        const bf16_t* gate = second ? gate2 : T;
#pragma unroll
        for (int ai = 0; ai < 2; ++ai)
#pragma unroll
            for (int m = 0; m < 4; ++m) { asm volatile("" ::: "memory"); __builtin_amdgcn_sched_barrier(0); const size_t ro = (size_t)(row0 + ai * HALF + m * 16) * 1024 + col0;
#pragma unroll
                for (int bj = 0; bj < 2; ++bj) {
                    const u32x4 gv = *(const u32x4*)(gate + ro + bj * HALF);
                    u32x4 av = (u32x4){0u, 0u, 0u, 0u}; if (second) av = *(const u32x4*)(T + ro + bj * HALF);
                    const f32x4 v0 = acc[ai][bj][m][0], v1 = acc[ai][bj][m][1];
                    u32x4 w;
                    w.x = cvt_pk_bf16(bflo(av.x) + bflo(gv.x) * v0[0], bfhi(av.x) + bfhi(gv.x) * v0[1]);
                    w.y = cvt_pk_bf16(bflo(av.y) + bflo(gv.y) * v0[2], bfhi(av.y) + bfhi(gv.y) * v0[3]);
                    w.z = cvt_pk_bf16(bflo(av.z) + bflo(gv.z) * v1[0], bfhi(av.z) + bfhi(gv.z) * v1[1]);
                    w.w = cvt_pk_bf16(bflo(av.w) + bflo(gv.w) * v1[2], bfhi(av.w) + bfhi(gv.w) * v1[3]);
                    *(u32x4*)(T + ro + bj * HALF) = w; } }
    }
};
struct PairOrder {
    StaticOrder S;
    __device__ void init(int M_, int N_, int G_, int c_) { S.init(M_, N_, G_, c_); }
    __device__ bool next(int i, Unit& u) const { if (!S.next(i >> 1, u)) return false; if (i & 1) { u.pm += 64; u.pn += 4; } return true; }
    __device__ __forceinline__ void a_ready(const Unit&) const {}
    __device__ __forceinline__ void done(const Unit&) const {}
};
struct EpiResid {
    static constexpr bool PERM = true, AFTER_DRAIN = false;
    const float* base32; const bf16_t* xg_in; const float* gain_in; float* out32; bf16_t* xg_out; const float* gain_out; float* rowsq;
    __device__ __forceinline__ void operator()(const f32x4 (&acc)[2][2][4][2], const Unit& u, int wr, int wc, int fr, int fq) const {
        const int col0 = u.pn * BM + wc * 32 + 8 * fq, row0 = u.pm * BM + wr * 64 + fr;
#pragma unroll
        for (int ai = 0; ai < 2; ++ai)
#pragma unroll
            for (int m = 0; m < 4; ++m) { asm volatile("" ::: "memory"); __builtin_amdgcn_sched_barrier(0); const int row = row0 + ai * HALF + m * 16; const size_t ro = (size_t)row * 1024 + col0; float ss = 0.f;
#pragma unroll
                for (int bj = 0; bj < 2; ++bj) { f32x4 h[2];
                    if (base32) { h[0] = *(const f32x4*)(base32 + ro + bj * HALF); h[1] = *(const f32x4*)(base32 + ro + bj * HALF + 4); }
                    else { const u32x4 xv = *(const u32x4*)(xg_in + ro + bj * HALF); const f32x4 g0 = *(const f32x4*)(gain_in + col0 + bj * HALF), g1 = *(const f32x4*)(gain_in + col0 + bj * HALF + 4);
                        h[0] = (f32x4){bflo(xv.x) * __builtin_amdgcn_rcpf(g0[0]), bfhi(xv.x) * __builtin_amdgcn_rcpf(g0[1]), bflo(xv.y) * __builtin_amdgcn_rcpf(g0[2]), bfhi(xv.y) * __builtin_amdgcn_rcpf(g0[3])};
                        h[1] = (f32x4){bflo(xv.z) * __builtin_amdgcn_rcpf(g1[0]), bfhi(xv.z) * __builtin_amdgcn_rcpf(g1[1]), bflo(xv.w) * __builtin_amdgcn_rcpf(g1[2]), bfhi(xv.w) * __builtin_amdgcn_rcpf(g1[3])}; }
#pragma unroll
                    for (int n = 0; n < 2; ++n) { h[n] = h[n] + acc[ai][bj][m][n]; if (out32) *(f32x4*)(out32 + ro + bj * HALF + 4 * n) = h[n];
                        ss += (h[n][0] * h[n][0] + h[n][1] * h[n][1]) + (h[n][2] * h[n][2] + h[n][3] * h[n][3]); }
                    if (xg_out) { const f32x4 g0 = *(const f32x4*)(gain_out + col0 + bj * HALF), g1 = *(const f32x4*)(gain_out + col0 + bj * HALF + 4);
                        u32x4 w; w.x = cvt_pk_bf16(h[0][0] * g0[0], h[0][1] * g0[1]); w.y = cvt_pk_bf16(h[0][2] * g0[2], h[0][3] * g0[3]); w.z = cvt_pk_bf16(h[1][0] * g1[0], h[1][1] * g1[1]); w.w = cvt_pk_bf16(h[1][2] * g1[2], h[1][3] * g1[3]);
                        *(u32x4*)(xg_out + ro + bj * HALF) = w; } }
                if (xg_out) { ss += __shfl_xor(ss, 16); ss += __shfl_xor(ss, 32); if (fq == 0) atomicAdd(rowsq + row, ss); } }
    }
};
struct EpiRelu2 {
    static constexpr bool PERM = true, AFTER_DRAIN = false;
    bf16_t* out; int ldc; const float* rowsq;
    __device__ __forceinline__ void operator()(const f32x4 (&acc)[2][2][4][2], const Unit& u, int wr, int wc, int fr, int fq) const {
        const int col0 = u.pn * BM + wc * 32 + 8 * fq, row0 = u.pm * BM + wr * 64 + fr;
#pragma unroll
        for (int ai = 0; ai < 2; ++ai)
#pragma unroll
            for (int m = 0; m < 4; ++m) { asm volatile("" ::: "memory"); __builtin_amdgcn_sched_barrier(0); bf16_t* rowp = out + (size_t)(row0 + ai * HALF + m * 16) * ldc + col0;
                const float rs = rsqrtf(rowsq[row0 + ai * HALF + m * 16] * (1.0f / 1024.0f) + 1e-6f);
#pragma unroll
                for (int bj = 0; bj < 2; ++bj) { f32x4 v0 = acc[ai][bj][m][0] * rs, v1 = acc[ai][bj][m][1] * rs;
#pragma unroll
                    for (int e = 0; e < 4; ++e) { const float a = fmaxf(v0[e], 0.f), b = fmaxf(v1[e], 0.f); v0[e] = a * a; v1[e] = b * b; }
                    u32x4 w; w.x = cvt_pk_bf16(v0[0], v0[1]); w.y = cvt_pk_bf16(v0[2], v0[3]); w.z = cvt_pk_bf16(v1[0], v1[1]); w.w = cvt_pk_bf16(v1[2], v1[3]);
                    *(u32x4*)(rowp + bj * HALF) = w; } }
    }
};
template <class Epi, class Sched, bool ALIGN_EPI = false, bool SP2 = false>
__device__ __forceinline__ void gemm_phase(PG8_LAS unsigned char* lds, const Gemm g, const Sched& S, const Epi& E) {
    int tid_l = threadIdx.x; asm volatile("" : "+v"(tid_l));
    const int tid = tid_l, wid = __builtin_amdgcn_readfirstlane(tid >> 6), lane = tid & 63, wr = wid >> 2, wc = wid & 3, fr = lane & 15, fq = lane >> 4;
    const int K = g.K, nt = K / BK;
    unsigned voffA[2], voffB[2];
#pragma unroll
    for (int i = 0; i < 2; ++i) { int R, C; stage_rc(tid * 16 + i * 8192, R, C); const int Rb = Epi::PERM ? ((R & ~31) + perm32(R & 31)) : R;
        voffA[i] = (unsigned)(R * K + C) * 2u; voffB[i] = (unsigned)(Rb * K + C) * 2u; }
    const size_t kstep = (size_t)(BK * 2);
    const size_t hstep = (size_t)HALF * K * 2;
    const size_t tstep = 2 * hstep;
    const unsigned ldsw = (unsigned)wid * 1024u;
    const int aoff = lds_byte(wr * 64 + fr, fq * 8), boff = lds_byte(wc * 32 + fr, fq * 8);
#define PG8_SA(b, h) (((b) * 2 + (h)) * HTB)
#define PG8_SB(b, h) ((4 + (b) * 2 + (h)) * HTB)
#define PG8_STAGE(bufoff, gbase, voff) do { _Pragma("unroll") for (int _i = 0; _i < 2; ++_i) \
        __builtin_amdgcn_global_load_lds((const unsigned*)((const char*)(gbase) + (voff)[_i]), (PG8_LAS unsigned*)(lds + (bufoff) + ldsw + _i * 8192), 16, 0, 0); } while (0)
#define PG8_LDA(dst, b, h) do { _Pragma("unroll") for (int m = 0; m < 4; ++m) _Pragma("unroll") for (int k = 0; k < 2; ++k) dst[m][k] = *(const PG8_LAS bf16x8*)(lds + PG8_SA(b, h) + aoff + m * 2048 + k * 1024); } while (0)
#define PG8_LDB(dst, b, h) do { _Pragma("unroll") for (int n = 0; n < 2; ++n) _Pragma("unroll") for (int k = 0; k < 2; ++k) dst[n][k] = *(const PG8_LAS bf16x8*)(lds + PG8_SB(b, h) + boff + n * 2048 + k * 1024); } while (0)
#define PG8_MMA(ai, bj, At, Bt) do { __builtin_amdgcn_s_setprio(1); _Pragma("unroll") for (int m = 0; m < 4; ++m) _Pragma("unroll") for (int n = 0; n < 2; ++n) _Pragma("unroll") for (int k = 0; k < 2; ++k) \
        acc[ai][bj][m][n] = __builtin_amdgcn_mfma_f32_16x16x32_bf16(Bt[n][k], At[m][k], acc[ai][bj][m][n], 0, 0, 0); __builtin_amdgcn_s_setprio(0); } while (0)
#define PG8_WAIT_V(n) asm volatile("s_waitcnt vmcnt(" #n ")" ::: "memory")
#define PG8_WAIT_L(n) asm volatile("s_waitcnt lgkmcnt(" #n ")" ::: "memory")
#define PG8_BAR __builtin_amdgcn_s_barrier()
#define PG8_SCHED __builtin_amdgcn_sched_barrier(0)
    Unit cur, nxt; int ui = 0;
    if (!S.next(0, cur)) return;
    f32x4 acc[2][2][4][2];
#pragma unroll
    for (int a = 0; a < 2; ++a)
#pragma unroll
        for (int b = 0; b < 2; ++b)
#pragma unroll
            for (int m = 0; m < 4; ++m)
#pragma unroll
                for (int n = 0; n < 2; ++n) acc[a][b][m][n] = (f32x4){0.f, 0.f, 0.f, 0.f};
    bf16x8 At[4][2], B0[2][2], B1[2][2];
    const char* cA = (const char*)g.A + (size_t)cur.pm * tstep; const char* cB = (const char*)g.Bt + (size_t)cur.pn * tstep;
    S.a_ready(cur);
    if constexpr (SP2) {
        PG8_STAGE(PG8_SB(0, 0), cB, voffB); PG8_STAGE(PG8_SB(0, 1), cB + hstep, voffB); PG8_STAGE(PG8_SA(0, 0), cA, voffA); PG8_STAGE(PG8_SA(0, 1), cA + hstep, voffA);
        if (wr == 1) PG8_BAR;
        PG8_WAIT_V(2); PG8_BAR;
        PG8_STAGE(PG8_SB(1, 0), cB + kstep, voffB); PG8_STAGE(PG8_SA(1, 0), cA + kstep, voffA); PG8_STAGE(PG8_SB(1, 1), cB + hstep + kstep, voffB);
        PG8_WAIT_V(6); PG8_BAR;
    } else {
        PG8_STAGE(PG8_SB(0, 0), cB, voffB); PG8_STAGE(PG8_SA(0, 0), cA, voffA); PG8_STAGE(PG8_SB(0, 1), cB + hstep, voffB); PG8_STAGE(PG8_SA(0, 1), cA + hstep, voffA);
        if (wr == 1) PG8_BAR;
        PG8_WAIT_V(4); PG8_BAR;
        PG8_STAGE(PG8_SB(1, 0), cB + kstep, voffB); PG8_STAGE(PG8_SA(1, 0), cA + kstep, voffA); PG8_STAGE(PG8_SB(1, 1), cB + hstep + kstep, voffB);
        PG8_WAIT_V(6); PG8_BAR;
    }
    for (;;) {
        const bool has_next = S.next(ui + 1, nxt);
        const char* nA = has_next ? (const char*)g.A + (size_t)nxt.pm * tstep : cA; const char* nB = has_next ? (const char*)g.Bt + (size_t)nxt.pn * tstep : cB;
        for (int t = 0; t < nt; t += 2) {
            const bool last = (t == nt - 2);
            const char* a1 = cA + (size_t)(t + 1) * kstep;
            const char* a2 = last ? nA : cA + (size_t)(t + 2) * kstep; const char* b2 = last ? nB : cB + (size_t)(t + 2) * kstep;
            const char* a3 = a2 + kstep; const char* b3 = b2 + kstep;
            if (last && has_next) S.a_ready(nxt);
            if constexpr (SP2) {
            PG8_LDB(B0, 0, 0); PG8_LDB(B1, 0, 1); PG8_SCHED; PG8_LDA(At, 0, 0); PG8_STAGE(PG8_SA(1, 1), a1 + hstep, voffA);
            PG8_WAIT_V(8); PG8_WAIT_L(0); PG8_BAR; PG8_MMA(0, 0, At, B0); PG8_MMA(0, 1, At, B1); PG8_BAR; PG8_SCHED;
            PG8_LDA(At, 0, 1); PG8_STAGE(PG8_SB(0, 0), b2, voffB); PG8_STAGE(PG8_SB(0, 1), b2 + hstep, voffB); PG8_STAGE(PG8_SA(0, 0), a2, voffA);
            PG8_WAIT_V(8); PG8_WAIT_L(0); PG8_BAR; PG8_MMA(1, 0, At, B0); PG8_MMA(1, 1, At, B1); PG8_BAR; PG8_SCHED;
            PG8_LDB(B0, 1, 0); PG8_LDB(B1, 1, 1); PG8_SCHED; PG8_LDA(At, 1, 0); PG8_STAGE(PG8_SA(0, 1), a2 + hstep, voffA);
            PG8_WAIT_V(8); PG8_WAIT_L(0); PG8_BAR; PG8_MMA(0, 0, At, B0); PG8_MMA(0, 1, At, B1); PG8_BAR; PG8_SCHED;
            PG8_LDA(At, 1, 1); PG8_STAGE(PG8_SB(1, 0), b3, voffB); PG8_STAGE(PG8_SB(1, 1), b3 + hstep, voffB); PG8_STAGE(PG8_SA(1, 0), a3, voffA);
            PG8_WAIT_V(8); PG8_WAIT_L(0); PG8_BAR; PG8_MMA(1, 0, At, B0); PG8_MMA(1, 1, At, B1); PG8_BAR; PG8_SCHED;
            } else {
            PG8_LDB(B0, 0, 0); PG8_SCHED; PG8_LDA(At, 0, 0); PG8_STAGE(PG8_SA(1, 1), a1 + hstep, voffA);
            PG8_WAIT_L(8); PG8_BAR; PG8_WAIT_L(0); PG8_MMA(0, 0, At, B0); PG8_BAR; PG8_SCHED;
            PG8_LDB(B1, 0, 1); PG8_STAGE(PG8_SB(0, 0), b2, voffB);
            PG8_BAR; PG8_WAIT_L(0); PG8_MMA(0, 1, At, B1); PG8_BAR;
            PG8_LDA(At, 0, 1); PG8_STAGE(PG8_SA(0, 0), a2, voffA);
            PG8_BAR; PG8_WAIT_L(0); PG8_MMA(1, 0, At, B0); PG8_BAR; PG8_SCHED;
            PG8_STAGE(PG8_SB(0, 1), b2 + hstep, voffB);
            PG8_WAIT_V(6); PG8_BAR; PG8_MMA(1, 1, At, B1); PG8_BAR;
            PG8_LDB(B0, 1, 0); PG8_SCHED; PG8_LDA(At, 1, 0); PG8_STAGE(PG8_SA(0, 1), a2 + hstep, voffA);
            PG8_WAIT_L(8); PG8_BAR; PG8_WAIT_L(0); PG8_MMA(0, 0, At, B0); PG8_BAR; PG8_SCHED;
            PG8_LDB(B1, 1, 1); PG8_STAGE(PG8_SB(1, 0), b3, voffB);
            PG8_BAR; PG8_WAIT_L(0); PG8_MMA(0, 1, At, B1); PG8_BAR;
            PG8_LDA(At, 1, 1); PG8_STAGE(PG8_SA(1, 0), a3, voffA);
            PG8_BAR; PG8_WAIT_L(0); PG8_MMA(1, 0, At, B0); PG8_BAR; PG8_SCHED;
            PG8_STAGE(PG8_SB(1, 1), b3 + hstep, voffB);
            PG8_WAIT_V(6); PG8_BAR; PG8_MMA(1, 1, At, B1); PG8_BAR;
            }
        }
        if constexpr (ALIGN_EPI) { if (wr == 0) PG8_BAR; }
        if constexpr (!Epi::AFTER_DRAIN) { E(acc, cur, wr, wc, fr, fq); S.done(cur); }
        if (!has_next) break;
#pragma unroll
        for (int a = 0; a < 2; ++a)
#pragma unroll
            for (int b = 0; b < 2; ++b)
#pragma unroll
                for (int m = 0; m < 4; ++m)
#pragma unroll
                    for (int n = 0; n < 2; ++n) acc[a][b][m][n] = (f32x4){0.f, 0.f, 0.f, 0.f};
        cur = nxt; cA = nA; cB = nB; ++ui;
        if constexpr (ALIGN_EPI) { if (wr == 1) PG8_BAR; }
    }
    PG8_WAIT_V(0);
    if constexpr (!ALIGN_EPI) { if (wr == 0) PG8_BAR; }
    PG8_BAR;
    if constexpr (Epi::AFTER_DRAIN) { E.fused(acc, cur, wr, wc, fr, fq, lds, wid, lane); S.done(cur); }
#undef PG8_SA
#undef PG8_SB
#undef PG8_STAGE
#undef PG8_LDA
#undef PG8_LDB
#undef PG8_MMA
#undef PG8_WAIT_V
#undef PG8_WAIT_L
#undef PG8_BAR
#undef PG8_SCHED
}
}

#define LAS __attribute__((address_space(3)))
typedef unsigned short bf16;
typedef unsigned v4u __attribute__((ext_vector_type(4)));
typedef unsigned v2u __attribute__((ext_vector_type(2)));
typedef float f32x4 __attribute__((ext_vector_type(4)));
typedef float f32x2 __attribute__((ext_vector_type(2)));
typedef short bf16x8 __attribute__((ext_vector_type(8)));
typedef short s16x4 __attribute__((ext_vector_type(4)));
using pg8::bflo; using pg8::bfhi; using pg8::cvt_pk_bf16;

#ifndef PROJ_ALIGN
#define PROJ_ALIGN true
#endif
#ifndef ONE_LAUNCH
#define ONE_LAUNCH 1
#endif
constexpr int DM = 1024, BATCH = 8, SEQ = 2048, M = BATCH * SEQ, NIN = 9216, DFF = 4096, DEPTH = 2;
constexpr float EPS = 1e-6f;
constexpr int NTHR = 512, NWAVES = 8;
constexpr int LDS_RING = 131072, LDS_BYTES = LDS_RING + 64;
constexpr size_t MiB = 1u << 20;
constexpr size_t WS_RSQ = 256 * 1024;
constexpr size_t WS_WSB = 512 * 1024;
constexpr size_t WS_LB = 64 * 1024;
constexpr size_t WS_WIN = 1 * MiB, WS_WPA = 19 * MiB, WS_WPB = 21 * MiB, WS_WOUT = 23 * MiB;
constexpr size_t WS_B0 = 25 * MiB, BUFB = 32 * MiB;
constexpr size_t WS_END = WS_B0 + 8 * BUFB;
#define WS_BUF(i) (WS_B0 + (size_t)(i) * BUFB)
constexpr size_t WS_WUP = WS_BUF(6), WS_WDN = WS_BUF(6) + 8 * MiB;
constexpr int PH_PER_LAYER = 10, NPH = DEPTH * PH_PER_LAYER + 1;

__device__ __forceinline__ float wave_sum(float v) {
#pragma unroll
    for (int o = 1; o < 64; o <<= 1) v += __shfl_xor(v, o);
    return v;
}
__device__ __forceinline__ void transpose_item(const float* W, int K, int N, bf16* WT, LAS float* scr, int item, int lane) {
    const int nblk = N / 32, kb = item / nblk, nb = item % nblk, k0 = 64 * kb, n0 = 32 * nb;
#pragma unroll 8
    for (int i = 0; i < 32; ++i) { const int kk = 2 * i + (lane >> 5); scr[kk * 33 + (lane & 31)] = W[(size_t)(k0 + kk) * N + n0 + (lane & 31)]; }
    asm volatile("s_waitcnt lgkmcnt(0)" ::: "memory");
    const int c = lane & 7;
#pragma unroll
    for (int j = 0; j < 4; ++j) { const int n = (lane >> 3) + 8 * j; const LAS float* s = scr + (8 * c) * 33 + n;
        v4u o; o.x = cvt_pk_bf16(s[0 * 33], s[1 * 33]); o.y = cvt_pk_bf16(s[2 * 33], s[3 * 33]); o.z = cvt_pk_bf16(s[4 * 33], s[5 * 33]); o.w = cvt_pk_bf16(s[6 * 33], s[7 * 33]);
        *(v4u*)(WT + (size_t)(n0 + n) * K + k0 + 8 * c) = o; }
    asm volatile("s_waitcnt lgkmcnt(0)" ::: "memory");
}
__device__ __forceinline__ void convert_weight(const float* W, int K, int N, bf16* WT, LAS unsigned char* lds, int gw, int NGW, int wave, int lane) {
    LAS float* scr = (LAS float*)(lds + wave * 16384);
    const int nitems = (K / 64) * (N / 32);
    for (int it = gw; it < nitems; it += NGW) transpose_item(W, K, N, WT, scr, it, lane);
}
__device__ __forceinline__ void rms_row_bf16(const float* xrow, const float* gain, bf16* orow, int lane) {
    const f32x4* xr = (const f32x4*)xrow + lane; const f32x4* gr = (const f32x4*)gain + lane;
    f32x4 v[4]; float s = 0.f;
#pragma unroll
    for (int j = 0; j < 4; ++j) { v[j] = xr[64 * j]; s += (v[j].x * v[j].x + v[j].y * v[j].y) + (v[j].z * v[j].z + v[j].w * v[j].w); }
    const float rstd = rsqrtf(wave_sum(s) * (1.f / DM) + EPS);
    v2u* o8 = (v2u*)orow + lane;
#pragma unroll
    for (int j = 0; j < 4; ++j) { const f32x4 gg = gr[64 * j]; v2u o; o.x = cvt_pk_bf16(v[j].x * rstd * gg.x, v[j].y * rstd * gg.y); o.y = cvt_pk_bf16(v[j].z * rstd * gg.z, v[j].w * rstd * gg.w); o8[64 * j] = o; }
}
__device__ __forceinline__ void rms_row_f32(const float* xrow, const float* gain, float* orow, int lane) {
    const f32x4* xr = (const f32x4*)xrow + lane; const f32x4* gr = (const f32x4*)gain + lane;
    f32x4 v[4]; float s = 0.f;
#pragma unroll
    for (int j = 0; j < 4; ++j) { v[j] = xr[64 * j]; s += (v[j].x * v[j].x + v[j].y * v[j].y) + (v[j].z * v[j].z + v[j].w * v[j].w); }
    const float rstd = rsqrtf(wave_sum(s) * (1.f / DM) + EPS);
    f32x4* o = (f32x4*)orow + lane;
#pragma unroll
    for (int j = 0; j < 4; ++j) { const f32x4 gg = gr[64 * j]; o[64 * j] = v[j] * rstd * gg; }
}

__device__ __forceinline__ void sg_phase(LAS unsigned char* lds, bf16* ZU, const bf16* ZV, const bf16* WSB, const float* bs_l, const float* sgn_l, int bid, int G) {
    int tid_l = threadIdx.x; asm volatile("" : "+v"(tid_l));
    const int tid = tid_l, lane = tid & 63, w = __builtin_amdgcn_readfirstlane(tid >> 6), g = lane >> 4, r16 = lane & 15;
    LAS unsigned char* VGT = lds; LAS unsigned char* WSL = lds + 34816;
    const int s = tid >> 2, dq = tid & 3;
    v4u z[4], wv[4];
#define SG_LOAD(item) do { const int gq_ = (item) & 7, row0_ = ((item) >> 3) * 128; \
        _Pragma("unroll") for (int e = 0; e < 4; ++e) { z[e] = *(const v4u*)(ZV + (size_t)(row0_ + s) * 1024 + gq_ * 128 + dq * 32 + 8 * e); wv[e] = *(const v4u*)(WSB + (size_t)gq_ * 16384 + s * 128 + dq * 32 + 8 * e); } } while (0)
    if (bid < 1024) SG_LOAD(bid);
    for (int item = bid; item < 1024; item += G) {
        const int gq = item & 7, bc = item >> 3, row0 = bc * 128, col0 = gq * 128;
        {
            float ss = 0.f;
#pragma unroll
            for (int e = 0; e < 4; ++e)
#pragma unroll
                for (int q = 0; q < 4; ++q) { const float a = bflo(z[e][q]), b = bfhi(z[e][q]); ss += a * a + b * b; }
            ss += __shfl_xor(ss, 1); ss += __shfl_xor(ss, 2);
            const float rstd = rsqrtf(ss * (1.f / 128.f) + EPS);
#pragma unroll
            for (int e = 0; e < 4; ++e) {
                const f32x4 n0 = *(const f32x4*)(sgn_l + col0 + dq * 32 + 8 * e), n1 = *(const f32x4*)(sgn_l + col0 + dq * 32 + 8 * e + 4);
#pragma unroll
                for (int q = 0; q < 4; ++q) { const int d = dq * 32 + 8 * e + 2 * q; const float na = q < 2 ? n0[2 * q] : n1[2 * q - 4], nb = q < 2 ? n0[2 * q + 1] : n1[2 * q - 3];
                    const unsigned pk = cvt_pk_bf16(bflo(z[e][q]) * rstd * na, bfhi(z[e][q]) * rstd * nb);
                    *(LAS unsigned short*)(VGT + d * 272 + s * 2) = (unsigned short)(pk & 0xffffu);
                    *(LAS unsigned short*)(VGT + (d + 1) * 272 + s * 2) = (unsigned short)(pk >> 16); }
                *(LAS v4u*)(WSL + s * 272 + (dq * 32 + 8 * e) * 2) = wv[e]; }
        }
        __syncthreads();
        if (item + G < 1024) SG_LOAD(item + G);
        {
            bf16x8 bw[4];
#pragma unroll
            for (int ks = 0; ks < 4; ++ks) bw[ks] = *(const LAS bf16x8*)(WSL + (16 * w + r16) * 272 + (32 * ks + 8 * g) * 2);
            const int row = row0 + 16 * w + r16; const float bias = bs_l[gq * 128 + 16 * w + r16];
            v2u zu[8];
#pragma unroll
            for (int dt = 0; dt < 8; ++dt) zu[dt] = *(const v2u*)(ZU + (size_t)row * 1024 + col0 + 16 * dt + 4 * g);
#pragma unroll
            for (int dt = 0; dt < 8; ++dt) { f32x4 acc = (f32x4){0.f, 0.f, 0.f, 0.f};
#pragma unroll
                for (int ks = 0; ks < 4; ++ks) { const bf16x8 a = *(const LAS bf16x8*)(VGT + (16 * dt + r16) * 272 + (32 * ks + 8 * g) * 2); acc = __builtin_amdgcn_mfma_f32_16x16x32_bf16(a, bw[ks], acc, 0, 0, 0); }
                v2u o; o.x = cvt_pk_bf16(bflo(zu[dt].x) * (acc[0] + bias), bfhi(zu[dt].x) * (acc[1] + bias)); o.y = cvt_pk_bf16(bflo(zu[dt].y) * (acc[2] + bias), bfhi(zu[dt].y) * (acc[3] + bias));
                *(v2u*)(ZU + (size_t)row * 1024 + col0 + 16 * dt + 4 * g) = o; }
        }
        __syncthreads();
    }
#undef SG_LOAD
}

constexpr int HG_QH = 0, HG_KH = 17408, HG_KT = 34816, HG_VT = 53248, HG_EBM = 62464, HG_EBL = 62976, HG_IMG = 63488;
__device__ __forceinline__ bf16x8 hg_ld2(const LAS unsigned char* p) {
    const v2u lo = *(const LAS v2u*)p, hi = *(const LAS v2u*)(p + 32); return __builtin_bit_cast(bf16x8, (v4u){lo.x, lo.y, hi.x, hi.y});
}
__device__ __forceinline__ bf16x8 hg_ld2s(const LAS unsigned char* row, int e0) {
    const v2u lo = *(const LAS v2u*)(row + 2 * e0), hi = *(const LAS v2u*)(row + 2 * (e0 ^ 16)); return __builtin_bit_cast(bf16x8, (v4u){lo.x, lo.y, hi.x, hi.y});
}
__device__ __forceinline__ void hg_phase(LAS unsigned char* lds, const bf16* Qb, const bf16* LFfw, const bf16* LFbw, const bf16* IVb, bf16* Ofw, bf16* Obw, int bid, int G) {
    int tid_l = threadIdx.x; asm volatile("" : "+v"(tid_l));
    const int tid = tid_l, lane = tid & 63, w = __builtin_amdgcn_readfirstlane(tid >> 6), g = lane >> 4, r16 = lane & 15;
    const int vs = tid >> 3, vc = tid & 7;
    const int kp = lane & 7, tg = lane >> 3, ek = 16 * w + 2 * kp, et0 = 8 * tg, ekz = ek ^ (16 * (tg >> 1));
    for (int item = bid; item < 256; item += G) {
        const int vh = (item >> 3) & 1, chain = (item & 7) | ((item >> 4) << 3), dir = chain & 1, h = (chain >> 1) & 7, b = chain >> 4;
        const bf16* LF = dir ? LFbw : LFfw; bf16* O = dir ? Obw : Ofw;
        const size_t colq = (size_t)h * 128 + ek, colv = (size_t)h * 128 + vh * 64;
#define HG_ROW(c, tau) ((size_t)(b * SEQ + (dir ? (SEQ - 1 - (64 * (c) + (tau))) : (64 * (c) + (tau)))))
        f32x4 S[8];
#pragma unroll
        for (int kt = 0; kt < 8; ++kt) S[kt] = (f32x4){0.f, 0.f, 0.f, 0.f};
        unsigned lfr[8], qr[8]; v4u vr;
#define HG_LOAD(c) do { _Pragma("unroll") for (int j = 0; j < 8; ++j) { const size_t ro = HG_ROW(c, et0 + j) * 1024 + colq; lfr[j] = *(const unsigned*)(LF + ro); qr[j] = *(const unsigned*)(Qb + ro); } \
        vr = *(const v4u*)(IVb + HG_ROW(c, vs) * 1024 + colv + vc * 8); } while (0)
#define HG_EW(img) do { LAS unsigned char* I_ = lds + (img) * HG_IMG; float f0_[8], f1_[8]; float a0_ = 0.f, a1_ = 0.f; \
        _Pragma("unroll") for (int j = 0; j < 8; ++j) { const float l0_ = bflo(lfr[j]), l1_ = bfhi(lfr[j]); a0_ += l0_; a1_ += l1_; f0_[j] = __builtin_amdgcn_exp2f(l0_); f1_[j] = __builtin_amdgcn_exp2f(l1_); } \
        float i0_ = a0_, i1_ = a1_; { float u0_ = __shfl_up(i0_, 8), u1_ = __shfl_up(i1_, 8); if (tg >= 1) { i0_ += u0_; i1_ += u1_; } \
            u0_ = __shfl_up(i0_, 16); u1_ = __shfl_up(i1_, 16); if (tg >= 2) { i0_ += u0_; i1_ += u1_; } u0_ = __shfl_up(i0_, 32); u1_ = __shfl_up(i1_, 32); if (tg >= 4) { i0_ += u0_; i1_ += u1_; } } \
        const float bm0_ = __shfl(i0_, kp + 24), bm1_ = __shfl(i1_, kp + 24), bl0_ = __shfl(i0_, kp + 56), bl1_ = __shfl(i1_, kp + 56); \
        const float off0_ = i0_ - a0_ - bm0_, off1_ = i1_ - a1_ - bm1_; \
        float ek0_ = __builtin_amdgcn_exp2f(fminf(-(off0_ + a0_), 115.f)), ek1_ = __builtin_amdgcn_exp2f(fminf(-(off1_ + a1_), 115.f)); \
        unsigned kw_[8]; \
        _Pragma("unroll") for (int j = 7; j >= 0; --j) { const float k0_ = (1.f - f0_[j]) * ek0_, k1_ = (1.f - f1_[j]) * ek1_; ek0_ *= f0_[j]; ek1_ *= f1_[j]; kw_[j] = cvt_pk_bf16(k0_, k1_); } \
        float eq0_ = __builtin_amdgcn_exp2f(fminf(off0_ + bflo(lfr[0]), 115.f)), eq1_ = __builtin_amdgcn_exp2f(fminf(off1_ + bfhi(lfr[0]), 115.f)); \
        _Pragma("unroll") for (int j = 0; j < 8; ++j) { if (j > 0) { eq0_ *= f0_[j]; eq1_ *= f1_[j]; } \
            *(LAS unsigned*)(I_ + HG_QH + (et0 + j) * 272 + 2 * ekz) = cvt_pk_bf16(bflo(qr[j]) * eq0_, bfhi(qr[j]) * eq1_); \
            *(LAS unsigned*)(I_ + HG_KH + (et0 + j) * 272 + 2 * ekz) = kw_[j]; } \
        *(LAS v4u*)(I_ + HG_KT + ek * 144 + 2 * et0) = (v4u){(kw_[0] & 0xffffu) | (kw_[1] << 16), (kw_[2] & 0xffffu) | (kw_[3] << 16), (kw_[4] & 0xffffu) | (kw_[5] << 16), (kw_[6] & 0xffffu) | (kw_[7] << 16)}; \
        *(LAS v4u*)(I_ + HG_KT + (ek + 1) * 144 + 2 * et0) = (v4u){(kw_[0] >> 16) | (kw_[1] & 0xffff0000u), (kw_[2] >> 16) | (kw_[3] & 0xffff0000u), (kw_[4] >> 16) | (kw_[5] & 0xffff0000u), (kw_[6] >> 16) | (kw_[7] & 0xffff0000u)}; \
        if (tg == 0) { *(LAS f32x2*)(I_ + HG_EBM + 4 * ek) = (f32x2){__builtin_amdgcn_exp2f(bm0_), __builtin_amdgcn_exp2f(bm1_)}; *(LAS f32x2*)(I_ + HG_EBL + 4 * ek) = (f32x2){__builtin_amdgcn_exp2f(bl0_ - bm0_), __builtin_amdgcn_exp2f(bl1_ - bm1_)}; } \
        _Pragma("unroll") for (int e = 0; e < 4; ++e) { const unsigned u_ = vr[e]; \
            *(LAS unsigned short*)(I_ + HG_VT + (vc * 8 + 2 * e) * 144 + vs * 2) = (unsigned short)(u_ & 0xffffu); \
            *(LAS unsigned short*)(I_ + HG_VT + (vc * 8 + 2 * e + 1) * 144 + vs * 2) = (unsigned short)(u_ >> 16); } } while (0)
        HG_LOAD(0);
        HG_EW(0);
        HG_LOAD(1);
        __syncthreads();
        const int vt = w & 3, th = w >> 2;
        for (int c = 0; c < 32; ++c) {
#ifndef HG_SKIP_EW
            if (c + 1 < 32) { HG_EW((c + 1) & 1); if (c + 2 < 32) HG_LOAD(c + 2); }
#else
            if (c + 2 < 32) HG_LOAD(c + 2);
#endif
#ifndef HG_SKIP_MM
            {
                const LAS unsigned char* I = lds + (c & 1) * HG_IMG;
                const LAS unsigned char* QH = I + HG_QH; const LAS unsigned char* KH = I + HG_KH; const LAS unsigned char* KT = I + HG_KT; const LAS unsigned char* VT = I + HG_VT;
                const LAS float* EBM = (const LAS float*)(I + HG_EBM); const LAS float* EBL = (const LAS float*)(I + HG_EBL);
                bf16x8 As[4];
#pragma unroll
                for (int kt = 0; kt < 8; ++kt) S[kt] = S[kt] * *(const LAS f32x4*)(EBM + 16 * kt + 4 * g);
#pragma unroll
                for (int ks = 0; ks < 4; ++ks) { const unsigned x0 = cvt_pk_bf16(S[2 * ks][0], S[2 * ks][1]), x1 = cvt_pk_bf16(S[2 * ks][2], S[2 * ks][3]), x2 = cvt_pk_bf16(S[2 * ks + 1][0], S[2 * ks + 1][1]), x3 = cvt_pk_bf16(S[2 * ks + 1][2], S[2 * ks + 1][3]);
                    As[ks] = __builtin_bit_cast(bf16x8, (v4u){x0, x1, x2, x3}); }
                bf16x8 avp[2], avn[2];
#pragma unroll
                for (int ks = 0; ks < 2; ++ks) { avp[ks] = hg_ld2(VT + (16 * vt + r16) * 144 + (32 * ks + 4 * g) * 2); avn[ks] = *(const LAS bf16x8*)(VT + (16 * vt + r16) * 144 + (32 * ks + 8 * g) * 2); }
#pragma unroll
                for (int ttl = 0; ttl < 2; ++ttl) { const int tt = th ? (1 + ttl) : (3 * ttl), trow = 16 * tt + r16; const LAS unsigned char* qrow = QH + trow * 272;
                    f32x4 oacc = (f32x4){0.f, 0.f, 0.f, 0.f};
#pragma unroll
                    for (int ks = 0; ks < 4; ++ks) oacc = __builtin_amdgcn_mfma_f32_16x16x32_bf16(As[ks], hg_ld2s(qrow, (32 * ks + 4 * g) ^ (16 * tt)), oacc, 0, 0, 0);
                    bf16x8 bq[4];
#pragma unroll
                    for (int ks = 0; ks < 4; ++ks) bq[ks] = *(const LAS bf16x8*)(qrow + 2 * ((32 * ks + 8 * g) ^ (16 * tt)));
#pragma unroll
                    for (int kp2 = 0; kp2 < 2; ++kp2) if (kp2 <= (tt >> 1)) {
                        unsigned pw[4] = {0u, 0u, 0u, 0u};
#pragma unroll
                        for (int si = 0; si < 2; ++si) { const int st = 2 * kp2 + si; if (st <= tt) { f32x4 p = (f32x4){0.f, 0.f, 0.f, 0.f};
#pragma unroll
                                for (int ks = 0; ks < 4; ++ks) p = __builtin_amdgcn_mfma_f32_16x16x32_bf16(*(const LAS bf16x8*)(KH + (16 * st + r16) * 272 + 2 * ((32 * ks + 8 * g) ^ (16 * st))), bq[ks], p, 0, 0, 0);
                                if (st == tt) {
#pragma unroll
                                    for (int i = 0; i < 4; ++i) if (4 * g + i > r16) p[i] = 0.f; }
                                pw[2 * si] = cvt_pk_bf16(p[0], p[1]); pw[2 * si + 1] = cvt_pk_bf16(p[2], p[3]); } }
                        oacc = __builtin_amdgcn_mfma_f32_16x16x32_bf16(avp[kp2], __builtin_bit_cast(bf16x8, (v4u){pw[0], pw[1], pw[2], pw[3]}), oacc, 0, 0, 0);
                    }
                    *(v2u*)(O + HG_ROW(c, trow) * 1024 + colv + vt * 16 + 4 * g) = (v2u){cvt_pk_bf16(oacc[0], oacc[1]), cvt_pk_bf16(oacc[2], oacc[3])};
                }
#pragma unroll
                for (int kt = 0; kt < 8; ++kt) {
#pragma unroll
                    for (int ks = 0; ks < 2; ++ks) S[kt] = __builtin_amdgcn_mfma_f32_16x16x32_bf16(*(const LAS bf16x8*)(KT + (16 * kt + r16) * 144 + (32 * ks + 8 * g) * 2), avn[ks], S[kt], 0, 0, 0);
                    S[kt] = S[kt] * *(const LAS f32x4*)(EBL + 16 * kt + 4 * g); }
            }
#endif
            __syncthreads();
        }
#undef HG_ROW
#undef HG_LOAD
#undef HG_EW
    }
}

__device__ __forceinline__ void cb_row(bf16* Ofw, const bf16* Obw, const bf16* OG, const float* gain, size_t row, int lane) {
    const size_t o = row * 1024 + 16 * lane;
    v4u a[2], b[2], gq[2]; float s[16]; float ss = 0.f;
#pragma unroll
    for (int e = 0; e < 2; ++e) { a[e] = *(const v4u*)(Ofw + o + 8 * e); b[e] = *(const v4u*)(Obw + o + 8 * e); gq[e] = *(const v4u*)(OG + o + 8 * e); }
#pragma unroll
    for (int e = 0; e < 2; ++e)
#pragma unroll
        for (int q = 0; q < 4; ++q) { const float x = bflo(a[e][q]) + bflo(b[e][q]), y = bfhi(a[e][q]) + bfhi(b[e][q]); s[8 * e + 2 * q] = x; s[8 * e + 2 * q + 1] = y; ss += x * x + y * y; }
    ss += __shfl_xor(ss, 1); ss += __shfl_xor(ss, 2); ss += __shfl_xor(ss, 4);
    const float rstd = rsqrtf(ss * (1.f / 128.f) + EPS);
#pragma unroll
    for (int e = 0; e < 2; ++e) { v4u ov;
#pragma unroll
        for (int q = 0; q < 4; ++q) { const f32x2 gn = *(const f32x2*)(gain + 16 * lane + 8 * e + 2 * q);
            ov[q] = cvt_pk_bf16(s[8 * e + 2 * q] * rstd * gn.x * bflo(gq[e][q]), s[8 * e + 2 * q + 1] * rstd * gn.y * bfhi(gq[e][q])); }
        *(v4u*)(Ofw + o + 8 * e) = ov; }
}

#define XB_TMO      128
#define XB_XCNT(j)  (256  + 64 * (j))
#define XB_XSUB(j)  (1280 + 64 * (j))
#define XB_XGEN(j)  (2304 + 64 * (j))
#define XB_TOP      3328
#define XB_TOPGEN   3392
#define XCD_BAR_WORDS 3456
#define XB_SPIN_CAP (1u << 18)

__device__ __forceinline__ unsigned xb_ld(unsigned* p)              { return __hip_atomic_load(p, __ATOMIC_RELAXED, __HIP_MEMORY_SCOPE_AGENT); }
__device__ __forceinline__ unsigned xb_add(unsigned* p, unsigned v) { return __hip_atomic_fetch_add(p, v, __ATOMIC_RELAXED, __HIP_MEMORY_SCOPE_AGENT); }
__device__ __forceinline__ unsigned xb_xcc_id() { return (unsigned)__builtin_amdgcn_s_getreg((3 << 11) | 20) & 0xFu; }
#define XB_SPIN(cond, bar) do { unsigned _sp = 0; while (cond) { __builtin_amdgcn_s_sleep(1); \
    if ((++_sp & 255u) == 0u) { if (xb_ld(&(bar)[XB_TMO])) break; if (_sp > XB_SPIN_CAP) { atomicAdd(&(bar)[XB_TMO], 1u); break; } } } } while (0)

struct XcdBarrier {
    unsigned* bar; unsigned x;
    volatile LAS unsigned* st;
};

__device__ __forceinline__ XcdBarrier xcd_barrier_post(unsigned* bar, volatile LAS unsigned* st) {
    XcdBarrier b; b.bar = bar; b.x = xb_xcc_id(); b.st = st;
    if (threadIdx.x == 0) (void)xb_add(&bar[XB_XCNT(b.x)], 1u);
    return b;
}
__device__ __forceinline__ void xcd_barrier_complete(unsigned* bar, unsigned x, unsigned& nloc, unsigned& nx) {
    const unsigned G = gridDim.x * gridDim.y * gridDim.z;
    unsigned sum, cnt, mine, sp = 0u;
    for (;;) {
        sum = 0u; cnt = 0u; mine = 0u;
#pragma unroll
        for (unsigned j = 0; j < 16; ++j) { const unsigned c = xb_ld(&bar[XB_XCNT(j)]); sum += c; cnt += (c > 0u) ? 1u : 0u; mine = (j == x) ? c : mine; }
        if (sum == G) break;
        __builtin_amdgcn_s_sleep(1);
        if ((++sp & 255u) == 0u) { if (xb_ld(&bar[XB_TMO])) break; if (sp > XB_SPIN_CAP) { atomicAdd(&bar[XB_TMO], 1u); break; } }
    }
    nloc = mine > 0u ? mine : 1u; nx = cnt > 0u ? cnt : 1u;
}

__device__ __forceinline__ void xcd_barrier(const XcdBarrier& b) {
    asm volatile("s_waitcnt vmcnt(0)" ::: "memory");
    __syncthreads();
    if (threadIdx.x == 0) {
        unsigned* bar = b.bar;
        __builtin_amdgcn_s_waitcnt(0);
        unsigned nloc = b.st[0], nx = b.st[1];
        if (nloc == 0u) { xcd_barrier_complete(bar, b.x, nloc, nx); b.st[0] = nloc; b.st[1] = nx; }
        const unsigned old = xb_add(&bar[XB_XSUB(b.x)], 1u);
        const unsigned gen = old / nloc;
        if (old + 1u == (gen + 1u) * nloc) {
            __builtin_amdgcn_fence(__ATOMIC_RELEASE, "agent");
            asm volatile("s_waitcnt vmcnt(0)" ::: "memory");
            const unsigned og = xb_add(&bar[XB_TOP], 1u);
            const unsigned tg = og / nx;
            if (og + 1u == (tg + 1u) * nx) xb_add(&bar[XB_TOPGEN], 1u);
            else XB_SPIN(xb_ld(&bar[XB_TOPGEN]) == tg, bar);
            __builtin_amdgcn_fence(__ATOMIC_ACQUIRE, "agent");
            xb_add(&bar[XB_XGEN(b.x)], 1u);
            asm volatile("s_waitcnt vmcnt(0)" ::: "memory");
        } else {
            XB_SPIN(xb_ld(&bar[XB_XGEN(b.x)]) == gen, bar);
            __builtin_amdgcn_fence(__ATOMIC_ACQUIRE, "agent");
            asm volatile("s_waitcnt vmcnt(0)" ::: "memory");
        }
    }
    __syncthreads();
}

struct Args { const float* in[15]; float* out; unsigned char* ws; int ph_lo, ph_hi; };

__global__ void __launch_bounds__(NTHR, 2) fwd(Args a) {
    extern __shared__ __attribute__((aligned(16))) unsigned char lds_raw[];
    LAS unsigned char* lds = (LAS unsigned char*)lds_raw;
    const int G = gridDim.x, bid = blockIdx.x, NGW = G * NWAVES;
    volatile LAS unsigned* MISC = (volatile LAS unsigned*)(lds + LDS_RING);
    if (threadIdx.x < 16) MISC[threadIdx.x] = 0u;
    __syncthreads();
    XcdBarrier xbar; xbar.bar = (unsigned*)a.ws; xbar.x = 0; xbar.st = nullptr;
    if (a.ph_hi - a.ph_lo > 1) xbar = xcd_barrier_post((unsigned*)a.ws, MISC);
    const float* x = a.in[0]; const float* w_in = a.in[1]; const float* ln_mix = a.in[2]; const float* ln_mlp = a.in[3]; const float* sg_norm = a.in[4];
    const float* w_s = a.in[5]; const float* b_s = a.in[6]; const float* lb_logits = a.in[7]; const float* rec_norm = a.in[8];
    const float* w_pa = a.in[9]; const float* w_pb = a.in[10]; const float* w_out = a.in[11]; const float* w_up = a.in[12]; const float* w_down = a.in[13]; const float* ln_final = a.in[14];
#define BUF(i) ((bf16*)(ws + WS_BUF(i)))
    for (int p = a.ph_lo; p < a.ph_hi; ++p) {
        if (p > a.ph_lo) { asm volatile("s_waitcnt vmcnt(0)" ::: "memory");
#ifdef PROBE_SYNC
            const unsigned long long ts0 = __builtin_amdgcn_s_memrealtime();
#endif
            if (a.ph_lo < 0) cg::this_grid().sync();
            xcd_barrier(xbar);
#ifdef PROBE_SYNC
            { const unsigned long long ts1 = __builtin_amdgcn_s_memrealtime(); if (blockIdx.x == PROBE_SYNC_BLK && threadIdx.x == 0) { float* pp = (float*)(a.ws + 32768); const float prev = (p == a.ph_lo + 1) ? 0.f : *(volatile float*)pp; *pp = prev + (float)(ts1 - ts0) * (1.0f / PROBE_DIV); } }
#endif
            }
        int tid = threadIdx.x; asm volatile("" : "+v"(tid));
        const int lane = tid & 63, wave = __builtin_amdgcn_readfirstlane(tid >> 6), gw = bid * NWAVES + wave;
        unsigned char* ws = a.ws; asm volatile("" : "+s"(ws));
        float* out = a.out; asm volatile("" : "+s"(out));
        float* LB = (float*)(ws + WS_LB); float* RSQ = (float*)(ws + WS_RSQ);
        bf16* WIN = (bf16*)(ws + WS_WIN); bf16* WPA = (bf16*)(ws + WS_WPA); bf16* WPB = (bf16*)(ws + WS_WPB); bf16* WOUT = (bf16*)(ws + WS_WOUT);
        bf16* WUP = (bf16*)(ws + WS_WUP); bf16* WDN = (bf16*)(ws + WS_WDN);
#ifdef DBG_NRUN
        if (p == DBG_NRUN) {
            for (size_t i = (size_t)bid * NTHR + tid; i < (size_t)M * DM; i += (size_t)G * NTHR) { float s = (DBG_NRUN >= 8) ? out[i] : 0.f;
                for (int k = 0; k < 8; ++k) s += bflo((unsigned)((const bf16*)(ws + WS_BUF(k)))[i]); out[i] = s; }
            continue;
        }
        if (p > DBG_NRUN) continue;
#endif
        if (p == NPH - 1) {
            for (int m = gw; m < M; m += NGW) rms_row_f32(out + (size_t)m * DM, ln_final, out + (size_t)m * DM, lane);
            continue;
        }
        const int l = p / PH_PER_LAYER, j = p % PH_PER_LAYER;
#ifdef PROBE_PH
        unsigned long long t0p = 0; if ((PROBE_PH >> j) & 1) t0p = __builtin_amdgcn_s_memrealtime();
#endif
        const float* hin = (l == 0) ? x : out;
#ifndef PHASE_MASK
#define PHASE_MASK 0x7ff
#endif
        if (!((PHASE_MASK >> j) & 1)) continue;
        switch (j) {
        case 0: {
#ifdef DBG_FILL
            if (l == 0) { v4u* fp = (v4u*)(ws + WS_BUF(1)); const size_t n16 = (size_t)7 * BUFB / 16; for (size_t i = (size_t)bid * NTHR + tid; i < n16; i += (size_t)G * NTHR) fp[i] = (v4u){DBG_FILL, DBG_FILL, DBG_FILL, DBG_FILL}; }
#endif
            {
                LAS float* scr = (LAS float*)(lds + wave * 16384);
                constexpr int I_IN = (DM / 64) * (NIN / 32), I_SQ = (DM / 64) * (DM / 32);
                for (int it = gw; it < I_IN + 3 * I_SQ; it += NGW) {
                    if (it < I_IN) transpose_item(w_in + (size_t)l * DM * NIN, DM, NIN, WIN, scr, it, lane);
                    else { const int r = it - I_IN, which = r / I_SQ, ii = r % I_SQ;
                        const float* src = (which == 0 ? w_pa : which == 1 ? w_pb : w_out) + (size_t)l * DM * DM; bf16* dst = which == 0 ? WPA : which == 1 ? WPB : WOUT;
                        transpose_item(src, DM, DM, dst, scr, ii, lane); }
                }
            }
            { const float* wsrc = w_s + (size_t)l * 8 * 16384; unsigned* wdst = (unsigned*)(ws + WS_WSB); for (int i = bid * NTHR + tid; i < 8 * 16384 / 2; i += G * NTHR) { const f32x2 v = *(const f32x2*)(wsrc + 2 * i); wdst[i] = cvt_pk_bf16(v.x, v.y); } }
            for (int i = bid * NTHR + tid; i < 2 * DM; i += G * NTHR) { LB[i] = 0.f; LB[2 * DM + i] = 1.f / (1.f + __expf(lb_logits[i] - lb_logits[2 * DM + i])); }
            if (l == 0) {
                for (int i = bid * NTHR + tid; i < 3 * M; i += G * NTHR) RSQ[i] = 0.f;
                for (int m = gw; m < M; m += NGW) rms_row_bf16(hin + (size_t)m * DM, ln_mix + l * DM, BUF(0) + (size_t)m * DM, lane);
            }
            __syncthreads();
        } break;
        case 1: {
#define PROJ(MA, MB, split, sec0, bufi, lbp) { pg8::Gemm g{BUF(0), WIN + (size_t)(sec0) * DM * DM, M, 3 * DM, DM}; pg8::StaticOrder S; S.init(M, 3 * DM, G, bid); \
            pg8::EpiProj<MA, MB> E{BUF(bufi), (size_t)M * DM, lbp, (l == 0) ? (const float*)nullptr : (const float*)(RSQ + M), split}; pg8::gemm_phase<pg8::EpiProj<MA, MB>, pg8::StaticOrder, PROJ_ALIGN, true>(lds, g, S, E); }
            PROJ(0, 1, 2, 0, 1, LB) PROJ(2, 3, 2, 3, 4, LB + (size_t)l * 2 * DM)
        } break;
        case 2: sg_phase(lds, BUF(1), BUF(2), (const bf16*)(ws + WS_WSB), b_s + (size_t)l * 1024, sg_norm + (size_t)l * DM, bid, G); break;
        case 3: hg_phase(lds, BUF(3), BUF(4), BUF(5), BUF(6), BUF(2), BUF(7), bid, G); break;
        case 4: {
            PROJ(3, 4, 1, 6, 3, LB)
        } break;
        case 5: {
            convert_weight(w_up + (size_t)l * DM * DFF, DM, DFF, WUP, lds, gw, NGW, wave, lane);
            convert_weight(w_down + (size_t)l * DFF * DM, DFF, DM, WDN, lds, gw, NGW, wave, lane);
            for (int m = gw; m < M; m += NGW) cb_row(BUF(2), BUF(7), BUF(3), rec_norm + (size_t)l * DM, (size_t)m, lane);
            __syncthreads();
        } break;
        case 6: {
            pg8::Gemm g{BUF(1), WPA, 2 * M, 2 * DM, DM}; pg8::PairOrder S; S.init(M, DM, G, bid); pg8::EpiGate E{BUF(4), BUF(5)};
            pg8::gemm_phase<pg8::EpiGate, pg8::PairOrder, true, true>(lds, g, S, E);
        } break;
        case 7: {
            pg8::Gemm g{BUF(4), WOUT, M, DM, DM}; pg8::StaticOrder S; S.init(M, DM, G, bid); pg8::EpiResid E{(l == 0) ? x : (const float*)nullptr, BUF(0), ln_mix + DM, (float*)nullptr, BUF(0), ln_mlp + l * DM, RSQ + (size_t)(l == 0 ? 0 : 2) * M};

            pg8::gemm_phase<pg8::EpiResid, pg8::StaticOrder, false, true>(lds, g, S, E);
        } break;
        case 8: {
            pg8::Gemm g{BUF(0), WUP, M, DFF, DM}; pg8::StaticOrder S; S.init(M, DFF, G, bid); pg8::EpiRelu2 E{BUF(1), DFF, RSQ + (size_t)(l == 0 ? 0 : 2) * M};
            pg8::gemm_phase<pg8::EpiRelu2, pg8::StaticOrder, true, true>(lds, g, S, E);
        } break;
        case 9: {
            pg8::Gemm g{BUF(1), WDN, M, DM, DFF}; pg8::StaticOrder S; S.init(M, DM, G, bid);
            pg8::EpiResid E{(const float*)nullptr, BUF(0), ln_mlp + l * DM, (l == 0) ? (float*)nullptr : out, (l == 0) ? BUF(0) : (bf16*)nullptr, ln_mix + DM, RSQ + M};
            pg8::gemm_phase<pg8::EpiResid, pg8::StaticOrder, false, true>(lds, g, S, E);
        } break;
        }
#ifdef PROBE_PH
        if ((PROBE_PH >> j) & 1) { asm volatile("s_waitcnt vmcnt(0)" ::: "memory"); __syncthreads(); const unsigned long long t1p = __builtin_amdgcn_s_memrealtime();
#ifdef PROBE_MAX
            if (tid == 0) atomicMax((unsigned*)(ws + 32768) + 1 + p, (unsigned)(t1p - t0p));
#else
            if (bid == 0 && tid == 0) atomicAdd((unsigned*)(ws + 32768) + 1 + p, (unsigned)(t1p - t0p));
#endif
        }
#endif
    }
#if defined(PROBE_PH)
    if (bid == 0 && threadIdx.x == 0) { asm volatile("s_waitcnt vmcnt(0)" ::: "memory"); unsigned s = 0; for (int q = 0; q < NPH; ++q) s += __hip_atomic_load((unsigned*)(a.ws + 32768) + 1 + q, __ATOMIC_RELAXED, __HIP_MEMORY_SCOPE_AGENT); a.out[0] = (float)s * (1.0f / PROBE_DIV); }
#elif defined(PROBE_SYNC)
    if (bid == 0 && threadIdx.x == 0) { asm volatile("s_waitcnt vmcnt(0)" ::: "memory"); a.out[0] = *(volatile float*)(a.ws + 32768); }
#endif
#undef BUF
}

extern "C" void kernel_launch(void* const* d_in, const int* in_sizes, int n_in, void* d_out, int out_size, void* d_ws, size_t ws_size, hipStream_t stream) {
    static int grid = 0;
    if (grid == 0) {
        if (n_in != 15 || out_size != M * DM || ws_size < WS_END) { fprintf(stderr, "kernel_launch: unexpected problem (n_in %d, out %d, ws %zu < %zu)\n", n_in, out_size, ws_size, (size_t)WS_END); grid = -1; return; }
        int dev = 0, cus = 0, per_cu = 0;
        hipGetDevice(&dev); hipDeviceGetAttribute(&cus, hipDeviceAttributeMultiprocessorCount, dev);
        if (hipFuncSetAttribute((const void*)fwd, hipFuncAttributeMaxDynamicSharedMemorySize, LDS_BYTES) != hipSuccess) { fprintf(stderr, "kernel_launch: hipFuncSetAttribute failed\n"); grid = -1; return; }
        if (hipOccupancyMaxActiveBlocksPerMultiprocessor(&per_cu, (const void*)fwd, NTHR, LDS_BYTES) != hipSuccess || per_cu < 1) { fprintf(stderr, "kernel_launch: occupancy query says %d\n", per_cu); per_cu = 1; }
        (void)hipGetLastError();
        grid = cus;
    }
    if (grid < 0) return;
#if defined(PROBE_PH)
    (void)hipMemsetAsync((char*)d_ws + 32768, 0, 512, stream);
#endif
    (void)hipMemsetAsync(d_ws, 0, 16384, stream);
    Args a{};
    for (int i = 0; i < 15; ++i) a.in[i] = (const float*)d_in[i];
    a.out = (float*)d_out; a.ws = (unsigned char*)d_ws;
#if ONE_LAUNCH
    a.ph_lo = 0; a.ph_hi = NPH;
    void* args[] = {&a};
    hipError_t e = hipLaunchCooperativeKernel((const void*)fwd, dim3(grid), dim3(NTHR), args, LDS_BYTES, stream);
    if (e != hipSuccess) fprintf(stderr, "cooperative launch failed: %s (grid %d)\n", hipGetErrorString(e), grid);
#else
    for (int p = 0; p < NPH; ++p) { a.ph_lo = p; a.ph_hi = p + 1; hipLaunchKernelGGL(fwd, dim3(grid), dim3(NTHR), LDS_BYTES, stream, a); }
#endif
}
```

```cpp
#define ONE_LAUNCH 1
#include <hip/hip_runtime.h>
#include <hip/hip_cooperative_groups.h>
#include <cstdio>
#include <cstdint>
namespace cg = cooperative_groups;
namespace pg8 {
#define PG8_LAS __attribute__((address_space(3)))
typedef unsigned short bf16_t;
typedef short bf16x8 __attribute__((ext_vector_type(8)));
typedef float f32x4 __attribute__((ext_vector_type(4)));
typedef unsigned u32x4 __attribute__((ext_vector_type(4)));
constexpr int BM = 256, BK = 64, HALF = 128, HTB = HALF * BK * 2  , STAGE_BYTES = 8 * HTB, NXCD = 8, WGM = 8;

__host__ __device__ __forceinline__ int lds_byte(int r, int c) { const int st = (r >> 4) * 2 + (c >> 5), rr = r & 15, cc = c & 31, ob = rr * 64 + cc * 2; return st * 1024 + (ob ^ (((ob >> 9) & 1) << 5)); }
__host__ __device__ __forceinline__ void stage_rc(int b, int& R, int& C) { const int st = b / 1024, sb = b % 1024, swz = sb ^ (((sb >> 9) & 1) << 5); R = (st >> 1) * 16 + swz / 64; C = (st & 1) * 32 + (swz % 64) / 2; }
__host__ __device__ __forceinline__ int perm32(int rho) { const int n = rho >> 4, i = rho & 15; return 8 * (i >> 2) + 4 * n + (i & 3); }

struct Unit { int pm, pn; };
struct Gemm { const bf16_t* A; const bf16_t* Bt; int M, N, K; };

struct StaticOrder {
    int nM, nN, nwg, G, c;
    __host__ __device__ void init(int M, int N, int G_, int c_) { nM = M / BM; nN = N / BM; nwg = nM * nN; G = G_; c = c_; }
    __host__ __device__ bool next(int i, Unit& u) const {
        const long L = (long)i * G + c; if (L >= nwg) return false;
        int wgid = (int)L; { const int q = nwg / NXCD, r = nwg % NXCD, xcd = wgid % NXCD, off = wgid / NXCD; wgid = (xcd < r ? xcd * (q + 1) : r * (q + 1) + (xcd - r) * q) + off; }
        const int nig = WGM * nN, gid = wgid / nig, fm = gid * WGM, gsz = (nM - fm) < WGM ? (nM - fm) : WGM;
        u.pm = fm + ((wgid % nig) % gsz); u.pn = (wgid % nig) / gsz; return true;
    }
    __device__ __forceinline__ void a_ready(const Unit&) const {}
    __device__ __forceinline__ void done(const Unit&) const {}
};

typedef float cvt_f32x2_t __attribute__((ext_vector_type(2)));
typedef __bf16 cvt_bf16x2_t __attribute__((ext_vector_type(2)));
__device__ __forceinline__ unsigned cvt_pk_bf16(float lo, float hi) { cvt_f32x2_t v = {lo, hi}; cvt_bf16x2_t b = __builtin_convertvector(v, cvt_bf16x2_t); return __builtin_bit_cast(unsigned, b); }
typedef float f32x2 __attribute__((ext_vector_type(2)));
__device__ __forceinline__ f32x2 gelu_pk(f32x2 v) {
    const f32x2 av = __builtin_elementwise_abs(v), d = av * 0.2316418882f + 1.0f;
    f32x2 t; t.x = __builtin_amdgcn_rcpf(d.x); t.y = __builtin_amdgcn_rcpf(d.y);
    f32x2 q = t * 0.5307027145f + (-0.7265760135f); q = q * t + 0.7107068705f; q = q * t + (-0.142248368f); q = q * t + 0.127414796f; q = q * t;
    const f32x2 s = (v * v) * (-0.72134752044f);
    f32x2 e; e.x = __builtin_amdgcn_exp2f(s.x); e.y = __builtin_amdgcn_exp2f(s.y);
    const f32x2 m = v * (q * e), r = v - m;
    f32x2 o; o.x = v.x < 0.f ? m.x : r.x; o.y = v.y < 0.f ? m.y : r.y; return o;
}
__device__ __forceinline__ float bflo(unsigned u) { return __builtin_bit_cast(float, u << 16); }
__device__ __forceinline__ float bfhi(unsigned u) { return __builtin_bit_cast(float, u & 0xffff0000u); }
__device__ __forceinline__ float sigm(float z) { return __builtin_amdgcn_rcpf(1.0f + __expf(-z)); }
template <int MA, int MB> struct EpiProj {
    static constexpr bool PERM = true, AFTER_DRAIN = false;
    bf16_t* out0; size_t sec_stride; const float* lb; const unsigned long long* rowsq; int split;
    template <int MODE> __device__ __forceinline__ void run(const f32x4 (&acc)[2][2][4][2], bf16_t* base, const float* lbrow, int row0, int col0) const {
#pragma unroll
        for (int ai = 0; ai < 2; ++ai)
#pragma unroll
            for (int m = 0; m < 4; ++m) { bf16_t* rowp = base + (size_t)(row0 + ai * HALF + m * 16) * 1024 + col0;
                const float rs = rowsq ? rsqrtf((float)rowsq[row0 + ai * HALF + m * 16] * (1.0f / 16777216.0f / 1024.0f) + 1e-6f) : 1.0f;
#pragma unroll
                for (int bj = 0; bj < 2; ++bj) { f32x4 v[2] = {acc[ai][bj][m][0] * rs, acc[ai][bj][m][1] * rs};
#pragma unroll
                    for (int n = 0; n < 2; ++n) {
                        if (MODE == 0) { f32x2 a = gelu_pk((f32x2){v[n][0], v[n][1]}), b = gelu_pk((f32x2){v[n][2], v[n][3]}); v[n] = (f32x4){a.x, a.y, b.x, b.y}; }
                        else if (MODE == 2) { const f32x4 lbv = *(const f32x4*)(lbrow + bj * HALF + 4 * n);
#pragma unroll
                            for (int e = 0; e < 4; ++e) { const float l = lbv[e]; const float f = l + (1.0f - l) * sigm(v[n][e]); v[n][e] = __log2f(f); }
                        } else if (MODE == 3) {
#pragma unroll
                            for (int e = 0; e < 4; ++e) v[n][e] = v[n][e] * sigm(v[n][e]);
                        } else if (MODE == 4) {
#pragma unroll
                            for (int e = 0; e < 4; ++e) v[n][e] = sigm(v[n][e]);
                        }
                    }
                    u32x4 w; w.x = cvt_pk_bf16(v[0][0], v[0][1]); w.y = cvt_pk_bf16(v[0][2], v[0][3]); w.z = cvt_pk_bf16(v[1][0], v[1][1]); w.w = cvt_pk_bf16(v[1][2], v[1][3]);
                    *(u32x4*)(rowp + bj * HALF) = w; } }
    }
    __device__ __forceinline__ void operator()(const f32x4 (&acc)[2][2][4][2], const Unit& u, int wr, int wc, int fr, int fq) const {
        const int colt = u.pn * BM, sec = colt >> 10;
        bf16_t* base = out0 + (size_t)sec * sec_stride;
        const int col0 = (colt & 1023) + wc * 32 + 8 * fq, row0 = u.pm * BM + wr * 64 + fr;
        const float* lbrow = lb + sec * 1024 + col0;
        if (sec < split) run<MA>(acc, base, lbrow, row0, col0); else run<MB>(acc, base, lbrow, row0, col0);
    }
};
struct EpiGate {
    static constexpr bool PERM = true, AFTER_DRAIN = false;
    bf16_t* T; const bf16_t* gate2;
    __device__ __forceinline__ void operator()(const f32x4 (&acc)[2][2][4][2], const Unit& u, int wr, int wc, int fr, int fq) const {
        const bool second = u.pm >= 64;
        const int col0 = (u.pn & 3) * BM + wc * 32 + 8 * fq, row0 = (u.pm & 63) * BM + wr * 64 + fr;
        const bf16_t* gate = second ? gate2 : T;
        u32x4 cg[2], ca[2], ng[2], na[2];
        { const size_t ro = (size_t)row0 * 1024 + col0; cg[0] = *(const u32x4*)(gate + ro); cg[1] = *(const u32x4*)(gate + ro + HALF);
          ca[0] = ca[1] = (u32x4){0u, 0u, 0u, 0u}; if (second) { ca[0] = *(const u32x4*)(T + ro); ca[1] = *(const u32x4*)(T + ro + HALF); } }
#pragma unroll
        for (int ai = 0; ai < 2; ++ai)
#pragma unroll
            for (int m = 0; m < 4; ++m) { asm volatile("" ::: "memory"); __builtin_amdgcn_sched_barrier(0); const size_t ro = (size_t)(row0 + ai * HALF + m * 16) * 1024 + col0;
                if (ai * 4 + m < 7) { const int nm = (m + 1) & 3, nai = ai + ((m + 1) >> 2); const size_t rn = (size_t)(row0 + nai * HALF + nm * 16) * 1024 + col0;
                    ng[0] = *(const u32x4*)(gate + rn); ng[1] = *(const u32x4*)(gate + rn + HALF); na[0] = na[1] = (u32x4){0u, 0u, 0u, 0u}; if (second) { na[0] = *(const u32x4*)(T + rn); na[1] = *(const u32x4*)(T + rn + HALF); } }
#pragma unroll
                for (int bj = 0; bj < 2; ++bj) {
                    const u32x4 gv = cg[bj], av = ca[bj];
                    const f32x4 v0 = acc[ai][bj][m][0], v1 = acc[ai][bj][m][1];
                    u32x4 w;
                    w.x = cvt_pk_bf16(bflo(av.x) + bflo(gv.x) * v0[0], bfhi(av.x) + bfhi(gv.x) * v0[1]);
                    w.y = cvt_pk_bf16(bflo(av.y) + bflo(gv.y) * v0[2], bfhi(av.y) + bfhi(gv.y) * v0[3]);
                    w.z = cvt_pk_bf16(bflo(av.z) + bflo(gv.z) * v1[0], bfhi(av.z) + bfhi(gv.z) * v1[1]);
                    w.w = cvt_pk_bf16(bflo(av.w) + bflo(gv.w) * v1[2], bfhi(av.w) + bfhi(gv.w) * v1[3]);
                    *(u32x4*)(T + ro + bj * HALF) = w; }
                cg[0] = ng[0]; cg[1] = ng[1]; ca[0] = na[0]; ca[1] = na[1]; }
    }
};
struct PairOrder {
    StaticOrder S;
    __device__ void init(int M_, int N_, int G_, int c_) { S.init(M_, N_, G_, c_); }
    __device__ bool next(int i, Unit& u) const { if (!S.next(i >> 1, u)) return false; if (i & 1) { u.pm += 64; u.pn += 4; } return true; }
    __device__ __forceinline__ void a_ready(const Unit&) const {}
    __device__ __forceinline__ void done(const Unit&) const {}
};
template <bool F32BASE> struct EpiResid {
    static constexpr bool PERM = true, AFTER_DRAIN = false;
    const float* base32; const bf16_t* xg_in; const float* gain_in; float* out32; bf16_t* xg_out; const float* gain_out; unsigned long long* rowsq;
    __device__ __forceinline__ void ldrow(u32x4 (&r)[4], size_t ro) const {
        if (F32BASE) { r[0] = *(const u32x4*)(base32 + ro); r[1] = *(const u32x4*)(base32 + ro + 4); r[2] = *(const u32x4*)(base32 + ro + HALF); r[3] = *(const u32x4*)(base32 + ro + HALF + 4); }
        else { r[0] = *(const u32x4*)(xg_in + ro); r[1] = *(const u32x4*)(xg_in + ro + HALF); }
    }
    __device__ __forceinline__ void operator()(const f32x4 (&acc)[2][2][4][2], const Unit& u, int wr, int wc, int fr, int fq) const {
        const int col0 = u.pn * BM + wc * 32 + 8 * fq, row0 = u.pm * BM + wr * 64 + fr;
        u32x4 cur[4], nxt[4];
        if (!F32BASE) ldrow(cur, (size_t)row0 * 1024 + col0);
#pragma unroll
        for (int ai = 0; ai < 2; ++ai)
#pragma unroll
            for (int m = 0; m < 4; ++m) { asm volatile("" ::: "memory"); __builtin_amdgcn_sched_barrier(0); const int row = row0 + ai * HALF + m * 16; const size_t ro = (size_t)row * 1024 + col0; float ss = 0.f;
                if (F32BASE) ldrow(cur, ro); else if (ai * 4 + m < 7) { const int nm = (m + 1) & 3, nai = ai + ((m + 1) >> 2); ldrow(nxt, (size_t)(row0 + nai * HALF + nm * 16) * 1024 + col0); }
#pragma unroll
                for (int bj = 0; bj < 2; ++bj) { f32x4 h[2];
                    if (F32BASE) { h[0] = __builtin_bit_cast(f32x4, cur[2 * bj]); h[1] = __builtin_bit_cast(f32x4, cur[2 * bj + 1]); }
                    else { const u32x4 xv = cur[bj];
                        const f32x4 g0 = *(const f32x4*)(gain_in + col0 + bj * HALF), g1 = *(const f32x4*)(gain_in + col0 + bj * HALF + 4);
                        h[0] = (f32x4){bflo(xv.x) * __builtin_amdgcn_rcpf(g0[0]), bfhi(xv.x) * __builtin_amdgcn_rcpf(g0[1]), bflo(xv.y) * __builtin_amdgcn_rcpf(g0[2]), bfhi(xv.y) * __builtin_amdgcn_rcpf(g0[3])};
                        h[1] = (f32x4){bflo(xv.z) * __builtin_amdgcn_rcpf(g1[0]), bfhi(xv.z) * __builtin_amdgcn_rcpf(g1[1]), bflo(xv.w) * __builtin_amdgcn_rcpf(g1[2]), bfhi(xv.w) * __builtin_amdgcn_rcpf(g1[3])}; }
#pragma unroll
                    for (int n = 0; n < 2; ++n) { h[n] = h[n] + acc[ai][bj][m][n]; if (out32) *(f32x4*)(out32 + ro + bj * HALF + 4 * n) = h[n];
                        ss += (h[n][0] * h[n][0] + h[n][1] * h[n][1]) + (h[n][2] * h[n][2] + h[n][3] * h[n][3]); }
                    if (xg_out) { const f32x4 g0 = *(const f32x4*)(gain_out + col0 + bj * HALF), g1 = *(const f32x4*)(gain_out + col0 + bj * HALF + 4);
                        u32x4 w; w.x = cvt_pk_bf16(h[0][0] * g0[0], h[0][1] * g0[1]); w.y = cvt_pk_bf16(h[0][2] * g0[2], h[0][3] * g0[3]); w.z = cvt_pk_bf16(h[1][0] * g1[0], h[1][1] * g1[1]); w.w = cvt_pk_bf16(h[1][2] * g1[2], h[1][3] * g1[3]);
                        *(u32x4*)(xg_out + ro + bj * HALF) = w; } }
                if (xg_out) { ss += __shfl_xor(ss, 16); ss += __shfl_xor(ss, 32); if (fq == 0) atomicAdd(rowsq + row, (unsigned long long)(ss * 16777216.0f)); }
                if (!F32BASE) { cur[0] = nxt[0]; cur[1] = nxt[1]; } }
    }
};
struct EpiRelu2 {
    static constexpr bool PERM = true, AFTER_DRAIN = false;
    bf16_t* out; int ldc; const unsigned long long* rowsq;
    __device__ __forceinline__ void operator()(const f32x4 (&acc)[2][2][4][2], const Unit& u, int wr, int wc, int fr, int fq) const {
        const int col0 = u.pn * BM + wc * 32 + 8 * fq, row0 = u.pm * BM + wr * 64 + fr;
#pragma unroll
        for (int ai = 0; ai < 2; ++ai)
#pragma unroll
            for (int m = 0; m < 4; ++m) { asm volatile("" ::: "memory"); __builtin_amdgcn_sched_barrier(0); bf16_t* rowp = out + (size_t)(row0 + ai * HALF + m * 16) * ldc + col0;
                const float rs = rsqrtf((float)rowsq[row0 + ai * HALF + m * 16] * (1.0f / 16777216.0f / 1024.0f) + 1e-6f);
#pragma unroll
                for (int bj = 0; bj < 2; ++bj) { f32x4 v0 = acc[ai][bj][m][0] * rs, v1 = acc[ai][bj][m][1] * rs;
#pragma unroll
                    for (int e = 0; e < 4; ++e) { const float a = fmaxf(v0[e], 0.f), b = fmaxf(v1[e], 0.f); v0[e] = a * a; v1[e] = b * b; }
                    u32x4 w; w.x = cvt_pk_bf16(v0[0], v0[1]); w.y = cvt_pk_bf16(v0[2], v0[3]); w.z = cvt_pk_bf16(v1[0], v1[1]); w.w = cvt_pk_bf16(v1[2], v1[3]);
                    *(u32x4*)(rowp + bj * HALF) = w; } }
    }
};
template <class Epi, class Sched, bool ALIGN_EPI = false, bool SP2 = false>
__device__ __forceinline__ void gemm_phase(PG8_LAS unsigned char* lds, const Gemm g, const Sched& S, const Epi& E) {
    int tid_l = threadIdx.x; asm volatile("" : "+v"(tid_l));
    const int tid = tid_l, wid = __builtin_amdgcn_readfirstlane(tid >> 6), lane = tid & 63, wr = wid >> 2, wc = wid & 3, fr = lane & 15, fq = lane >> 4;
    const int K = g.K, nt = K / BK;
    unsigned voffA[2], voffB[2];
#pragma unroll
    for (int i = 0; i < 2; ++i) { int R, C; stage_rc(tid * 16 + i * 8192, R, C); const int Rb = Epi::PERM ? ((R & ~31) + perm32(R & 31)) : R;
        voffA[i] = (unsigned)(R * K + C) * 2u; voffB[i] = (unsigned)(Rb * K + C) * 2u; }
    const size_t kstep = (size_t)(BK * 2);
    const size_t hstep = (size_t)HALF * K * 2;
    const size_t tstep = 2 * hstep;
    const unsigned ldsw = (unsigned)wid * 1024u;
    const int aoff = lds_byte(wr * 64 + fr, fq * 8), boff = lds_byte(wc * 32 + fr, fq * 8);
#define PG8_SA(b, h) (((b) * 2 + (h)) * HTB)
#define PG8_SB(b, h) ((4 + (b) * 2 + (h)) * HTB)
#define PG8_STAGE(bufoff, gbase, voff) do { _Pragma("unroll") for (int _i = 0; _i < 2; ++_i) \
        __builtin_amdgcn_global_load_lds((const unsigned*)((const char*)(gbase) + (voff)[_i]), (PG8_LAS unsigned*)(lds + (bufoff) + ldsw + _i * 8192), 16, 0, 0); } while (0)
#define PG8_LDA(dst, b, h) do { _Pragma("unroll") for (int m = 0; m < 4; ++m) _Pragma("unroll") for (int k = 0; k < 2; ++k) dst[m][k] = *(const PG8_LAS bf16x8*)(lds + PG8_SA(b, h) + aoff + m * 2048 + k * 1024); } while (0)
#define PG8_LDB(dst, b, h) do { _Pragma("unroll") for (int n = 0; n < 2; ++n) _Pragma("unroll") for (int k = 0; k < 2; ++k) dst[n][k] = *(const PG8_LAS bf16x8*)(lds + PG8_SB(b, h) + boff + n * 2048 + k * 1024); } while (0)
#define PG8_MMA(ai, bj, At, Bt) do { __builtin_amdgcn_s_setprio(1); _Pragma("unroll") for (int m = 0; m < 4; ++m) _Pragma("unroll") for (int n = 0; n < 2; ++n) _Pragma("unroll") for (int k = 0; k < 2; ++k) \
        acc[ai][bj][m][n] = __builtin_amdgcn_mfma_f32_16x16x32_bf16(Bt[n][k], At[m][k], acc[ai][bj][m][n], 0, 0, 0); __builtin_amdgcn_s_setprio(0); } while (0)
#define PG8_WAIT_V(n) asm volatile("s_waitcnt vmcnt(" #n ")" ::: "memory")
#define PG8_WAIT_L(n) asm volatile("s_waitcnt lgkmcnt(" #n ")" ::: "memory")
#define PG8_BAR __builtin_amdgcn_s_barrier()
#define PG8_SCHED __builtin_amdgcn_sched_barrier(0)
    Unit cur, nxt; int ui = 0;
    if (!S.next(0, cur)) return;
    f32x4 acc[2][2][4][2];
#pragma unroll
    for (int a = 0; a < 2; ++a)
#pragma unroll
        for (int b = 0; b < 2; ++b)
#pragma unroll
            for (int m = 0; m < 4; ++m)
#pragma unroll
                for (int n = 0; n < 2; ++n) acc[a][b][m][n] = (f32x4){0.f, 0.f, 0.f, 0.f};
    bf16x8 At[4][2], B0[2][2], B1[2][2];
    const char* cA = (const char*)g.A + (size_t)cur.pm * tstep; const char* cB = (const char*)g.Bt + (size_t)cur.pn * tstep;
    S.a_ready(cur);
    if constexpr (SP2) {
        PG8_STAGE(PG8_SB(0, 0), cB, voffB); PG8_STAGE(PG8_SB(0, 1), cB + hstep, voffB); PG8_STAGE(PG8_SA(0, 0), cA, voffA); PG8_STAGE(PG8_SA(0, 1), cA + hstep, voffA);
        if (wr == 1) PG8_BAR;
        PG8_WAIT_V(2); PG8_BAR;
        PG8_STAGE(PG8_SB(1, 0), cB + kstep, voffB); PG8_STAGE(PG8_SA(1, 0), cA + kstep, voffA); PG8_STAGE(PG8_SB(1, 1), cB + hstep + kstep, voffB);
        PG8_WAIT_V(6); PG8_BAR;
    } else {
        PG8_STAGE(PG8_SB(0, 0), cB, voffB); PG8_STAGE(PG8_SA(0, 0), cA, voffA); PG8_STAGE(PG8_SB(0, 1), cB + hstep, voffB); PG8_STAGE(PG8_SA(0, 1), cA + hstep, voffA);
        if (wr == 1) PG8_BAR;
        PG8_WAIT_V(4); PG8_BAR;
        PG8_STAGE(PG8_SB(1, 0), cB + kstep, voffB); PG8_STAGE(PG8_SA(1, 0), cA + kstep, voffA); PG8_STAGE(PG8_SB(1, 1), cB + hstep + kstep, voffB);
        PG8_WAIT_V(6); PG8_BAR;
    }
    for (;;) {
        const bool has_next = S.next(ui + 1, nxt);
        const char* nA = has_next ? (const char*)g.A + (size_t)nxt.pm * tstep : cA; const char* nB = has_next ? (const char*)g.Bt + (size_t)nxt.pn * tstep : cB;
        for (int t = 0; t < nt; t += 2) {
            const bool last = (t == nt - 2);
            const char* a1 = cA + (size_t)(t + 1) * kstep;
            const char* a2 = last ? nA : cA + (size_t)(t + 2) * kstep; const char* b2 = last ? nB : cB + (size_t)(t + 2) * kstep;
            const char* a3 = a2 + kstep; const char* b3 = b2 + kstep;
            if (last && has_next) S.a_ready(nxt);
            if constexpr (SP2) {
            PG8_LDB(B0, 0, 0); PG8_LDB(B1, 0, 1); PG8_SCHED; PG8_LDA(At, 0, 0); PG8_STAGE(PG8_SA(1, 1), a1 + hstep, voffA);
            PG8_WAIT_V(8); PG8_WAIT_L(0); PG8_BAR; PG8_MMA(0, 0, At, B0); PG8_MMA(0, 1, At, B1); PG8_BAR; PG8_SCHED;
            PG8_LDA(At, 0, 1); PG8_STAGE(PG8_SB(0, 0), b2, voffB); PG8_STAGE(PG8_SB(0, 1), b2 + hstep, voffB); PG8_STAGE(PG8_SA(0, 0), a2, voffA);
            PG8_WAIT_V(8); PG8_WAIT_L(0); PG8_BAR; PG8_MMA(1, 0, At, B0); PG8_MMA(1, 1, At, B1); PG8_BAR; PG8_SCHED;
            PG8_LDB(B0, 1, 0); PG8_LDB(B1, 1, 1); PG8_SCHED; PG8_LDA(At, 1, 0); PG8_STAGE(PG8_SA(0, 1), a2 + hstep, voffA);
            PG8_WAIT_V(8); PG8_WAIT_L(0); PG8_BAR; PG8_MMA(0, 0, At, B0); PG8_MMA(0, 1, At, B1); PG8_BAR; PG8_SCHED;
            PG8_LDA(At, 1, 1); PG8_STAGE(PG8_SB(1, 0), b3, voffB); PG8_STAGE(PG8_SB(1, 1), b3 + hstep, voffB); PG8_STAGE(PG8_SA(1, 0), a3, voffA);
            PG8_WAIT_V(8); PG8_WAIT_L(0); PG8_BAR; PG8_MMA(1, 0, At, B0); PG8_MMA(1, 1, At, B1); PG8_BAR; PG8_SCHED;
            } else {
            PG8_LDB(B0, 0, 0); PG8_SCHED; PG8_LDA(At, 0, 0); PG8_STAGE(PG8_SA(1, 1), a1 + hstep, voffA);
            PG8_WAIT_L(8); PG8_BAR; PG8_WAIT_L(0); PG8_MMA(0, 0, At, B0); PG8_BAR; PG8_SCHED;
            PG8_LDB(B1, 0, 1); PG8_STAGE(PG8_SB(0, 0), b2, voffB);
            PG8_BAR; PG8_WAIT_L(0); PG8_MMA(0, 1, At, B1); PG8_BAR;
            PG8_LDA(At, 0, 1); PG8_STAGE(PG8_SA(0, 0), a2, voffA);
            PG8_BAR; PG8_WAIT_L(0); PG8_MMA(1, 0, At, B0); PG8_BAR; PG8_SCHED;
            PG8_STAGE(PG8_SB(0, 1), b2 + hstep, voffB);
            PG8_WAIT_V(6); PG8_BAR; PG8_MMA(1, 1, At, B1); PG8_BAR;
            PG8_LDB(B0, 1, 0); PG8_SCHED; PG8_LDA(At, 1, 0); PG8_STAGE(PG8_SA(0, 1), a2 + hstep, voffA);
            PG8_WAIT_L(8); PG8_BAR; PG8_WAIT_L(0); PG8_MMA(0, 0, At, B0); PG8_BAR; PG8_SCHED;
            PG8_LDB(B1, 1, 1); PG8_STAGE(PG8_SB(1, 0), b3, voffB);
            PG8_BAR; PG8_WAIT_L(0); PG8_MMA(0, 1, At, B1); PG8_BAR;
            PG8_LDA(At, 1, 1); PG8_STAGE(PG8_SA(1, 0), a3, voffA);
            PG8_BAR; PG8_WAIT_L(0); PG8_MMA(1, 0, At, B0); PG8_BAR; PG8_SCHED;
            PG8_STAGE(PG8_SB(1, 1), b3 + hstep, voffB);
            PG8_WAIT_V(6); PG8_BAR; PG8_MMA(1, 1, At, B1); PG8_BAR;
            }
        }
        if constexpr (ALIGN_EPI) { if (wr == 0) PG8_BAR; }
        if constexpr (!Epi::AFTER_DRAIN) { E(acc, cur, wr, wc, fr, fq); S.done(cur); }
        if (!has_next) break;
#pragma unroll
        for (int a = 0; a < 2; ++a)
#pragma unroll
            for (int b = 0; b < 2; ++b)
#pragma unroll
                for (int m = 0; m < 4; ++m)
#pragma unroll
                    for (int n = 0; n < 2; ++n) acc[a][b][m][n] = (f32x4){0.f, 0.f, 0.f, 0.f};
        cur = nxt; cA = nA; cB = nB; ++ui;
        if constexpr (ALIGN_EPI) { if (wr == 1) PG8_BAR; }
    }
    PG8_WAIT_V(0);
    if constexpr (!ALIGN_EPI) { if (wr == 0) PG8_BAR; }
    PG8_BAR;
    if constexpr (Epi::AFTER_DRAIN) { E.fused(acc, cur, wr, wc, fr, fq, lds, wid, lane); S.done(cur); }
#undef PG8_SA
#undef PG8_SB
#undef PG8_STAGE
#undef PG8_LDA
#undef PG8_LDB
#undef PG8_MMA
#undef PG8_WAIT_V
#undef PG8_WAIT_L
#undef PG8_BAR
#undef PG8_SCHED
}
}

#define LAS __attribute__((address_space(3)))
typedef unsigned short bf16;
typedef unsigned v4u __attribute__((ext_vector_type(4)));
typedef unsigned v2u __attribute__((ext_vector_type(2)));
typedef float f32x4 __attribute__((ext_vector_type(4)));
typedef float f32x2 __attribute__((ext_vector_type(2)));
typedef short bf16x8 __attribute__((ext_vector_type(8)));
typedef short s16x4 __attribute__((ext_vector_type(4)));
using pg8::bflo; using pg8::bfhi; using pg8::cvt_pk_bf16;

#ifndef PROJ_ALIGN
#define PROJ_ALIGN true
#endif
#ifndef ONE_LAUNCH
#define ONE_LAUNCH 1
#endif
constexpr int DM = 1024, BATCH = 8, SEQ = 2048, M = BATCH * SEQ, NIN = 9216, DFF = 4096, DEPTH = 2;
constexpr float EPS = 1e-6f;
constexpr int NTHR = 512, NWAVES = 8;
constexpr int LDS_RING = 131072, LDS_BYTES = LDS_RING + 64;
constexpr size_t MiB = 1u << 20;
constexpr size_t WS_RSQ = 256 * 1024;
constexpr size_t WS_WSB = 768 * 1024;
constexpr size_t WS_LB = 64 * 1024;
constexpr size_t WS_WIN = 1 * MiB, WS_WPA = 19 * MiB, WS_WPB = 21 * MiB, WS_WOUT = 23 * MiB;
constexpr size_t WS_B0 = 25 * MiB, BUFB = 32 * MiB;
constexpr size_t WS_END = WS_B0 + 8 * BUFB;
#define WS_BUF(i) (WS_B0 + (size_t)(i) * BUFB)
constexpr size_t WS_WUP = WS_BUF(6), WS_WDN = WS_BUF(6) + 8 * MiB;
constexpr int PH_PER_LAYER = 10, NPH = DEPTH * PH_PER_LAYER + 1;

__device__ __forceinline__ float wave_sum(float v) {
#pragma unroll
    for (int o = 1; o < 64; o <<= 1) v += __shfl_xor(v, o);
    return v;
}
__device__ __forceinline__ void transpose_item(const float* W, int K, int N, bf16* WT, LAS float* scr, int item, int lane) {
    const int nblk = N / 32, kb = item / nblk, nb = item % nblk, k0 = 64 * kb, n0 = 32 * nb;
#pragma unroll
    for (int i = 0; i < 8; ++i) { const int kk = 8 * i + (lane >> 3), c4 = lane & 7; const f32x4 v = __builtin_nontemporal_load((const f32x4*)(W + (size_t)(k0 + kk) * N + n0 + 4 * c4));
        LAS float* d = scr + kk * 33 + 4 * c4; d[0] = v.x; d[1] = v.y; d[2] = v.z; d[3] = v.w; }
    asm volatile("s_waitcnt lgkmcnt(0)" ::: "memory");
    const int c = lane & 7;
#pragma unroll
    for (int j = 0; j < 4; ++j) { const int n = (lane >> 3) + 8 * j; const LAS float* s = scr + (8 * c) * 33 + n;
        v4u o; o.x = cvt_pk_bf16(s[0 * 33], s[1 * 33]); o.y = cvt_pk_bf16(s[2 * 33], s[3 * 33]); o.z = cvt_pk_bf16(s[4 * 33], s[5 * 33]); o.w = cvt_pk_bf16(s[6 * 33], s[7 * 33]);
        *(v4u*)(WT + (size_t)(n0 + n) * K + k0 + 8 * c) = o; }
    asm volatile("s_waitcnt lgkmcnt(0)" ::: "memory");
}
__device__ __forceinline__ void convert_weight(const float* W, int K, int N, bf16* WT, LAS unsigned char* lds, int gw, int NGW, int wave, int lane) {
    LAS float* scr = (LAS float*)(lds + wave * 16384);
    const int nitems = (K / 64) * (N / 32);
    for (int it = gw; it < nitems; it += NGW) transpose_item(W, K, N, WT, scr, it, lane);
}
__device__ __forceinline__ void rms_row_bf16(const float* xrow, const float* gain, bf16* orow, int lane) {
    const f32x4* xr = (const f32x4*)xrow + lane; const f32x4* gr = (const f32x4*)gain + lane;
    f32x4 v[4]; float s = 0.f;
#pragma unroll
    for (int j = 0; j < 4; ++j) { v[j] = xr[64 * j]; s += (v[j].x * v[j].x + v[j].y * v[j].y) + (v[j].z * v[j].z + v[j].w * v[j].w); }
    const float rstd = rsqrtf(wave_sum(s) * (1.f / DM) + EPS);
    v2u* o8 = (v2u*)orow + lane;
#pragma unroll
    for (int j = 0; j < 4; ++j) { const f32x4 gg = gr[64 * j]; v2u o; o.x = cvt_pk_bf16(v[j].x * rstd * gg.x, v[j].y * rstd * gg.y); o.y = cvt_pk_bf16(v[j].z * rstd * gg.z, v[j].w * rstd * gg.w); o8[64 * j] = o; }
}
__device__ __forceinline__ void rms_row_f32(const float* xrow, const float* gain, float* orow, int lane) {
    const f32x4* xr = (const f32x4*)xrow + lane; const f32x4* gr = (const f32x4*)gain + lane;
    f32x4 v[4]; float s = 0.f;
#pragma unroll
    for (int j = 0; j < 4; ++j) { v[j] = xr[64 * j]; s += (v[j].x * v[j].x + v[j].y * v[j].y) + (v[j].z * v[j].z + v[j].w * v[j].w); }
    const float rstd = rsqrtf(wave_sum(s) * (1.f / DM) + EPS);
    f32x4* o = (f32x4*)orow + lane;
#pragma unroll
    for (int j = 0; j < 4; ++j) { const f32x4 gg = gr[64 * j]; o[64 * j] = v[j] * rstd * gg; }
}

__device__ __forceinline__ void sg_phase(LAS unsigned char* lds, bf16* ZU, const bf16* ZV, const bf16* WSB, const float* bs_l, const float* sgn_l, int bid, int G, unsigned* done) {
    int tid_l = threadIdx.x; asm volatile("" : "+v"(tid_l));
    const int tid = tid_l, lane = tid & 63, w = __builtin_amdgcn_readfirstlane(tid >> 6), g = lane >> 4, r16 = lane & 15;
    LAS unsigned char* VGT = lds; LAS unsigned char* WSL = lds + 34816;
    const int s = tid >> 2, dq = tid & 3;
    v4u z[4], wv[4];
#define SG_LOAD(item) do { const int gq_ = (item) & 7, row0_ = ((item) >> 3) * 128; \
        _Pragma("unroll") for (int e = 0; e < 4; ++e) { z[e] = *(const v4u*)(ZV + (size_t)(row0_ + s) * 1024 + gq_ * 128 + dq * 32 + 8 * e); wv[e] = *(const v4u*)(WSB + (size_t)gq_ * 16384 + s * 128 + dq * 32 + 8 * e); } } while (0)
    const bool sib = (G == 256);
    const int sb_ = ((bid & 7) | ((bid >> 4) << 3)), sq_ = (sb_ & 1) * 2 + ((bid >> 3) & 1), sbase_ = (((sb_ >> 4) * 16 + 4 * sq_) << 3) | ((sb_ >> 1) & 7);
    const int nit = sib ? 4 : (1024 - bid + G - 1) / G;
#define SG_ITEM(j) (sib ? (sbase_ + ((j) << 3)) : (bid + (j) * G))
    if (nit > 0) SG_LOAD(SG_ITEM(0));
    for (int jj = 0; jj < nit; ++jj) { const int item = SG_ITEM(jj);
        const int gq = item & 7, bc = item >> 3, row0 = bc * 128, col0 = gq * 128;
        {
            float ss = 0.f;
#pragma unroll
            for (int e = 0; e < 4; ++e)
#pragma unroll
                for (int q = 0; q < 4; ++q) { const float a = bflo(z[e][q]), b = bfhi(z[e][q]); ss += a * a + b * b; }
            ss += __shfl_xor(ss, 1); ss += __shfl_xor(ss, 2);
            const float rstd = rsqrtf(ss * (1.f / 128.f) + EPS);
#pragma unroll
            for (int e = 0; e < 4; ++e) {
                const f32x4 n0 = *(const f32x4*)(sgn_l + col0 + dq * 32 + 8 * e), n1 = *(const f32x4*)(sgn_l + col0 + dq * 32 + 8 * e + 4);
#pragma unroll
                for (int q = 0; q < 4; ++q) { const int d = dq * 32 + 8 * e + 2 * q; const float na = q < 2 ? n0[2 * q] : n1[2 * q - 4], nb = q < 2 ? n0[2 * q + 1] : n1[2 * q - 3];
                    const unsigned pk = cvt_pk_bf16(bflo(z[e][q]) * rstd * na, bfhi(z[e][q]) * rstd * nb);
                    *(LAS unsigned short*)(VGT + d * 272 + (s ^ (16 * dq)) * 2) = (unsigned short)(pk & 0xffffu);
                    *(LAS unsigned short*)(VGT + (d + 1) * 272 + (s ^ (16 * dq)) * 2) = (unsigned short)(pk >> 16); }
                *(LAS v4u*)(WSL + s * 272 + (dq * 32 + 8 * e) * 2) = wv[e]; }
        }
        __syncthreads();
        if (jj + 1 < nit) SG_LOAD(SG_ITEM(jj + 1));
        {
            bf16x8 bw[4];
#pragma unroll
            for (int ks = 0; ks < 4; ++ks) bw[ks] = *(const LAS bf16x8*)(WSL + (16 * w + r16) * 272 + (32 * ks + 8 * g) * 2);
            const int row = row0 + 16 * w + r16; const float bias = bs_l[gq * 128 + 16 * w + r16];
            v2u zu[8];
#pragma unroll
            for (int dt = 0; dt < 8; ++dt) zu[dt] = *(const v2u*)(ZU + (size_t)row * 1024 + col0 + 16 * dt + 4 * g);
#pragma unroll
            for (int dt = 0; dt < 8; ++dt) { f32x4 acc = (f32x4){0.f, 0.f, 0.f, 0.f};
#pragma unroll
                for (int ks = 0; ks < 4; ++ks) { const bf16x8 a = *(const LAS bf16x8*)(VGT + (16 * dt + r16) * 272 + ((32 * ks + 8 * g) ^ (16 * (dt >> 1))) * 2); acc = __builtin_amdgcn_mfma_f32_16x16x32_bf16(a, bw[ks], acc, 0, 0, 0); }
                v2u o; o.x = cvt_pk_bf16(bflo(zu[dt].x) * (acc[0] + bias), bfhi(zu[dt].x) * (acc[1] + bias)); o.y = cvt_pk_bf16(bflo(zu[dt].y) * (acc[2] + bias), bfhi(zu[dt].y) * (acc[3] + bias));
                *(v2u*)(ZU + (size_t)row * 1024 + col0 + 16 * dt + 4 * g) = o; }
        }
        __syncthreads();
        if (tid == 0) __hip_atomic_fetch_add(done + (bc >> 4) * 8 + gq, 1u, __ATOMIC_RELAXED, __HIP_MEMORY_SCOPE_AGENT);
    }
#undef SG_LOAD
#undef SG_ITEM
}

constexpr int HG_QH = 0, HG_KH = 17408, HG_KT = 34816, HG_VT = 53248, HG_EBM = 62464, HG_EBL = 62976, HG_IMG = 63488;
__device__ __forceinline__ bf16x8 hg_ld2(const LAS unsigned char* p) {
    const v2u lo = *(const LAS v2u*)p, hi = *(const LAS v2u*)(p + 32); return __builtin_bit_cast(bf16x8, (v4u){lo.x, lo.y, hi.x, hi.y});
}
__device__ __forceinline__ bf16x8 hg_ld2s(const LAS unsigned char* row, int e0) {
    const v2u lo = *(const LAS v2u*)(row + 2 * e0), hi = *(const LAS v2u*)(row + 2 * (e0 ^ 16)); return __builtin_bit_cast(bf16x8, (v4u){lo.x, lo.y, hi.x, hi.y});
}
__device__ __forceinline__ void hg_phase(LAS unsigned char* lds, const bf16* Qb, const bf16* LFfw, const bf16* LFbw, const bf16* IVb, bf16* Ofw, bf16* Obw, int bid, int G, const unsigned* done) {
    int tid_l = threadIdx.x; asm volatile("" : "+v"(tid_l));
    const int tid = tid_l, lane = tid & 63, w = __builtin_amdgcn_readfirstlane(tid >> 6), g = lane >> 4, r16 = lane & 15;
    const int vsp = tid & 31, vq = tid >> 5;
    const int kp = lane & 7, tg = lane >> 3, ek = 16 * w + 2 * kp, et0 = 8 * tg, ekz = ek ^ (16 * (tg >> 1));
    for (int item = bid; item < 256; item += G) {
        const int vh = (item >> 3) & 1, chain = (item & 7) | ((item >> 4) << 3), dir = chain & 1, h = (chain >> 1) & 7, b = chain >> 4;
        const bf16* LF = dir ? LFbw : LFfw; bf16* O = dir ? Obw : Ofw;
        const size_t colq = (size_t)h * 128 + ek, colv = (size_t)h * 128 + vh * 64;
#define HG_ROW(c, tau) ((size_t)(b * SEQ + (dir ? (SEQ - 1 - (64 * (c) + (tau))) : (64 * (c) + (tau)))))
        f32x4 S[8];
#pragma unroll
        for (int kt = 0; kt < 8; ++kt) S[kt] = (f32x4){0.f, 0.f, 0.f, 0.f};
        unsigned lfr[8], qr[8]; v2u vr0, vr1;
#define HG_LOAD(c) do { _Pragma("unroll") for (int j = 0; j < 8; ++j) { const size_t ro = HG_ROW(c, et0 + j) * 1024 + colq; lfr[j] = *(const unsigned*)(LF + ro); qr[j] = *(const unsigned*)(Qb + ro); } \
        vr0 = *(const v2u*)(IVb + HG_ROW(c, 2 * vsp) * 1024 + colv + 4 * vq); vr1 = *(const v2u*)(IVb + HG_ROW(c, 2 * vsp + 1) * 1024 + colv + 4 * vq); } while (0)
#define HG_EW(img) do { LAS unsigned char* I_ = lds + (img) * HG_IMG; float f0_[8], f1_[8]; float a0_ = 0.f, a1_ = 0.f; \
        _Pragma("unroll") for (int j = 0; j < 8; ++j) { const float l0_ = bflo(lfr[j]), l1_ = bfhi(lfr[j]); a0_ += l0_; a1_ += l1_; f0_[j] = __builtin_amdgcn_exp2f(l0_); f1_[j] = __builtin_amdgcn_exp2f(l1_); } \
        float i0_ = a0_, i1_ = a1_; { float u0_ = __shfl_up(i0_, 8), u1_ = __shfl_up(i1_, 8); if (tg >= 1) { i0_ += u0_; i1_ += u1_; } \
            u0_ = __shfl_up(i0_, 16); u1_ = __shfl_up(i1_, 16); if (tg >= 2) { i0_ += u0_; i1_ += u1_; } u0_ = __shfl_up(i0_, 32); u1_ = __shfl_up(i1_, 32); if (tg >= 4) { i0_ += u0_; i1_ += u1_; } } \
        const float bm0_ = __shfl(i0_, kp + 24), bm1_ = __shfl(i1_, kp + 24), bl0_ = __shfl(i0_, kp + 56), bl1_ = __shfl(i1_, kp + 56); \
        const float off0_ = i0_ - a0_ - bm0_, off1_ = i1_ - a1_ - bm1_; \
        float ek0_ = __builtin_amdgcn_exp2f(fminf(-(off0_ + a0_), 115.f)), ek1_ = __builtin_amdgcn_exp2f(fminf(-(off1_ + a1_), 115.f)); \
        unsigned kw_[8]; \
        _Pragma("unroll") for (int j = 7; j >= 0; --j) { const float k0_ = (1.f - f0_[j]) * ek0_, k1_ = (1.f - f1_[j]) * ek1_; ek0_ *= f0_[j]; ek1_ *= f1_[j]; kw_[j] = cvt_pk_bf16(k0_, k1_); } \
        float eq0_ = __builtin_amdgcn_exp2f(fminf(off0_ + bflo(lfr[0]), 115.f)), eq1_ = __builtin_amdgcn_exp2f(fminf(off1_ + bfhi(lfr[0]), 115.f)); \
        _Pragma("unroll") for (int j = 0; j < 8; ++j) { if (j > 0) { eq0_ *= f0_[j]; eq1_ *= f1_[j]; } \
            *(LAS unsigned*)(I_ + HG_QH + (et0 + j) * 272 + 2 * ekz) = cvt_pk_bf16(bflo(qr[j]) * eq0_, bfhi(qr[j]) * eq1_); \
            *(LAS unsigned*)(I_ + HG_KH + (et0 + j) * 272 + 2 * ekz) = kw_[j]; } \
        *(LAS v4u*)(I_ + HG_KT + ek * 144 + 2 * et0) = (v4u){(kw_[0] & 0xffffu) | (kw_[1] << 16), (kw_[2] & 0xffffu) | (kw_[3] << 16), (kw_[4] & 0xffffu) | (kw_[5] << 16), (kw_[6] & 0xffffu) | (kw_[7] << 16)}; \
        *(LAS v4u*)(I_ + HG_KT + (ek + 1) * 144 + 2 * et0) = (v4u){(kw_[0] >> 16) | (kw_[1] & 0xffff0000u), (kw_[2] >> 16) | (kw_[3] & 0xffff0000u), (kw_[4] >> 16) | (kw_[5] & 0xffff0000u), (kw_[6] >> 16) | (kw_[7] & 0xffff0000u)}; \
        if (tg == 0) { *(LAS f32x2*)(I_ + HG_EBM + 4 * ek) = (f32x2){__builtin_amdgcn_exp2f(bm0_), __builtin_amdgcn_exp2f(bm1_)}; *(LAS f32x2*)(I_ + HG_EBL + 4 * ek) = (f32x2){__builtin_amdgcn_exp2f(bl0_ - bm0_), __builtin_amdgcn_exp2f(bl1_ - bm1_)}; } \
          \
        *(LAS unsigned*)(I_ + HG_VT + (4 * vq + 0) * 144 + 4 * vsp) = (vr0.x & 0xffffu) | (vr1.x << 16); \
        *(LAS unsigned*)(I_ + HG_VT + (4 * vq + 1) * 144 + 4 * vsp) = (vr0.x >> 16) | (vr1.x & 0xffff0000u); \
        *(LAS unsigned*)(I_ + HG_VT + (4 * vq + 2) * 144 + 4 * vsp) = (vr0.y & 0xffffu) | (vr1.y << 16); \
        *(LAS unsigned*)(I_ + HG_VT + (4 * vq + 3) * 144 + 4 * vsp) = (vr0.y >> 16) | (vr1.y & 0xffff0000u); } while (0)
        HG_LOAD(0);
        HG_EW(0);
        HG_LOAD(1);
        __syncthreads();
        const int vt = w & 3, th = w >> 2;
        for (int c = 0; c < 32; ++c) {
            if (c + 1 < 32) { HG_EW((c + 1) & 1); if (c + 2 < 32) HG_LOAD(c + 2); }
            if (c == 0 && dir == 0) {
                if (tid == 0) { unsigned sp = 0; while (__hip_atomic_load(done + b * 8 + h, __ATOMIC_RELAXED, __HIP_MEMORY_SCOPE_AGENT) < 16u) { __builtin_amdgcn_s_sleep(1); if (++sp > (1u << 24)) break; } }
                __syncthreads(); }
            {
                const LAS unsigned char* I = lds + (c & 1) * HG_IMG;
                const LAS unsigned char* QH = I + HG_QH; const LAS unsigned char* KH = I + HG_KH; const LAS unsigned char* KT = I + HG_KT; const LAS unsigned char* VT = I + HG_VT;
                const LAS float* EBM = (const LAS float*)(I + HG_EBM); const LAS float* EBL = (const LAS float*)(I + HG_EBL);
#define HG_FENCE __builtin_amdgcn_sched_barrier(0)
                bf16x8 As[4], avp[2], avn[2];
                { f32x4 em[8];
#pragma unroll
                  for (int kt = 0; kt < 8; ++kt) em[kt] = *(const LAS f32x4*)(EBM + 16 * kt + 4 * g);
#pragma unroll
                  for (int ks = 0; ks < 2; ++ks) { avp[ks] = hg_ld2(VT + (16 * vt + r16) * 144 + (32 * ks + 4 * g) * 2); avn[ks] = *(const LAS bf16x8*)(VT + (16 * vt + r16) * 144 + (32 * ks + 8 * g) * 2); }
                  HG_FENCE;
#pragma unroll
                  for (int kt = 0; kt < 8; ++kt) S[kt] = S[kt] * em[kt]; }
#pragma unroll
                for (int ks = 0; ks < 4; ++ks) { const unsigned x0 = cvt_pk_bf16(S[2 * ks][0], S[2 * ks][1]), x1 = cvt_pk_bf16(S[2 * ks][2], S[2 * ks][3]), x2 = cvt_pk_bf16(S[2 * ks + 1][0], S[2 * ks + 1][1]), x3 = cvt_pk_bf16(S[2 * ks + 1][2], S[2 * ks + 1][3]);
                    As[ks] = __builtin_bit_cast(bf16x8, (v4u){x0, x1, x2, x3}); }
#pragma unroll
                for (int ttl = 0; ttl < 2; ++ttl) { const int tt = th ? (1 + ttl) : (3 * ttl), trow = 16 * tt + r16; const LAS unsigned char* qrow = QH + trow * 272;
                    bf16x8 bq[4], bqp[4];
#pragma unroll
                    for (int ks = 0; ks < 4; ++ks) { bqp[ks] = hg_ld2s(qrow, (32 * ks + 4 * g) ^ (16 * tt)); bq[ks] = *(const LAS bf16x8*)(qrow + 2 * ((32 * ks + 8 * g) ^ (16 * tt))); }
                    HG_FENCE;
                    f32x4 oacc = (f32x4){0.f, 0.f, 0.f, 0.f};
#pragma unroll
                    for (int ks = 0; ks < 4; ++ks) oacc = __builtin_amdgcn_mfma_f32_16x16x32_bf16(As[ks], bqp[ks], oacc, 0, 0, 0);
#pragma unroll
                    for (int kp2 = 0; kp2 < 2; ++kp2) if (kp2 <= (tt >> 1)) {
                        const int st0 = 2 * kp2, st1 = 2 * kp2 + 1; const bool two = (st1 <= tt);
                        bf16x8 ka[4], kb[4];
#pragma unroll
                        for (int ks = 0; ks < 4; ++ks) { ka[ks] = *(const LAS bf16x8*)(KH + (16 * st0 + r16) * 272 + 2 * ((32 * ks + 8 * g) ^ (16 * st0)));
                            if (two) kb[ks] = *(const LAS bf16x8*)(KH + (16 * st1 + r16) * 272 + 2 * ((32 * ks + 8 * g) ^ (16 * st1))); }
                        HG_FENCE;
                        f32x4 p0 = (f32x4){0.f, 0.f, 0.f, 0.f}, p1 = (f32x4){0.f, 0.f, 0.f, 0.f};
#pragma unroll
                        for (int ks = 0; ks < 4; ++ks) { p0 = __builtin_amdgcn_mfma_f32_16x16x32_bf16(ka[ks], bq[ks], p0, 0, 0, 0); if (two) p1 = __builtin_amdgcn_mfma_f32_16x16x32_bf16(kb[ks], bq[ks], p1, 0, 0, 0); }
                        if (st0 == tt) {
#pragma unroll
                            for (int i = 0; i < 4; ++i) if (4 * g + i > r16) p0[i] = 0.f; }
                        if (two && st1 == tt) {
#pragma unroll
                            for (int i = 0; i < 4; ++i) if (4 * g + i > r16) p1[i] = 0.f; }
                        unsigned pw2 = 0u, pw3 = 0u; if (two) { pw2 = cvt_pk_bf16(p1[0], p1[1]); pw3 = cvt_pk_bf16(p1[2], p1[3]); }
                        oacc = __builtin_amdgcn_mfma_f32_16x16x32_bf16(avp[kp2], __builtin_bit_cast(bf16x8, (v4u){cvt_pk_bf16(p0[0], p0[1]), cvt_pk_bf16(p0[2], p0[3]), pw2, pw3}), oacc, 0, 0, 0);
                    }
                    *(v2u*)(O + HG_ROW(c, trow) * 1024 + colv + vt * 16 + 4 * g) = (v2u){cvt_pk_bf16(oacc[0], oacc[1]), cvt_pk_bf16(oacc[2], oacc[3])};
                }
#pragma unroll
                for (int hf = 0; hf < 2; ++hf) {
                    bf16x8 kc[8]; f32x4 el[4];
#pragma unroll
                    for (int q = 0; q < 4; ++q) { const int kt = 4 * hf + q; el[q] = *(const LAS f32x4*)(EBL + 16 * kt + 4 * g);
#pragma unroll
                        for (int ks = 0; ks < 2; ++ks) kc[2 * q + ks] = *(const LAS bf16x8*)(KT + (16 * kt + r16) * 144 + (32 * ks + 8 * g) * 2); }
                    HG_FENCE;
#pragma unroll
                    for (int ks = 0; ks < 2; ++ks)
#pragma unroll
                        for (int q = 0; q < 4; ++q) S[4 * hf + q] = __builtin_amdgcn_mfma_f32_16x16x32_bf16(kc[2 * q + ks], avn[ks], S[4 * hf + q], 0, 0, 0);
#pragma unroll
                    for (int q = 0; q < 4; ++q) S[4 * hf + q] = S[4 * hf + q] * el[q];
                    HG_FENCE; }
#undef HG_FENCE
            }
            __syncthreads();
        }
#undef HG_ROW
#undef HG_LOAD
#undef HG_EW
    }
}

__device__ __forceinline__ void cb_row(bf16* Ofw, const bf16* Obw, const bf16* OG, const float* gain, size_t row, int lane) {
    const size_t o = row * 1024 + 16 * lane;
    v4u a[2], b[2], gq[2]; float s[16]; float ss = 0.f;
#pragma unroll
    for (int e = 0; e < 2; ++e) { a[e] = *(const v4u*)(Ofw + o + 8 * e); b[e] = *(const v4u*)(Obw + o + 8 * e); gq[e] = *(const v4u*)(OG + o + 8 * e); }
#pragma unroll
    for (int e = 0; e < 2; ++e)
#pragma unroll
        for (int q = 0; q < 4; ++q) { const float x = bflo(a[e][q]) + bflo(b[e][q]), y = bfhi(a[e][q]) + bfhi(b[e][q]); s[8 * e + 2 * q] = x; s[8 * e + 2 * q + 1] = y; ss += x * x + y * y; }
    ss += __shfl_xor(ss, 1); ss += __shfl_xor(ss, 2); ss += __shfl_xor(ss, 4);
    const float rstd = rsqrtf(ss * (1.f / 128.f) + EPS);
#pragma unroll
    for (int e = 0; e < 2; ++e) { v4u ov;
#pragma unroll
        for (int q = 0; q < 4; ++q) { const f32x2 gn = *(const f32x2*)(gain + 16 * lane + 8 * e + 2 * q);
            ov[q] = cvt_pk_bf16(s[8 * e + 2 * q] * rstd * gn.x * bflo(gq[e][q]), s[8 * e + 2 * q + 1] * rstd * gn.y * bfhi(gq[e][q])); }
        *(v4u*)(Ofw + o + 8 * e) = ov; }
}

#define XB_TMO      128
#define XB_XCNT(j)  (256  + 64 * (j))
#define XB_XSUB(j)  (1280 + 64 * (j))
#define XB_XGEN(j)  (2304 + 64 * (j))
#define XB_TOP      3328
#define XB_TOPGEN   3392
#define XCD_BAR_WORDS 3456
#define XB_SPIN_CAP (1u << 18)

__device__ __forceinline__ unsigned xb_ld(unsigned* p)              { return __hip_atomic_load(p, __ATOMIC_RELAXED, __HIP_MEMORY_SCOPE_AGENT); }
__device__ __forceinline__ unsigned xb_add(unsigned* p, unsigned v) { return __hip_atomic_fetch_add(p, v, __ATOMIC_RELAXED, __HIP_MEMORY_SCOPE_AGENT); }
__device__ __forceinline__ unsigned xb_xcc_id() { return (unsigned)__builtin_amdgcn_s_getreg((3 << 11) | 20) & 0xFu; }
#define XB_SPIN(cond, bar) do { unsigned _sp = 0; while (cond) { __builtin_amdgcn_s_sleep(1); \
    if ((++_sp & 255u) == 0u) { if (xb_ld(&(bar)[XB_TMO])) break; if (_sp > XB_SPIN_CAP) { atomicAdd(&(bar)[XB_TMO], 1u); break; } } } } while (0)

struct XcdBarrier {
    unsigned* bar; unsigned x;
    volatile LAS unsigned* st;
};

__device__ __forceinline__ XcdBarrier xcd_barrier_post(unsigned* bar, volatile LAS unsigned* st) {
    XcdBarrier b; b.bar = bar; b.x = xb_xcc_id(); b.st = st;
    if (threadIdx.x == 0) (void)xb_add(&bar[XB_XCNT(b.x)], 1u);
    return b;
}
__device__ __forceinline__ void xcd_barrier_complete(unsigned* bar, unsigned x, unsigned& nloc, unsigned& nx) {
    const unsigned G = gridDim.x * gridDim.y * gridDim.z;
    unsigned sum, cnt, mine, sp = 0u;
    for (;;) {
        sum = 0u; cnt = 0u; mine = 0u;
#pragma unroll
        for (unsigned j = 0; j < 16; ++j) { const unsigned c = xb_ld(&bar[XB_XCNT(j)]); sum += c; cnt += (c > 0u) ? 1u : 0u; mine = (j == x) ? c : mine; }
        if (sum == G) break;
        __builtin_amdgcn_s_sleep(1);
        if ((++sp & 255u) == 0u) { if (xb_ld(&bar[XB_TMO])) break; if (sp > XB_SPIN_CAP) { atomicAdd(&bar[XB_TMO], 1u); break; } }
    }
    nloc = mine > 0u ? mine : 1u; nx = cnt > 0u ? cnt : 1u;
}

__device__ __forceinline__ void xcd_barrier(const XcdBarrier& b) {
    asm volatile("s_waitcnt vmcnt(0)" ::: "memory");
    __syncthreads();
    if (threadIdx.x == 0) {
        unsigned* bar = b.bar;
        __builtin_amdgcn_s_waitcnt(0);
        unsigned nloc = b.st[0], nx = b.st[1];
        if (nloc == 0u) { xcd_barrier_complete(bar, b.x, nloc, nx); b.st[0] = nloc; b.st[1] = nx; }
        const unsigned old = xb_add(&bar[XB_XSUB(b.x)], 1u);
        const unsigned gen = old / nloc;
        if (old + 1u == (gen + 1u) * nloc) {
            __builtin_amdgcn_fence(__ATOMIC_RELEASE, "agent");
            asm volatile("s_waitcnt vmcnt(0)" ::: "memory");
            const unsigned og = xb_add(&bar[XB_TOP], 1u);
            const unsigned tg = og / nx;
            if (og + 1u == (tg + 1u) * nx) xb_add(&bar[XB_TOPGEN], 1u);
            else XB_SPIN(xb_ld(&bar[XB_TOPGEN]) == tg, bar);
            __builtin_amdgcn_fence(__ATOMIC_ACQUIRE, "agent");
            xb_add(&bar[XB_XGEN(b.x)], 1u);
            asm volatile("s_waitcnt vmcnt(0)" ::: "memory");
        } else {
            XB_SPIN(xb_ld(&bar[XB_XGEN(b.x)]) == gen, bar);
            __builtin_amdgcn_fence(__ATOMIC_ACQUIRE, "agent");
            asm volatile("s_waitcnt vmcnt(0)" ::: "memory");
        }
    }
    __syncthreads();
}

struct Args { const float* in[15]; float* out; unsigned char* ws; int ph_lo, ph_hi; };

__global__ void __launch_bounds__(NTHR, 2) fwd(Args a) {
    extern __shared__ __attribute__((aligned(16))) unsigned char lds_raw[];
    LAS unsigned char* lds = (LAS unsigned char*)lds_raw;
    const int G = gridDim.x, bid = blockIdx.x, NGW = G * NWAVES;
    volatile LAS unsigned* MISC = (volatile LAS unsigned*)(lds + LDS_RING);
    if (threadIdx.x < 16) MISC[threadIdx.x] = 0u;
    __syncthreads();
    XcdBarrier xbar; xbar.bar = (unsigned*)a.ws; xbar.x = 0; xbar.st = nullptr;
    if (a.ph_hi - a.ph_lo > 1) xbar = xcd_barrier_post((unsigned*)a.ws, MISC);
    const float* x = a.in[0]; const float* w_in = a.in[1]; const float* ln_mix = a.in[2]; const float* ln_mlp = a.in[3]; const float* sg_norm = a.in[4];
    const float* w_s = a.in[5]; const float* b_s = a.in[6]; const float* lb_logits = a.in[7]; const float* rec_norm = a.in[8];
    const float* w_pa = a.in[9]; const float* w_pb = a.in[10]; const float* w_out = a.in[11]; const float* w_up = a.in[12]; const float* w_down = a.in[13]; const float* ln_final = a.in[14];
#define BUF(i) ((bf16*)(ws + WS_BUF(i)))
#define CONVERT_LAYER(LL) do { {    LAS float* scr = (LAS float*)(lds + wave * 16384); constexpr int I_IN = (DM / 64) * (NIN / 32), I_SQ = (DM / 64) * (DM / 32); for (int it = gw; it < I_IN + 3 * I_SQ; it += NGW) { if (it < I_IN) transpose_item(w_in + (size_t)(LL) * DM * NIN, DM, NIN, WIN, scr, it, lane); else { const int r = it - I_IN, which = r / I_SQ, ii = r % I_SQ; const float* src = (which == 0 ? w_pa : which == 1 ? w_pb : w_out) + (size_t)(LL) * DM * DM; bf16* dst = which == 0 ? WPA : which == 1 ? WPB : WOUT; transpose_item(src, DM, DM, dst, scr, ii, lane); } } } { const float* wsrc = w_s + (size_t)(LL) * 8 * 16384; unsigned* wdst = (unsigned*)(ws + WS_WSB); for (int i = bid * NTHR + tid; i < 8 * 16384 / 2; i += G * NTHR) { const f32x2 v = *(const f32x2*)(wsrc + 2 * i); wdst[i] = cvt_pk_bf16(v.x, v.y); } } } while (0)
    for (int p = a.ph_lo; p < a.ph_hi; ++p) {
        if (p != NPH - 1 && (p % PH_PER_LAYER) == 3) continue;
        if (p > a.ph_lo) { asm volatile("s_waitcnt vmcnt(0)" ::: "memory");
#ifdef PROBE_SYNC
            const unsigned long long ts0 = __builtin_amdgcn_s_memrealtime();
#endif
            if (a.ph_lo < 0) cg::this_grid().sync();
            xcd_barrier(xbar);
#ifdef PROBE_SYNC
            { const unsigned long long ts1 = __builtin_amdgcn_s_memrealtime(); if (blockIdx.x == PROBE_SYNC_BLK && threadIdx.x == 0) { float* pp = (float*)(a.ws + 32768); const float prev = (p == a.ph_lo + 1) ? 0.f : *(volatile float*)pp; *pp = prev + (float)(ts1 - ts0) * (1.0f / PROBE_DIV); } }
#endif
            }
        int tid = threadIdx.x; asm volatile("" : "+v"(tid));
        const int lane = tid & 63, wave = __builtin_amdgcn_readfirstlane(tid >> 6), gw = bid * NWAVES + wave;
        unsigned char* ws = a.ws; asm volatile("" : "+s"(ws));
        float* out = a.out; asm volatile("" : "+s"(out));
        float* LB = (float*)(ws + WS_LB); unsigned long long* RSQ = (unsigned long long*)(ws + WS_RSQ);
        bf16* WIN = (bf16*)(ws + WS_WIN); bf16* WPA = (bf16*)(ws + WS_WPA); bf16* WPB = (bf16*)(ws + WS_WPB); bf16* WOUT = (bf16*)(ws + WS_WOUT);
        bf16* WUP = (bf16*)(ws + WS_WUP); bf16* WDN = (bf16*)(ws + WS_WDN);
#ifdef DBG_NRUN
        if (p == DBG_NRUN) {
            for (size_t i = (size_t)bid * NTHR + tid; i < (size_t)M * DM; i += (size_t)G * NTHR) { float s = (DBG_NRUN >= 8) ? out[i] : 0.f;
                for (int k = 0; k < 8; ++k) s += bflo((unsigned)((const bf16*)(ws + WS_BUF(k)))[i]); out[i] = s; }
            continue;
        }
        if (p > DBG_NRUN) continue;
#endif
        if (p == NPH - 1) {
            for (int m = gw; m < M; m += NGW) {
                const float rs = rsqrtf((float)RSQ[3 * (size_t)M + m] * (1.0f / 16777216.0f / 1024.0f) + EPS);
                const v4u* xr = (const v4u*)(BUF(0) + (size_t)m * DM) + lane; f32x4* o = (f32x4*)(out + (size_t)m * DM) + 2 * lane;
#pragma unroll
                for (int j = 0; j < 2; ++j) { const v4u xv = xr[64 * j];
                    o[128 * j] = (f32x4){bflo(xv.x) * rs, bfhi(xv.x) * rs, bflo(xv.y) * rs, bfhi(xv.y) * rs}; o[128 * j + 1] = (f32x4){bflo(xv.z) * rs, bfhi(xv.z) * rs, bflo(xv.w) * rs, bfhi(xv.w) * rs}; }
            }
            continue;
        }
        const int l = p / PH_PER_LAYER, j = p % PH_PER_LAYER;
#ifdef PROBE_PH
        unsigned long long t0p = 0; if ((PROBE_PH >> j) & 1) t0p = __builtin_amdgcn_s_memrealtime();
#endif
        const float* hin = (l == 0) ? x : out;
#ifndef PHASE_MASK
#define PHASE_MASK 0x7ff
#endif
        if (!((PHASE_MASK >> j) & 1)) continue;
        switch (j) {
        case 0: {
#ifdef DBG_FILL
            if (l == 0) { v4u* fp = (v4u*)(ws + WS_BUF(1)); const size_t n16 = (size_t)7 * BUFB / 16; for (size_t i = (size_t)bid * NTHR + tid; i < n16; i += (size_t)G * NTHR) fp[i] = (v4u){DBG_FILL, DBG_FILL, DBG_FILL, DBG_FILL}; }
#endif
            CONVERT_LAYER(l);
            for (int i = bid * NTHR + tid; i < 2 * DM; i += G * NTHR) { LB[i] = 0.f; LB[2 * DM + i] = 1.f / (1.f + __expf(lb_logits[i] - lb_logits[2 * DM + i])); }
            if (l == 0) {
                for (int i = bid * NTHR + tid; i < 4 * M; i += G * NTHR) RSQ[i] = 0ull;
                for (int m = gw; m < M; m += NGW) rms_row_bf16(hin + (size_t)m * DM, ln_mix + l * DM, BUF(0) + (size_t)m * DM, lane);
            }
            __syncthreads();
        } break;
        case 1: {
#define PROJ(MA, MB, split, sec0, bufi, lbp) { pg8::Gemm g{BUF(0), WIN + (size_t)(sec0) * DM * DM, M, 3 * DM, DM}; pg8::StaticOrder S; S.init(M, 3 * DM, G, bid); \
            pg8::EpiProj<MA, MB> E{BUF(bufi), (size_t)M * DM, lbp, (l == 0) ? (const unsigned long long*)nullptr : (const unsigned long long*)(RSQ + M), split}; pg8::gemm_phase<pg8::EpiProj<MA, MB>, pg8::StaticOrder, PROJ_ALIGN, true>(lds, g, S, E); }
            PROJ(0, 1, 2, 0, 1, LB) PROJ(2, 3, 2, 3, 4, LB + (size_t)l * 2 * DM)
        } break;
        case 2: {
            unsigned* done = (unsigned*)(ws + 14336) + l * 64;
            sg_phase(lds, BUF(1), BUF(2), (const bf16*)(ws + WS_WSB), b_s + (size_t)l * 1024, sg_norm + (size_t)l * DM, bid, G, done);
            hg_phase(lds, BUF(3), BUF(4), BUF(5), BUF(6), BUF(2), BUF(7), bid, G, done);
        } break;
        case 3: break;
        case 4: {
            PROJ(3, 4, 1, 6, 3, LB)
        } break;
        case 5: {
            convert_weight(w_up + (size_t)l * DM * DFF, DM, DFF, WUP, lds, gw, NGW, wave, lane);
            convert_weight(w_down + (size_t)l * DFF * DM, DFF, DM, WDN, lds, gw, NGW, wave, lane);
            for (int m = gw; m < M; m += NGW) cb_row(BUF(2), BUF(7), BUF(3), rec_norm + (size_t)l * DM, (size_t)m, lane);
            __syncthreads();
        } break;
        case 6: {
            pg8::Gemm g{BUF(1), WPA, 2 * M, 2 * DM, DM}; pg8::PairOrder S; S.init(M, DM, G, bid); pg8::EpiGate E{BUF(4), BUF(5)};
            pg8::gemm_phase<pg8::EpiGate, pg8::PairOrder, true, true>(lds, g, S, E);
        } break;
        case 7: {
            pg8::Gemm g{BUF(4), WOUT, M, DM, DM}; pg8::StaticOrder S; S.init(M, DM, G, bid);
            if (l == 0) { pg8::EpiResid<true> E{x, (const bf16*)nullptr, ln_mix, (float*)nullptr, BUF(0), ln_mlp, RSQ};
                pg8::gemm_phase<pg8::EpiResid<true>, pg8::StaticOrder, true, true>(lds, g, S, E); }
            else { pg8::EpiResid<false> E{(const float*)nullptr, BUF(0), ln_mix + DM, (float*)nullptr, BUF(0), ln_mlp + DM, RSQ + 2 * (size_t)M};
                pg8::gemm_phase<pg8::EpiResid<false>, pg8::StaticOrder, true, true>(lds, g, S, E); }
        } break;
        case 8: {
            pg8::Gemm g{BUF(0), WUP, M, DFF, DM}; pg8::StaticOrder S; S.init(M, DFF, G, bid); pg8::EpiRelu2 E{BUF(1), DFF, RSQ + (size_t)(l == 0 ? 0 : 2) * M};
            pg8::gemm_phase<pg8::EpiRelu2, pg8::StaticOrder, true, true>(lds, g, S, E);
        } break;
        case 9: {
            pg8::Gemm g{BUF(1), WDN, M, DM, DFF}; pg8::StaticOrder S; S.init(M, DM, G, bid);
            pg8::EpiResid<false> E{(const float*)nullptr, BUF(0), ln_mlp + l * DM, (float*)nullptr, BUF(0), (l == 0) ? ln_mix + DM : ln_final, RSQ + (size_t)(l == 0 ? 1 : 3) * M};
            pg8::gemm_phase<pg8::EpiResid<false>, pg8::StaticOrder, true, true>(lds, g, S, E);
        } break;
        }
#ifdef PROBE_PH
        if ((PROBE_PH >> j) & 1) { asm volatile("s_waitcnt vmcnt(0)" ::: "memory"); __syncthreads(); const unsigned long long t1p = __builtin_amdgcn_s_memrealtime();
#ifdef PROBE_MAX
            if (tid == 0) atomicMax((unsigned*)(ws + 32768) + 1 + p, (unsigned)(t1p - t0p));
#else
            if (bid == 0 && tid == 0) atomicAdd((unsigned*)(ws + 32768) + 1 + p, (unsigned)(t1p - t0p));
#endif
        }
#endif
    }
#if defined(PROBE_PH)
    if (bid == 0 && threadIdx.x == 0) { asm volatile("s_waitcnt vmcnt(0)" ::: "memory"); unsigned s = 0; for (int q = 0; q < NPH; ++q) s += __hip_atomic_load((unsigned*)(a.ws + 32768) + 1 + q, __ATOMIC_RELAXED, __HIP_MEMORY_SCOPE_AGENT); a.out[0] = (float)s * (1.0f / PROBE_DIV); }
#elif defined(PROBE_SYNC)
    if (bid == 0 && threadIdx.x == 0) { asm volatile("s_waitcnt vmcnt(0)" ::: "memory"); a.out[0] = *(volatile float*)(a.ws + 32768); }
#endif
#undef BUF
}

extern "C" void kernel_launch(void* const* d_in, const int* in_sizes, int n_in, void* d_out, int out_size, void* d_ws, size_t ws_size, hipStream_t stream) {
    static int grid = 0;
    if (grid == 0) {
        if (n_in != 15 || out_size != M * DM || ws_size < WS_END) { fprintf(stderr, "kernel_launch: unexpected problem (n_in %d, out %d, ws %zu < %zu)\n", n_in, out_size, ws_size, (size_t)WS_END); grid = -1; return; }
        int dev = 0, cus = 0, per_cu = 0;
        hipGetDevice(&dev); hipDeviceGetAttribute(&cus, hipDeviceAttributeMultiprocessorCount, dev);
        if (hipFuncSetAttribute((const void*)fwd, hipFuncAttributeMaxDynamicSharedMemorySize, LDS_BYTES) != hipSuccess) { fprintf(stderr, "kernel_launch: hipFuncSetAttribute failed\n"); grid = -1; return; }
        if (hipOccupancyMaxActiveBlocksPerMultiprocessor(&per_cu, (const void*)fwd, NTHR, LDS_BYTES) != hipSuccess || per_cu < 1) { fprintf(stderr, "kernel_launch: occupancy query says %d\n", per_cu); per_cu = 1; }
        (void)hipGetLastError();
        grid = cus;
    }
    if (grid < 0) return;
#if defined(PROBE_PH)
    (void)hipMemsetAsync((char*)d_ws + 32768, 0, 512, stream);
#endif
    (void)hipMemsetAsync(d_ws, 0, 16384, stream);
    Args a{};
    for (int i = 0; i < 15; ++i) a.in[i] = (const float*)d_in[i];
    a.out = (float*)d_out; a.ws = (unsigned char*)d_ws;
#if ONE_LAUNCH
    a.ph_lo = 0; a.ph_hi = NPH;
    void* args[] = {&a};
    hipError_t e = hipLaunchCooperativeKernel((const void*)fwd, dim3(grid), dim3(NTHR), args, LDS_BYTES, stream);
    if (e != hipSuccess) fprintf(stderr, "cooperative launch failed: %s (grid %d)\n", hipGetErrorString(e), grid);
#else
    for (int p = 0; p < NPH; ++p) { a.ph_lo = p; a.ph_hi = p + 1; hipLaunchKernelGGL(fwd, dim3(grid), dim3(NTHR), LDS_BYTES, stream, a); }
#endif
}
```

```cpp
#define ONE_LAUNCH 1
#include <hip/hip_runtime.h>
#include <hip/hip_cooperative_groups.h>
#include <cstdio>
#include <cstdint>
namespace cg = cooperative_groups;
namespace pg8 {
#define PG8_LAS __attribute__((address_space(3)))
typedef unsigned short bf16_t;
typedef short bf16x8 __attribute__((ext_vector_type(8)));
typedef float f32x4 __attribute__((ext_vector_type(4)));
typedef unsigned u32x4 __attribute__((ext_vector_type(4)));
constexpr int BM = 256, BK = 64, HALF = 128, HTB = HALF * BK * 2  , STAGE_BYTES = 8 * HTB, NXCD = 8, WGM = 8;

__host__ __device__ __forceinline__ int lds_byte(int r, int c) { const int st = (r >> 4) * 2 + (c >> 5), rr = r & 15, cc = c & 31, ob = rr * 64 + cc * 2; return st * 1024 + (ob ^ (((ob >> 9) & 1) << 5)); }
__host__ __device__ __forceinline__ void stage_rc(int b, int& R, int& C) { const int st = b / 1024, sb = b % 1024, swz = sb ^ (((sb >> 9) & 1) << 5); R = (st >> 1) * 16 + swz / 64; C = (st & 1) * 32 + (swz % 64) / 2; }
__host__ __device__ __forceinline__ int perm32(int rho) { const int n = rho >> 4, i = rho & 15; return 8 * (i >> 2) + 4 * n + (i & 3); }

struct Unit { int pm, pn; };
struct Gemm { const bf16_t* A; const bf16_t* Bt; int M, N, K; };

struct StaticOrder {
    int nM, nN, nwg, G, c;
    __host__ __device__ void init(int M, int N, int G_, int c_) { nM = M / BM; nN = N / BM; nwg = nM * nN; G = G_; c = c_; }
    __host__ __device__ bool next(int i, Unit& u) const {
        const long L = (long)i * G + c; if (L >= nwg) return false;
        int wgid = (int)L; { const int q = nwg / NXCD, r = nwg % NXCD, xcd = wgid % NXCD, off = wgid / NXCD; wgid = (xcd < r ? xcd * (q + 1) : r * (q + 1) + (xcd - r) * q) + off; }
        const int nig = WGM * nN, gid = wgid / nig, fm = gid * WGM, gsz = (nM - fm) < WGM ? (nM - fm) : WGM;
        u.pm = fm + ((wgid % nig) % gsz); u.pn = (wgid % nig) / gsz; return true;
    }
    __device__ __forceinline__ void a_ready(const Unit&) const {}
    __device__ __forceinline__ void done(const Unit&) const {}
};

typedef float cvt_f32x2_t __attribute__((ext_vector_type(2)));
typedef __bf16 cvt_bf16x2_t __attribute__((ext_vector_type(2)));
__device__ __forceinline__ unsigned cvt_pk_bf16(float lo, float hi) { cvt_f32x2_t v = {lo, hi}; cvt_bf16x2_t b = __builtin_convertvector(v, cvt_bf16x2_t); return __builtin_bit_cast(unsigned, b); }
typedef float f32x2 __attribute__((ext_vector_type(2)));
__device__ __forceinline__ f32x2 gelu_pk(f32x2 v) {
    const f32x2 av = __builtin_elementwise_abs(v), d = av * 0.2316418882f + 1.0f;
    f32x2 t; t.x = __builtin_amdgcn_rcpf(d.x); t.y = __builtin_amdgcn_rcpf(d.y);
    f32x2 q = t * 0.5307027145f + (-0.7265760135f); q = q * t + 0.7107068705f; q = q * t + (-0.142248368f); q = q * t + 0.127414796f; q = q * t;
    const f32x2 s = (v * v) * (-0.72134752044f);
    f32x2 e; e.x = __builtin_amdgcn_exp2f(s.x); e.y = __builtin_amdgcn_exp2f(s.y);
    const f32x2 m = v * (q * e), r = v - m;
    f32x2 o; o.x = v.x < 0.f ? m.x : r.x; o.y = v.y < 0.f ? m.y : r.y; return o;
}
__device__ __forceinline__ float bflo(unsigned u) { return __builtin_bit_cast(float, u << 16); }
__device__ __forceinline__ float bfhi(unsigned u) { return __builtin_bit_cast(float, u & 0xffff0000u); }
__device__ __forceinline__ float sigm(float z) { return __builtin_amdgcn_rcpf(1.0f + __expf(-z)); }
template <int MA, int MB> struct EpiProj {
    static constexpr bool PERM = true, AFTER_DRAIN = false;
    bf16_t* out0; size_t sec_stride; const float* lb; const unsigned long long* rowsq; int split;
    template <int MODE> __device__ __forceinline__ void run(const f32x4 (&acc)[2][2][4][2], bf16_t* base, const float* lbrow, int row0, int col0) const {
#pragma unroll
        for (int ai = 0; ai < 2; ++ai)
#pragma unroll
            for (int m = 0; m < 4; ++m) { bf16_t* rowp = base + (size_t)(row0 + ai * HALF + m * 16) * 1024 + col0;
                const float rs = rowsq ? rsqrtf((float)rowsq[row0 + ai * HALF + m * 16] * (1.0f / 16777216.0f / 1024.0f) + 1e-6f) : 1.0f;
#pragma unroll
                for (int bj = 0; bj < 2; ++bj) { f32x4 v[2] = {acc[ai][bj][m][0] * rs, acc[ai][bj][m][1] * rs};
#pragma unroll
                    for (int n = 0; n < 2; ++n) {
                        if (MODE == 0) { f32x2 a = gelu_pk((f32x2){v[n][0], v[n][1]}), b = gelu_pk((f32x2){v[n][2], v[n][3]}); v[n] = (f32x4){a.x, a.y, b.x, b.y}; }
                        else if (MODE == 2) { const f32x4 lbv = *(const f32x4*)(lbrow + bj * HALF + 4 * n);
#pragma unroll
                            for (int e = 0; e < 4; ++e) { const float l = lbv[e]; const float f = l + (1.0f - l) * sigm(v[n][e]); v[n][e] = __log2f(f); }
                        } else if (MODE == 3) {
#pragma unroll
                            for (int e = 0; e < 4; ++e) v[n][e] = v[n][e] * sigm(v[n][e]);
                        } else if (MODE == 4) {
#pragma unroll
                            for (int e = 0; e < 4; ++e) v[n][e] = sigm(v[n][e]);
                        }
                    }
                    u32x4 w; w.x = cvt_pk_bf16(v[0][0], v[0][1]); w.y = cvt_pk_bf16(v[0][2], v[0][3]); w.z = cvt_pk_bf16(v[1][0], v[1][1]); w.w = cvt_pk_bf16(v[1][2], v[1][3]);
                    *(u32x4*)(rowp + bj * HALF) = w; } }
    }
    __device__ __forceinline__ void operator()(const f32x4 (&acc)[2][2][4][2], const Unit& u, int wr, int wc, int fr, int fq) const {
        const int colt = u.pn * BM, sec = colt >> 10;
        bf16_t* base = out0 + (size_t)sec * sec_stride;
        const int col0 = (colt & 1023) + wc * 32 + 8 * fq, row0 = u.pm * BM + wr * 64 + fr;
        const float* lbrow = lb + sec * 1024 + col0;
        if (sec < split) run<MA>(acc, base, lbrow, row0, col0); else run<MB>(acc, base, lbrow, row0, col0);
    }
};
struct EpiGate {
    static constexpr bool PERM = true, AFTER_DRAIN = false;
    bf16_t* T; const bf16_t* gate2;
    __device__ __forceinline__ void operator()(const f32x4 (&acc)[2][2][4][2], const Unit& u, int wr, int wc, int fr, int fq) const {
        const bool second = u.pm >= 64;
        const int col0 = (u.pn & 3) * BM + wc * 32 + 8 * fq, row0 = (u.pm & 63) * BM + wr * 64 + fr;
        const bf16_t* gate = second ? gate2 : T;
        u32x4 cg[2], ca[2], ng[2], na[2];
        { const size_t ro = (size_t)row0 * 1024 + col0; cg[0] = *(const u32x4*)(gate + ro); cg[1] = *(const u32x4*)(gate + ro + HALF);
          ca[0] = ca[1] = (u32x4){0u, 0u, 0u, 0u}; if (second) { ca[0] = *(const u32x4*)(T + ro); ca[1] = *(const u32x4*)(T + ro + HALF); } }
#pragma unroll
        for (int ai = 0; ai < 2; ++ai)
#pragma unroll
            for (int m = 0; m < 4; ++m) { asm volatile("" ::: "memory"); __builtin_amdgcn_sched_barrier(0); const size_t ro = (size_t)(row0 + ai * HALF + m * 16) * 1024 + col0;
                if (ai * 4 + m < 7) { const int nm = (m + 1) & 3, nai = ai + ((m + 1) >> 2); const size_t rn = (size_t)(row0 + nai * HALF + nm * 16) * 1024 + col0;
                    ng[0] = *(const u32x4*)(gate + rn); ng[1] = *(const u32x4*)(gate + rn + HALF); na[0] = na[1] = (u32x4){0u, 0u, 0u, 0u}; if (second) { na[0] = *(const u32x4*)(T + rn); na[1] = *(const u32x4*)(T + rn + HALF); } }
#pragma unroll
                for (int bj = 0; bj < 2; ++bj) {
                    const u32x4 gv = cg[bj], av = ca[bj];
                    const f32x4 v0 = acc[ai][bj][m][0], v1 = acc[ai][bj][m][1];
                    u32x4 w;
                    w.x = cvt_pk_bf16(bflo(av.x) + bflo(gv.x) * v0[0], bfhi(av.x) + bfhi(gv.x) * v0[1]);
                    w.y = cvt_pk_bf16(bflo(av.y) + bflo(gv.y) * v0[2], bfhi(av.y) + bfhi(gv.y) * v0[3]);
                    w.z = cvt_pk_bf16(bflo(av.z) + bflo(gv.z) * v1[0], bfhi(av.z) + bfhi(gv.z) * v1[1]);
                    w.w = cvt_pk_bf16(bflo(av.w) + bflo(gv.w) * v1[2], bfhi(av.w) + bfhi(gv.w) * v1[3]);
                    *(u32x4*)(T + ro + bj * HALF) = w; }
                cg[0] = ng[0]; cg[1] = ng[1]; ca[0] = na[0]; ca[1] = na[1]; }
    }
};
struct PairOrder {
    StaticOrder S;
    __device__ void init(int M_, int N_, int G_, int c_) { S.init(M_, N_, G_, c_); }
    __device__ bool next(int i, Unit& u) const { if (!S.next(i >> 1, u)) return false; if (i & 1) { u.pm += 64; u.pn += 4; } return true; }
    __device__ __forceinline__ void a_ready(const Unit&) const {}
    __device__ __forceinline__ void done(const Unit&) const {}
};
template <bool F32BASE> struct EpiResid {
    static constexpr bool PERM = true, AFTER_DRAIN = false;
    const float* base32; const bf16_t* xg_in; const float* gain_in; float* out32; bf16_t* xg_out; const float* gain_out; unsigned long long* rowsq;
    __device__ __forceinline__ void ldrow(u32x4 (&r)[4], size_t ro) const {
        if (F32BASE) { r[0] = *(const u32x4*)(base32 + ro); r[1] = *(const u32x4*)(base32 + ro + 4); r[2] = *(const u32x4*)(base32 + ro + HALF); r[3] = *(const u32x4*)(base32 + ro + HALF + 4); }
        else { r[0] = *(const u32x4*)(xg_in + ro); r[1] = *(const u32x4*)(xg_in + ro + HALF); }
    }
    __device__ __forceinline__ void operator()(const f32x4 (&acc)[2][2][4][2], const Unit& u, int wr, int wc, int fr, int fq) const {
        const int col0 = u.pn * BM + wc * 32 + 8 * fq, row0 = u.pm * BM + wr * 64 + fr;
        u32x4 cur[4], nxt[4];
        if (!F32BASE) ldrow(cur, (size_t)row0 * 1024 + col0);
#pragma unroll
        for (int ai = 0; ai < 2; ++ai)
#pragma unroll
            for (int m = 0; m < 4; ++m) { asm volatile("" ::: "memory"); __builtin_amdgcn_sched_barrier(0); const int row = row0 + ai * HALF + m * 16; const size_t ro = (size_t)row * 1024 + col0; float ss = 0.f;
                if (F32BASE) ldrow(cur, ro); else if (ai * 4 + m < 7) { const int nm = (m + 1) & 3, nai = ai + ((m + 1) >> 2); ldrow(nxt, (size_t)(row0 + nai * HALF + nm * 16) * 1024 + col0); }
#pragma unroll
                for (int bj = 0; bj < 2; ++bj) { f32x4 h[2];
                    if (F32BASE) { h[0] = __builtin_bit_cast(f32x4, cur[2 * bj]); h[1] = __builtin_bit_cast(f32x4, cur[2 * bj + 1]); }
                    else { const u32x4 xv = cur[bj];
                        const f32x4 g0 = *(const f32x4*)(gain_in + col0 + bj * HALF), g1 = *(const f32x4*)(gain_in + col0 + bj * HALF + 4);
                        h[0] = (f32x4){bflo(xv.x) * __builtin_amdgcn_rcpf(g0[0]), bfhi(xv.x) * __builtin_amdgcn_rcpf(g0[1]), bflo(xv.y) * __builtin_amdgcn_rcpf(g0[2]), bfhi(xv.y) * __builtin_amdgcn_rcpf(g0[3])};
                        h[1] = (f32x4){bflo(xv.z) * __builtin_amdgcn_rcpf(g1[0]), bfhi(xv.z) * __builtin_amdgcn_rcpf(g1[1]), bflo(xv.w) * __builtin_amdgcn_rcpf(g1[2]), bfhi(xv.w) * __builtin_amdgcn_rcpf(g1[3])}; }
#pragma unroll
                    for (int n = 0; n < 2; ++n) { h[n] = h[n] + acc[ai][bj][m][n]; if (out32) *(f32x4*)(out32 + ro + bj * HALF + 4 * n) = h[n];
                        ss += (h[n][0] * h[n][0] + h[n][1] * h[n][1]) + (h[n][2] * h[n][2] + h[n][3] * h[n][3]); }
                    if (xg_out) { const f32x4 g0 = *(const f32x4*)(gain_out + col0 + bj * HALF), g1 = *(const f32x4*)(gain_out + col0 + bj * HALF + 4);
                        u32x4 w; w.x = cvt_pk_bf16(h[0][0] * g0[0], h[0][1] * g0[1]); w.y = cvt_pk_bf16(h[0][2] * g0[2], h[0][3] * g0[3]); w.z = cvt_pk_bf16(h[1][0] * g1[0], h[1][1] * g1[1]); w.w = cvt_pk_bf16(h[1][2] * g1[2], h[1][3] * g1[3]);
                        *(u32x4*)(xg_out + ro + bj * HALF) = w; } }
                if (xg_out) { ss += __shfl_xor(ss, 16); ss += __shfl_xor(ss, 32); if (fq == 0) atomicAdd(rowsq + row, (unsigned long long)(ss * 16777216.0f)); }
                if (!F32BASE) { cur[0] = nxt[0]; cur[1] = nxt[1]; } }
    }
};
struct EpiRelu2 {
    static constexpr bool PERM = true, AFTER_DRAIN = false;
    bf16_t* out; int ldc; const unsigned long long* rowsq;
    __device__ __forceinline__ void operator()(const f32x4 (&acc)[2][2][4][2], const Unit& u, int wr, int wc, int fr, int fq) const {
        const int col0 = u.pn * BM + wc * 32 + 8 * fq, row0 = u.pm * BM + wr * 64 + fr;
#pragma unroll
        for (int ai = 0; ai < 2; ++ai)
#pragma unroll
            for (int m = 0; m < 4; ++m) { asm volatile("" ::: "memory"); __builtin_amdgcn_sched_barrier(0); bf16_t* rowp = out + (size_t)(row0 + ai * HALF + m * 16) * ldc + col0;
                const float rs = rsqrtf((float)rowsq[row0 + ai * HALF + m * 16] * (1.0f / 16777216.0f / 1024.0f) + 1e-6f);
#pragma unroll
                for (int bj = 0; bj < 2; ++bj) { f32x4 v0 = acc[ai][bj][m][0] * rs, v1 = acc[ai][bj][m][1] * rs;
#pragma unroll
                    for (int e = 0; e < 4; ++e) { const float a = fmaxf(v0[e], 0.f), b = fmaxf(v1[e], 0.f); v0[e] = a * a; v1[e] = b * b; }
                    u32x4 w; w.x = cvt_pk_bf16(v0[0], v0[1]); w.y = cvt_pk_bf16(v0[2], v0[3]); w.z = cvt_pk_bf16(v1[0], v1[1]); w.w = cvt_pk_bf16(v1[2], v1[3]);
                    *(u32x4*)(rowp + bj * HALF) = w; } }
    }
};
template <class Epi, class Sched, bool ALIGN_EPI = false, bool SP2 = false>
__device__ __forceinline__ void gemm_phase(PG8_LAS unsigned char* lds, const Gemm g, const Sched& S, const Epi& E) {
    int tid_l = threadIdx.x; asm volatile("" : "+v"(tid_l));
    const int tid = tid_l, wid = __builtin_amdgcn_readfirstlane(tid >> 6), lane = tid & 63, wr = wid >> 2, wc = wid & 3, fr = lane & 15, fq = lane >> 4;
    const int K = g.K, nt = K / BK;
    unsigned voffA[2], voffB[2];
#pragma unroll
    for (int i = 0; i < 2; ++i) { int R, C; stage_rc(tid * 16 + i * 8192, R, C); const int Rb = Epi::PERM ? ((R & ~31) + perm32(R & 31)) : R;
        voffA[i] = (unsigned)(R * K + C) * 2u; voffB[i] = (unsigned)(Rb * K + C) * 2u; }
    const size_t kstep = (size_t)(BK * 2);
    const size_t hstep = (size_t)HALF * K * 2;
    const size_t tstep = 2 * hstep;
    const unsigned ldsw = (unsigned)wid * 1024u;
    const int aoff = lds_byte(wr * 64 + fr, fq * 8), boff = lds_byte(wc * 32 + fr, fq * 8);
#define PG8_SA(b, h) (((b) * 2 + (h)) * HTB)
#define PG8_SB(b, h) ((4 + (b) * 2 + (h)) * HTB)
#define PG8_STAGE(bufoff, gbase, voff) do { _Pragma("unroll") for (int _i = 0; _i < 2; ++_i) \
        __builtin_amdgcn_global_load_lds((const unsigned*)((const char*)(gbase) + (voff)[_i]), (PG8_LAS unsigned*)(lds + (bufoff) + ldsw + _i * 8192), 16, 0, 0); } while (0)
#define PG8_LDA(dst, b, h) do { _Pragma("unroll") for (int m = 0; m < 4; ++m) _Pragma("unroll") for (int k = 0; k < 2; ++k) dst[m][k] = *(const PG8_LAS bf16x8*)(lds + PG8_SA(b, h) + aoff + m * 2048 + k * 1024); } while (0)
#define PG8_LDB(dst, b, h) do { _Pragma("unroll") for (int n = 0; n < 2; ++n) _Pragma("unroll") for (int k = 0; k < 2; ++k) dst[n][k] = *(const PG8_LAS bf16x8*)(lds + PG8_SB(b, h) + boff + n * 2048 + k * 1024); } while (0)
#define PG8_MMA(ai, bj, At, Bt) do { __builtin_amdgcn_s_setprio(1); _Pragma("unroll") for (int m = 0; m < 4; ++m) _Pragma("unroll") for (int n = 0; n < 2; ++n) _Pragma("unroll") for (int k = 0; k < 2; ++k) \
        acc[ai][bj][m][n] = __builtin_amdgcn_mfma_f32_16x16x32_bf16(Bt[n][k], At[m][k], acc[ai][bj][m][n], 0, 0, 0); __builtin_amdgcn_s_setprio(0); } while (0)
#define PG8_WAIT_V(n) asm volatile("s_waitcnt vmcnt(" #n ")" ::: "memory")
#define PG8_WAIT_L(n) asm volatile("s_waitcnt lgkmcnt(" #n ")" ::: "memory")
#define PG8_BAR __builtin_amdgcn_s_barrier()
#define PG8_SCHED __builtin_amdgcn_sched_barrier(0)
    Unit cur, nxt; int ui = 0;
    if (!S.next(0, cur)) return;
    f32x4 acc[2][2][4][2];
#pragma unroll
    for (int a = 0; a < 2; ++a)
#pragma unroll
        for (int b = 0; b < 2; ++b)
#pragma unroll
            for (int m = 0; m < 4; ++m)
#pragma unroll
                for (int n = 0; n < 2; ++n) acc[a][b][m][n] = (f32x4){0.f, 0.f, 0.f, 0.f};
    bf16x8 At[4][2], B0[2][2], B1[2][2];
    const char* cA = (const char*)g.A + (size_t)cur.pm * tstep; const char* cB = (const char*)g.Bt + (size_t)cur.pn * tstep;
    S.a_ready(cur);
    if constexpr (SP2) {
        PG8_STAGE(PG8_SB(0, 0), cB, voffB); PG8_STAGE(PG8_SB(0, 1), cB + hstep, voffB); PG8_STAGE(PG8_SA(0, 0), cA, voffA); PG8_STAGE(PG8_SA(0, 1), cA + hstep, voffA);
        if (wr == 1) PG8_BAR;
        PG8_WAIT_V(2); PG8_BAR;
        PG8_STAGE(PG8_SB(1, 0), cB + kstep, voffB); PG8_STAGE(PG8_SA(1, 0), cA + kstep, voffA); PG8_STAGE(PG8_SB(1, 1), cB + hstep + kstep, voffB);
        PG8_WAIT_V(6); PG8_BAR;
    } else {
        PG8_STAGE(PG8_SB(0, 0), cB, voffB); PG8_STAGE(PG8_SA(0, 0), cA, voffA); PG8_STAGE(PG8_SB(0, 1), cB + hstep, voffB); PG8_STAGE(PG8_SA(0, 1), cA + hstep, voffA);
        if (wr == 1) PG8_BAR;
        PG8_WAIT_V(4); PG8_BAR;
        PG8_STAGE(PG8_SB(1, 0), cB + kstep, voffB); PG8_STAGE(PG8_SA(1, 0), cA + kstep, voffA); PG8_STAGE(PG8_SB(1, 1), cB + hstep + kstep, voffB);
        PG8_WAIT_V(6); PG8_BAR;
    }
    for (;;) {
        const bool has_next = S.next(ui + 1, nxt);
        const char* nA = has_next ? (const char*)g.A + (size_t)nxt.pm * tstep : cA; const char* nB = has_next ? (const char*)g.Bt + (size_t)nxt.pn * tstep : cB;
        for (int t = 0; t < nt; t += 2) {
            const bool last = (t == nt - 2);
            const char* a1 = cA + (size_t)(t + 1) * kstep;
            const char* a2 = last ? nA : cA + (size_t)(t + 2) * kstep; const char* b2 = last ? nB : cB + (size_t)(t + 2) * kstep;
            const char* a3 = a2 + kstep; const char* b3 = b2 + kstep;
            if (last && has_next) S.a_ready(nxt);
            if constexpr (SP2) {
            PG8_LDB(B0, 0, 0); PG8_LDB(B1, 0, 1); PG8_SCHED; PG8_LDA(At, 0, 0); PG8_STAGE(PG8_SA(1, 1), a1 + hstep, voffA);
            PG8_WAIT_V(8); PG8_WAIT_L(0); PG8_BAR; PG8_MMA(0, 0, At, B0); PG8_MMA(0, 1, At, B1); PG8_BAR; PG8_SCHED;
            PG8_LDA(At, 0, 1); PG8_STAGE(PG8_SB(0, 0), b2, voffB); PG8_STAGE(PG8_SB(0, 1), b2 + hstep, voffB); PG8_STAGE(PG8_SA(0, 0), a2, voffA);
            PG8_WAIT_V(8); PG8_WAIT_L(0); PG8_BAR; PG8_MMA(1, 0, At, B0); PG8_MMA(1, 1, At, B1); PG8_BAR; PG8_SCHED;
            PG8_LDB(B0, 1, 0); PG8_LDB(B1, 1, 1); PG8_SCHED; PG8_LDA(At, 1, 0); PG8_STAGE(PG8_SA(0, 1), a2 + hstep, voffA);
            PG8_WAIT_V(8); PG8_WAIT_L(0); PG8_BAR; PG8_MMA(0, 0, At, B0); PG8_MMA(0, 1, At, B1); PG8_BAR; PG8_SCHED;
            PG8_LDA(At, 1, 1); PG8_STAGE(PG8_SB(1, 0), b3, voffB); PG8_STAGE(PG8_SB(1, 1), b3 + hstep, voffB); PG8_STAGE(PG8_SA(1, 0), a3, voffA);
            PG8_WAIT_V(8); PG8_WAIT_L(0); PG8_BAR; PG8_MMA(1, 0, At, B0); PG8_MMA(1, 1, At, B1); PG8_BAR; PG8_SCHED;
            } else {
            PG8_LDB(B0, 0, 0); PG8_SCHED; PG8_LDA(At, 0, 0); PG8_STAGE(PG8_SA(1, 1), a1 + hstep, voffA);
            PG8_WAIT_L(8); PG8_BAR; PG8_WAIT_L(0); PG8_MMA(0, 0, At, B0); PG8_BAR; PG8_SCHED;
            PG8_LDB(B1, 0, 1); PG8_STAGE(PG8_SB(0, 0), b2, voffB);
            PG8_BAR; PG8_WAIT_L(0); PG8_MMA(0, 1, At, B1); PG8_BAR;
            PG8_LDA(At, 0, 1); PG8_STAGE(PG8_SA(0, 0), a2, voffA);
            PG8_BAR; PG8_WAIT_L(0); PG8_MMA(1, 0, At, B0); PG8_BAR; PG8_SCHED;
            PG8_STAGE(PG8_SB(0, 1), b2 + hstep, voffB);
            PG8_WAIT_V(6); PG8_BAR; PG8_MMA(1, 1, At, B1); PG8_BAR;
            PG8_LDB(B0, 1, 0); PG8_SCHED; PG8_LDA(At, 1, 0); PG8_STAGE(PG8_SA(0, 1), a2 + hstep, voffA);
            PG8_WAIT_L(8); PG8_BAR; PG8_WAIT_L(0); PG8_MMA(0, 0, At, B0); PG8_BAR; PG8_SCHED;
            PG8_LDB(B1, 1, 1); PG8_STAGE(PG8_SB(1, 0), b3, voffB);
            PG8_BAR; PG8_WAIT_L(0); PG8_MMA(0, 1, At, B1); PG8_BAR;
            PG8_LDA(At, 1, 1); PG8_STAGE(PG8_SA(1, 0), a3, voffA);
            PG8_BAR; PG8_WAIT_L(0); PG8_MMA(1, 0, At, B0); PG8_BAR; PG8_SCHED;
            PG8_STAGE(PG8_SB(1, 1), b3 + hstep, voffB);
            PG8_WAIT_V(6); PG8_BAR; PG8_MMA(1, 1, At, B1); PG8_BAR;
            }
        }
        if constexpr (ALIGN_EPI) { if (wr == 0) PG8_BAR; }
        if constexpr (!Epi::AFTER_DRAIN) { E(acc, cur, wr, wc, fr, fq); S.done(cur); }
        if (!has_next) break;
#pragma unroll
        for (int a = 0; a < 2; ++a)
#pragma unroll
            for (int b = 0; b < 2; ++b)
#pragma unroll
                for (int m = 0; m < 4; ++m)
#pragma unroll
                    for (int n = 0; n < 2; ++n) acc[a][b][m][n] = (f32x4){0.f, 0.f, 0.f, 0.f};
        cur = nxt; cA = nA; cB = nB; ++ui;
        if constexpr (ALIGN_EPI) { if (wr == 1) PG8_BAR; }
    }
    PG8_WAIT_V(0);
    if constexpr (!ALIGN_EPI) { if (wr == 0) PG8_BAR; }
    PG8_BAR;
    if constexpr (Epi::AFTER_DRAIN) { E.fused(acc, cur, wr, wc, fr, fq, lds, wid, lane); S.done(cur); }
#undef PG8_SA
#undef PG8_SB
#undef PG8_STAGE
#undef PG8_LDA
#undef PG8_LDB
#undef PG8_MMA
#undef PG8_WAIT_V
#undef PG8_WAIT_L
#undef PG8_BAR
#undef PG8_SCHED
}
}

#define LAS __attribute__((address_space(3)))
typedef unsigned short bf16;
typedef unsigned v4u __attribute__((ext_vector_type(4)));
typedef unsigned v2u __attribute__((ext_vector_type(2)));
typedef float f32x4 __attribute__((ext_vector_type(4)));
typedef float f32x2 __attribute__((ext_vector_type(2)));
typedef short bf16x8 __attribute__((ext_vector_type(8)));
typedef short s16x4 __attribute__((ext_vector_type(4)));
using pg8::bflo; using pg8::bfhi; using pg8::cvt_pk_bf16;

#ifndef PROJ_ALIGN
#define PROJ_ALIGN true
#endif
#ifndef ONE_LAUNCH
#define ONE_LAUNCH 1
#endif
constexpr int DM = 1024, BATCH = 8, SEQ = 2048, M = BATCH * SEQ, NIN = 9216, DFF = 4096, DEPTH = 2;
constexpr float EPS = 1e-6f;
constexpr int NTHR = 512, NWAVES = 8;
constexpr int LDS_RING = 131072, LDS_BYTES = LDS_RING + 64;
constexpr size_t MiB = 1u << 20;
constexpr size_t WS_RSQ = 256 * 1024;
constexpr size_t WS_WSB = 768 * 1024;
constexpr size_t WS_LB = 64 * 1024;
constexpr size_t WS_WIN = 1 * MiB, WS_WPA = 19 * MiB, WS_WPB = 21 * MiB, WS_WOUT = 23 * MiB;
constexpr size_t WS_B0 = 25 * MiB, BUFB = 32 * MiB;
constexpr size_t WS_END = WS_B0 + 8 * BUFB;
#define WS_BUF(i) (WS_B0 + (size_t)(i) * BUFB)
constexpr size_t WS_WUP = WS_BUF(6), WS_WDN = WS_BUF(6) + 8 * MiB;
constexpr int PH_PER_LAYER = 10, NPH = DEPTH * PH_PER_LAYER + 1;

__device__ __forceinline__ float wave_sum(float v) {
#pragma unroll
    for (int o = 1; o < 64; o <<= 1) v += __shfl_xor(v, o);
    return v;
}
__device__ __forceinline__ void transpose_item(const float* W, int K, int N, bf16* WT, LAS float* scr, int item, int lane) {
    const int nblk = N / 32, kb = item / nblk, nb = item % nblk, k0 = 64 * kb, n0 = 32 * nb;
#pragma unroll
    for (int i = 0; i < 8; ++i) { const int kk = 8 * i + (lane >> 3), c4 = lane & 7; const f32x4 v = __builtin_nontemporal_load((const f32x4*)(W + (size_t)(k0 + kk) * N + n0 + 4 * c4));
        LAS float* d = scr + kk * 33 + 4 * c4; d[0] = v.x; d[1] = v.y; d[2] = v.z; d[3] = v.w; }
    asm volatile("s_waitcnt lgkmcnt(0)" ::: "memory");
    const int c = lane & 7;
#pragma unroll
    for (int j = 0; j < 4; ++j) { const int n = (lane >> 3) + 8 * j; const LAS float* s = scr + (8 * c) * 33 + n;
        v4u o; o.x = cvt_pk_bf16(s[0 * 33], s[1 * 33]); o.y = cvt_pk_bf16(s[2 * 33], s[3 * 33]); o.z = cvt_pk_bf16(s[4 * 33], s[5 * 33]); o.w = cvt_pk_bf16(s[6 * 33], s[7 * 33]);
        *(v4u*)(WT + (size_t)(n0 + n) * K + k0 + 8 * c) = o; }
    asm volatile("s_waitcnt lgkmcnt(0)" ::: "memory");
}
__device__ __forceinline__ void convert_weight(const float* W, int K, int N, bf16* WT, LAS unsigned char* lds, int gw, int NGW, int wave, int lane) {
    LAS float* scr = (LAS float*)(lds + wave * 16384);
    const int nitems = (K / 64) * (N / 32);
    for (int it = gw; it < nitems; it += NGW) transpose_item(W, K, N, WT, scr, it, lane);
}
__device__ __forceinline__ void rms_row_bf16(const float* xrow, const float* gain, bf16* orow, int lane) {
    const f32x4* xr = (const f32x4*)xrow + lane; const f32x4* gr = (const f32x4*)gain + lane;
    f32x4 v[4]; float s = 0.f;
#pragma unroll
    for (int j = 0; j < 4; ++j) { v[j] = xr[64 * j]; s += (v[j].x * v[j].x + v[j].y * v[j].y) + (v[j].z * v[j].z + v[j].w * v[j].w); }
    const float rstd = rsqrtf(wave_sum(s) * (1.f / DM) + EPS);
    v2u* o8 = (v2u*)orow + lane;
#pragma unroll
    for (int j = 0; j < 4; ++j) { const f32x4 gg = gr[64 * j]; v2u o; o.x = cvt_pk_bf16(v[j].x * rstd * gg.x, v[j].y * rstd * gg.y); o.y = cvt_pk_bf16(v[j].z * rstd * gg.z, v[j].w * rstd * gg.w); o8[64 * j] = o; }
}
__device__ __forceinline__ void rms_row_f32(const float* xrow, const float* gain, float* orow, int lane) {
    const f32x4* xr = (const f32x4*)xrow + lane; const f32x4* gr = (const f32x4*)gain + lane;
    f32x4 v[4]; float s = 0.f;
#pragma unroll
    for (int j = 0; j < 4; ++j) { v[j] = xr[64 * j]; s += (v[j].x * v[j].x + v[j].y * v[j].y) + (v[j].z * v[j].z + v[j].w * v[j].w); }
    const float rstd = rsqrtf(wave_sum(s) * (1.f / DM) + EPS);
    f32x4* o = (f32x4*)orow + lane;
#pragma unroll
    for (int j = 0; j < 4; ++j) { const f32x4 gg = gr[64 * j]; o[64 * j] = v[j] * rstd * gg; }
}

__device__ __forceinline__ void sg_phase(LAS unsigned char* lds, bf16* ZU, const bf16* ZV, const bf16* WSB, const float* bs_l, const float* sgn_l, int bid, int G, unsigned* done) {
    int tid_l = threadIdx.x; asm volatile("" : "+v"(tid_l));
    const int tid = tid_l, lane = tid & 63, w = __builtin_amdgcn_readfirstlane(tid >> 6), g = lane >> 4, r16 = lane & 15;
    LAS unsigned char* VGT = lds; LAS unsigned char* WSL = lds + 34816;
    const int s = tid >> 2, dq = tid & 3;
    v4u z[4], wv[4];
#define SG_LOAD(item) do { const int gq_ = (item) & 7, row0_ = ((item) >> 3) * 128; \
        _Pragma("unroll") for (int e = 0; e < 4; ++e) { z[e] = *(const v4u*)(ZV + (size_t)(row0_ + s) * 1024 + gq_ * 128 + dq * 32 + 8 * e); if (!sib || first_) wv[e] = *(const v4u*)(WSB + (size_t)gq_ * 16384 + s * 128 + dq * 32 + 8 * e); } } while (0)
    const bool sib = (G == 256);
    const int sb_ = ((bid & 7) | ((bid >> 4) << 3)), sq_ = (sb_ & 1) * 2 + ((bid >> 3) & 1), sbase_ = (((sb_ >> 4) * 16 + 4 * sq_) << 3) | ((sb_ >> 1) & 7);
    const int nit = sib ? 4 : (1024 - bid + G - 1) / G;
#define SG_ITEM(j) (sib ? (sbase_ + ((j) << 3)) : (bid + (j) * G))
    bool first_ = true;
    if (nit > 0) SG_LOAD(SG_ITEM(0));
    first_ = false;
    for (int jj = 0; jj < nit; ++jj) { const int item = SG_ITEM(jj);
        const int gq = item & 7, bc = item >> 3, row0 = bc * 128, col0 = gq * 128;
        {
            float ss = 0.f;
#pragma unroll
            for (int e = 0; e < 4; ++e)
#pragma unroll
                for (int q = 0; q < 4; ++q) { const float a = bflo(z[e][q]), b = bfhi(z[e][q]); ss += a * a + b * b; }
            ss += __shfl_xor(ss, 1); ss += __shfl_xor(ss, 2);
            const float rstd = rsqrtf(ss * (1.f / 128.f) + EPS);
#pragma unroll
            for (int e = 0; e < 4; ++e) {
                const f32x4 n0 = *(const f32x4*)(sgn_l + col0 + dq * 32 + 8 * e), n1 = *(const f32x4*)(sgn_l + col0 + dq * 32 + 8 * e + 4);
#pragma unroll
                for (int q = 0; q < 4; ++q) { const int d = dq * 32 + 8 * e + 2 * q; const float na = q < 2 ? n0[2 * q] : n1[2 * q - 4], nb = q < 2 ? n0[2 * q + 1] : n1[2 * q - 3];
                    const unsigned pk = cvt_pk_bf16(bflo(z[e][q]) * rstd * na, bfhi(z[e][q]) * rstd * nb);
                    *(LAS unsigned short*)(VGT + d * 272 + (s ^ (16 * dq)) * 2) = (unsigned short)(pk & 0xffffu);
                    *(LAS unsigned short*)(VGT + (d + 1) * 272 + (s ^ (16 * dq)) * 2) = (unsigned short)(pk >> 16); }
                if (!sib || jj == 0) *(LAS v4u*)(WSL + s * 272 + (dq * 32 + 8 * e) * 2) = wv[e]; }
        }
        __syncthreads();
        if (jj + 1 < nit) SG_LOAD(SG_ITEM(jj + 1));
        {
            bf16x8 bw[4];
#pragma unroll
            for (int ks = 0; ks < 4; ++ks) bw[ks] = *(const LAS bf16x8*)(WSL + (16 * w + r16) * 272 + (32 * ks + 8 * g) * 2);
            const int row = row0 + 16 * w + r16; const float bias = bs_l[gq * 128 + 16 * w + r16];
            v2u zu[8];
#pragma unroll
            for (int dt = 0; dt < 8; ++dt) zu[dt] = *(const v2u*)(ZU + (size_t)row * 1024 + col0 + 16 * dt + 4 * g);
#pragma unroll
            for (int dt = 0; dt < 8; ++dt) { f32x4 acc = (f32x4){0.f, 0.f, 0.f, 0.f};
#pragma unroll
                for (int ks = 0; ks < 4; ++ks) { const bf16x8 a = *(const LAS bf16x8*)(VGT + (16 * dt + r16) * 272 + ((32 * ks + 8 * g) ^ (16 * (dt >> 1))) * 2); acc = __builtin_amdgcn_mfma_f32_16x16x32_bf16(a, bw[ks], acc, 0, 0, 0); }
                v2u o; o.x = cvt_pk_bf16(bflo(zu[dt].x) * (acc[0] + bias), bfhi(zu[dt].x) * (acc[1] + bias)); o.y = cvt_pk_bf16(bflo(zu[dt].y) * (acc[2] + bias), bfhi(zu[dt].y) * (acc[3] + bias));
                *(v2u*)(ZU + (size_t)row * 1024 + col0 + 16 * dt + 4 * g) = o; }
        }
        __syncthreads();
        if (tid == 0) __hip_atomic_fetch_add(done + (bc >> 4) * 8 + gq, 1u, __ATOMIC_RELAXED, __HIP_MEMORY_SCOPE_AGENT);
    }
#undef SG_LOAD
#undef SG_ITEM
}

constexpr int HG_QH = 0, HG_KH = 17408, HG_KT = 34816, HG_VT = 53248, HG_EBM = 62464, HG_EBL = 62976, HG_IMG = 63488;
__device__ __forceinline__ bf16x8 hg_ld2(const LAS unsigned char* p) {
    const v2u lo = *(const LAS v2u*)p, hi = *(const LAS v2u*)(p + 32); return __builtin_bit_cast(bf16x8, (v4u){lo.x, lo.y, hi.x, hi.y});
}
__device__ __forceinline__ bf16x8 hg_ld2s(const LAS unsigned char* row, int e0) {
    const v2u lo = *(const LAS v2u*)(row + 2 * e0), hi = *(const LAS v2u*)(row + 2 * (e0 ^ 16)); return __builtin_bit_cast(bf16x8, (v4u){lo.x, lo.y, hi.x, hi.y});
}
__device__ __forceinline__ void hg_phase(LAS unsigned char* lds, const bf16* Qb, const bf16* LFfw, const bf16* LFbw, const bf16* IVb, bf16* Ofw, bf16* Obw, int bid, int G, const unsigned* done) {
    int tid_l = threadIdx.x; asm volatile("" : "+v"(tid_l));
    const int tid = tid_l, lane = tid & 63, w = __builtin_amdgcn_readfirstlane(tid >> 6), g = lane >> 4, r16 = lane & 15;
    const int vsp = tid & 31, vq = tid >> 5;
    const int kp = lane & 7, tg = lane >> 3, ek = 16 * w + 2 * kp, et0 = 8 * tg, ekz = ek ^ (16 * (tg >> 1));
    for (int item = bid; item < 256; item += G) {
        const int vh = (item >> 3) & 1, chain = (item & 7) | ((item >> 4) << 3), dir = chain & 1, h = (chain >> 1) & 7, b = chain >> 4;
        const bf16* LF = dir ? LFbw : LFfw; bf16* O = dir ? Obw : Ofw;
        const size_t colq = (size_t)h * 128 + ek, colv = (size_t)h * 128 + vh * 64;
#define HG_ROW(c, tau) ((size_t)(b * SEQ + (dir ? (SEQ - 1 - (64 * (c) + (tau))) : (64 * (c) + (tau)))))
        f32x4 S[8];
#pragma unroll
        for (int kt = 0; kt < 8; ++kt) S[kt] = (f32x4){0.f, 0.f, 0.f, 0.f};
        unsigned lfr[8], qr[8]; v2u vr0, vr1;
#define HG_LOAD(c) do { _Pragma("unroll") for (int j = 0; j < 8; ++j) { const size_t ro = HG_ROW(c, et0 + j) * 1024 + colq; lfr[j] = *(const unsigned*)(LF + ro); qr[j] = *(const unsigned*)(Qb + ro); } \
        vr0 = *(const v2u*)(IVb + HG_ROW(c, 2 * vsp) * 1024 + colv + 4 * vq); vr1 = *(const v2u*)(IVb + HG_ROW(c, 2 * vsp + 1) * 1024 + colv + 4 * vq); } while (0)
#define HG_EW(img) do { LAS unsigned char* I_ = lds + (img) * HG_IMG; float f0_[8], f1_[8]; float a0_ = 0.f, a1_ = 0.f; \
        _Pragma("unroll") for (int j = 0; j < 8; ++j) { const float l0_ = bflo(lfr[j]), l1_ = bfhi(lfr[j]); a0_ += l0_; a1_ += l1_; f0_[j] = __builtin_amdgcn_exp2f(l0_); f1_[j] = __builtin_amdgcn_exp2f(l1_); } \
        float i0_ = a0_, i1_ = a1_; { float u0_ = __shfl_up(i0_, 8), u1_ = __shfl_up(i1_, 8); if (tg >= 1) { i0_ += u0_; i1_ += u1_; } \
            u0_ = __shfl_up(i0_, 16); u1_ = __shfl_up(i1_, 16); if (tg >= 2) { i0_ += u0_; i1_ += u1_; } u0_ = __shfl_up(i0_, 32); u1_ = __shfl_up(i1_, 32); if (tg >= 4) { i0_ += u0_; i1_ += u1_; } } \
        const float bm0_ = __shfl(i0_, kp + 24), bm1_ = __shfl(i1_, kp + 24), bl0_ = __shfl(i0_, kp + 56), bl1_ = __shfl(i1_, kp + 56); \
        const float off0_ = i0_ - a0_ - bm0_, off1_ = i1_ - a1_ - bm1_; \
        float ek0_ = __builtin_amdgcn_exp2f(fminf(-(off0_ + a0_), 115.f)), ek1_ = __builtin_amdgcn_exp2f(fminf(-(off1_ + a1_), 115.f)); \
        unsigned kw_[8]; \
        _Pragma("unroll") for (int j = 7; j >= 0; --j) { const float k0_ = (1.f - f0_[j]) * ek0_, k1_ = (1.f - f1_[j]) * ek1_; ek0_ *= f0_[j]; ek1_ *= f1_[j]; kw_[j] = cvt_pk_bf16(k0_, k1_); } \
        float eq0_ = __builtin_amdgcn_exp2f(fminf(off0_ + bflo(lfr[0]), 115.f)), eq1_ = __builtin_amdgcn_exp2f(fminf(off1_ + bfhi(lfr[0]), 115.f)); \
        _Pragma("unroll") for (int j = 0; j < 8; ++j) { if (j > 0) { eq0_ *= f0_[j]; eq1_ *= f1_[j]; } \
            *(LAS unsigned*)(I_ + HG_QH + (et0 + j) * 272 + 2 * ekz) = cvt_pk_bf16(bflo(qr[j]) * eq0_, bfhi(qr[j]) * eq1_); \
            *(LAS unsigned*)(I_ + HG_KH + (et0 + j) * 272 + 2 * ekz) = kw_[j]; } \
        *(LAS v4u*)(I_ + HG_KT + ek * 144 + 2 * et0) = (v4u){(kw_[0] & 0xffffu) | (kw_[1] << 16), (kw_[2] & 0xffffu) | (kw_[3] << 16), (kw_[4] & 0xffffu) | (kw_[5] << 16), (kw_[6] & 0xffffu) | (kw_[7] << 16)}; \
        *(LAS v4u*)(I_ + HG_KT + (ek + 1) * 144 + 2 * et0) = (v4u){(kw_[0] >> 16) | (kw_[1] & 0xffff0000u), (kw_[2] >> 16) | (kw_[3] & 0xffff0000u), (kw_[4] >> 16) | (kw_[5] & 0xffff0000u), (kw_[6] >> 16) | (kw_[7] & 0xffff0000u)}; \
        if (tg == 0) { *(LAS f32x2*)(I_ + HG_EBM + 4 * ek) = (f32x2){__builtin_amdgcn_exp2f(bm0_), __builtin_amdgcn_exp2f(bm1_)}; *(LAS f32x2*)(I_ + HG_EBL + 4 * ek) = (f32x2){__builtin_amdgcn_exp2f(bl0_ - bm0_), __builtin_amdgcn_exp2f(bl1_ - bm1_)}; } \
          \
        *(LAS unsigned*)(I_ + HG_VT + (4 * vq + 0) * 144 + 4 * vsp) = (vr0.x & 0xffffu) | (vr1.x << 16); \
        *(LAS unsigned*)(I_ + HG_VT + (4 * vq + 1) * 144 + 4 * vsp) = (vr0.x >> 16) | (vr1.x & 0xffff0000u); \
        *(LAS unsigned*)(I_ + HG_VT + (4 * vq + 2) * 144 + 4 * vsp) = (vr0.y & 0xffffu) | (vr1.y << 16); \
        *(LAS unsigned*)(I_ + HG_VT + (4 * vq + 3) * 144 + 4 * vsp) = (vr0.y >> 16) | (vr1.y & 0xffff0000u); } while (0)
        HG_LOAD(0);
        HG_EW(0);
        HG_LOAD(1);
        if (dir == 0) {
            if (tid == 0) { unsigned sp = 0; while (__hip_atomic_load(done + b * 8 + h, __ATOMIC_RELAXED, __HIP_MEMORY_SCOPE_AGENT) < 16u) { __builtin_amdgcn_s_sleep(2); if (++sp > (1u << 24)) break; } }
        }
        __syncthreads();
        const int vt = w & 3, th = w >> 2;
        for (int c = 0; c < 32; ++c) {
            if (c + 1 < 32) { HG_EW((c + 1) & 1); if (c + 2 < 32) HG_LOAD(c + 2); }
            {
                const LAS unsigned char* I = lds + (c & 1) * HG_IMG;
                const LAS unsigned char* QH = I + HG_QH; const LAS unsigned char* KH = I + HG_KH; const LAS unsigned char* KT = I + HG_KT; const LAS unsigned char* VT = I + HG_VT;
                const LAS float* EBM = (const LAS float*)(I + HG_EBM); const LAS float* EBL = (const LAS float*)(I + HG_EBL);
#define HG_FENCE __builtin_amdgcn_sched_barrier(0)
                bf16x8 As[4], avp[2], avn[2];
                { f32x4 em[8];
#pragma unroll
                  for (int kt = 0; kt < 8; ++kt) em[kt] = *(const LAS f32x4*)(EBM + 16 * kt + 4 * g);
#pragma unroll
                  for (int ks = 0; ks < 2; ++ks) { avp[ks] = hg_ld2(VT + (16 * vt + r16) * 144 + (32 * ks + 4 * g) * 2); avn[ks] = *(const LAS bf16x8*)(VT + (16 * vt + r16) * 144 + (32 * ks + 8 * g) * 2); }
                  HG_FENCE;
#pragma unroll
                  for (int kt = 0; kt < 8; ++kt) S[kt] = S[kt] * em[kt]; }
#pragma unroll
                for (int ks = 0; ks < 4; ++ks) { const unsigned x0 = cvt_pk_bf16(S[2 * ks][0], S[2 * ks][1]), x1 = cvt_pk_bf16(S[2 * ks][2], S[2 * ks][3]), x2 = cvt_pk_bf16(S[2 * ks + 1][0], S[2 * ks + 1][1]), x3 = cvt_pk_bf16(S[2 * ks + 1][2], S[2 * ks + 1][3]);
                    As[ks] = __builtin_bit_cast(bf16x8, (v4u){x0, x1, x2, x3}); }
#pragma unroll
                for (int ttl = 0; ttl < 2; ++ttl) { const int tt = th ? (1 + ttl) : (3 * ttl), trow = 16 * tt + r16; const LAS unsigned char* qrow = QH + trow * 272;
                    bf16x8 bq[4], bqp[4];
#pragma unroll
                    for (int ks = 0; ks < 4; ++ks) { bqp[ks] = hg_ld2s(qrow, (32 * ks + 4 * g) ^ (16 * tt)); bq[ks] = *(const LAS bf16x8*)(qrow + 2 * ((32 * ks + 8 * g) ^ (16 * tt))); }
                    HG_FENCE;
                    f32x4 oacc = (f32x4){0.f, 0.f, 0.f, 0.f};
#pragma unroll
                    for (int ks = 0; ks < 4; ++ks) oacc = __builtin_amdgcn_mfma_f32_16x16x32_bf16(As[ks], bqp[ks], oacc, 0, 0, 0);
#pragma unroll
                    for (int kp2 = 0; kp2 < 2; ++kp2) if (kp2 <= (tt >> 1)) {
                        const int st0 = 2 * kp2, st1 = 2 * kp2 + 1; const bool two = (st1 <= tt);
                        bf16x8 ka[4], kb[4];
#pragma unroll
                        for (int ks = 0; ks < 4; ++ks) { ka[ks] = *(const LAS bf16x8*)(KH + (16 * st0 + r16) * 272 + 2 * ((32 * ks + 8 * g) ^ (16 * st0)));
                            if (two) kb[ks] = *(const LAS bf16x8*)(KH + (16 * st1 + r16) * 272 + 2 * ((32 * ks + 8 * g) ^ (16 * st1))); }
                        HG_FENCE;
                        f32x4 p0 = (f32x4){0.f, 0.f, 0.f, 0.f}, p1 = (f32x4){0.f, 0.f, 0.f, 0.f};
#pragma unroll
                        for (int ks = 0; ks < 4; ++ks) { p0 = __builtin_amdgcn_mfma_f32_16x16x32_bf16(ka[ks], bq[ks], p0, 0, 0, 0); if (two) p1 = __builtin_amdgcn_mfma_f32_16x16x32_bf16(kb[ks], bq[ks], p1, 0, 0, 0); }
                        if (st0 == tt) {
#pragma unroll
                            for (int i = 0; i < 4; ++i) if (4 * g + i > r16) p0[i] = 0.f; }
                        if (two && st1 == tt) {
#pragma unroll
                            for (int i = 0; i < 4; ++i) if (4 * g + i > r16) p1[i] = 0.f; }
                        unsigned pw2 = 0u, pw3 = 0u; if (two) { pw2 = cvt_pk_bf16(p1[0], p1[1]); pw3 = cvt_pk_bf16(p1[2], p1[3]); }
                        oacc = __builtin_amdgcn_mfma_f32_16x16x32_bf16(avp[kp2], __builtin_bit_cast(bf16x8, (v4u){cvt_pk_bf16(p0[0], p0[1]), cvt_pk_bf16(p0[2], p0[3]), pw2, pw3}), oacc, 0, 0, 0);
                    }
                    *(v2u*)(O + HG_ROW(c, trow) * 1024 + colv + vt * 16 + 4 * g) = (v2u){cvt_pk_bf16(oacc[0], oacc[1]), cvt_pk_bf16(oacc[2], oacc[3])};
                }
#pragma unroll
                for (int hf = 0; hf < 2; ++hf) {
                    bf16x8 kc[8]; f32x4 el[4];
#pragma unroll
                    for (int q = 0; q < 4; ++q) { const int kt = 4 * hf + q; el[q] = *(const LAS f32x4*)(EBL + 16 * kt + 4 * g);
#pragma unroll
                        for (int ks = 0; ks < 2; ++ks) kc[2 * q + ks] = *(const LAS bf16x8*)(KT + (16 * kt + r16) * 144 + (32 * ks + 8 * g) * 2); }
                    HG_FENCE;
#pragma unroll
                    for (int ks = 0; ks < 2; ++ks)
#pragma unroll
                        for (int q = 0; q < 4; ++q) S[4 * hf + q] = __builtin_amdgcn_mfma_f32_16x16x32_bf16(kc[2 * q + ks], avn[ks], S[4 * hf + q], 0, 0, 0);
#pragma unroll
                    for (int q = 0; q < 4; ++q) S[4 * hf + q] = S[4 * hf + q] * el[q];
                    HG_FENCE; }
#undef HG_FENCE
            }
            __syncthreads();
        }
#undef HG_ROW
#undef HG_LOAD
#undef HG_EW
    }
}

__device__ __forceinline__ void cb_row(bf16* Ofw, const bf16* Obw, const bf16* OG, const float* gain, size_t row, int lane) {
    const size_t o = row * 1024 + 16 * lane;
    v4u a[2], b[2], gq[2]; float s[16]; float ss = 0.f;
#pragma unroll
    for (int e = 0; e < 2; ++e) { a[e] = *(const v4u*)(Ofw + o + 8 * e); b[e] = *(const v4u*)(Obw + o + 8 * e); gq[e] = *(const v4u*)(OG + o + 8 * e); }
#pragma unroll
    for (int e = 0; e < 2; ++e)
#pragma unroll
        for (int q = 0; q < 4; ++q) { const float x = bflo(a[e][q]) + bflo(b[e][q]), y = bfhi(a[e][q]) + bfhi(b[e][q]); s[8 * e + 2 * q] = x; s[8 * e + 2 * q + 1] = y; ss += x * x + y * y; }
    ss += __shfl_xor(ss, 1); ss += __shfl_xor(ss, 2); ss += __shfl_xor(ss, 4);
    const float rstd = rsqrtf(ss * (1.f / 128.f) + EPS);
#pragma unroll
    for (int e = 0; e < 2; ++e) { v4u ov;
#pragma unroll
        for (int q = 0; q < 4; ++q) { const f32x2 gn = *(const f32x2*)(gain + 16 * lane + 8 * e + 2 * q);
            ov[q] = cvt_pk_bf16(s[8 * e + 2 * q] * rstd * gn.x * bflo(gq[e][q]), s[8 * e + 2 * q + 1] * rstd * gn.y * bfhi(gq[e][q])); }
        *(v4u*)(Ofw + o + 8 * e) = ov; }
}

#define XB_TMO      128
#define XB_XCNT(j)  (256  + 64 * (j))
#define XB_XSUB(j)  (1280 + 64 * (j))
#define XB_XGEN(j)  (2304 + 64 * (j))
#define XB_TOP      3328
#define XB_TOPGEN   3392
#define XCD_BAR_WORDS 3456
#define XB_SPIN_CAP (1u << 18)

__device__ __forceinline__ unsigned xb_ld(unsigned* p)              { return __hip_atomic_load(p, __ATOMIC_RELAXED, __HIP_MEMORY_SCOPE_AGENT); }
__device__ __forceinline__ unsigned xb_add(unsigned* p, unsigned v) { return __hip_atomic_fetch_add(p, v, __ATOMIC_RELAXED, __HIP_MEMORY_SCOPE_AGENT); }
__device__ __forceinline__ unsigned xb_xcc_id() { return (unsigned)__builtin_amdgcn_s_getreg((3 << 11) | 20) & 0xFu; }
#define XB_SPIN(cond, bar) do { unsigned _sp = 0; while (cond) { __builtin_amdgcn_s_sleep(1); \
    if ((++_sp & 255u) == 0u) { if (xb_ld(&(bar)[XB_TMO])) break; if (_sp > XB_SPIN_CAP) { atomicAdd(&(bar)[XB_TMO], 1u); break; } } } } while (0)

struct XcdBarrier {
    unsigned* bar; unsigned x;
    volatile LAS unsigned* st;
};

__device__ __forceinline__ XcdBarrier xcd_barrier_post(unsigned* bar, volatile LAS unsigned* st) {
    XcdBarrier b; b.bar = bar; b.x = xb_xcc_id(); b.st = st;
    if (threadIdx.x == 0) (void)xb_add(&bar[XB_XCNT(b.x)], 1u);
    return b;
}
__device__ __forceinline__ void xcd_barrier_complete(unsigned* bar, unsigned x, unsigned& nloc, unsigned& nx) {
    const unsigned G = gridDim.x * gridDim.y * gridDim.z;
    unsigned sum, cnt, mine, sp = 0u;
    for (;;) {
        sum = 0u; cnt = 0u; mine = 0u;
#pragma unroll
        for (unsigned j = 0; j < 16; ++j) { const unsigned c = xb_ld(&bar[XB_XCNT(j)]); sum += c; cnt += (c > 0u) ? 1u : 0u; mine = (j == x) ? c : mine; }
        if (sum == G) break;
        __builtin_amdgcn_s_sleep(1);
        if ((++sp & 255u) == 0u) { if (xb_ld(&bar[XB_TMO])) break; if (sp > XB_SPIN_CAP) { atomicAdd(&bar[XB_TMO], 1u); break; } }
    }
    nloc = mine > 0u ? mine : 1u; nx = cnt > 0u ? cnt : 1u;
}

__device__ __forceinline__ void xcd_barrier(const XcdBarrier& b) {
    asm volatile("s_waitcnt vmcnt(0)" ::: "memory");
    __syncthreads();
    if (threadIdx.x == 0) {
        unsigned* bar = b.bar;
        __builtin_amdgcn_s_waitcnt(0);
        unsigned nloc = b.st[0], nx = b.st[1];
        if (nloc == 0u) { xcd_barrier_complete(bar, b.x, nloc, nx); b.st[0] = nloc; b.st[1] = nx; }
        const unsigned old = xb_add(&bar[XB_XSUB(b.x)], 1u);
        const unsigned gen = old / nloc;
        if (old + 1u == (gen + 1u) * nloc) {
            __builtin_amdgcn_fence(__ATOMIC_RELEASE, "agent");
            asm volatile("s_waitcnt vmcnt(0)" ::: "memory");
            const unsigned og = xb_add(&bar[XB_TOP], 1u);
            const unsigned tg = og / nx;
            if (og + 1u == (tg + 1u) * nx) xb_add(&bar[XB_TOPGEN], 1u);
            else XB_SPIN(xb_ld(&bar[XB_TOPGEN]) == tg, bar);
            __builtin_amdgcn_fence(__ATOMIC_ACQUIRE, "agent");
            xb_add(&bar[XB_XGEN(b.x)], 1u);
            asm volatile("s_waitcnt vmcnt(0)" ::: "memory");
        } else {
            XB_SPIN(xb_ld(&bar[XB_XGEN(b.x)]) == gen, bar);
            __builtin_amdgcn_fence(__ATOMIC_ACQUIRE, "agent");
            asm volatile("s_waitcnt vmcnt(0)" ::: "memory");
        }
    }
    __syncthreads();
}

struct Args { const float* in[15]; float* out; unsigned char* ws; int ph_lo, ph_hi; };

__global__ void __launch_bounds__(NTHR, 2) fwd(Args a) {
    extern __shared__ __attribute__((aligned(16))) unsigned char lds_raw[];
    LAS unsigned char* lds = (LAS unsigned char*)lds_raw;
    const int G = gridDim.x, bid = blockIdx.x, NGW = G * NWAVES;
    volatile LAS unsigned* MISC = (volatile LAS unsigned*)(lds + LDS_RING);
    if (threadIdx.x < 16) MISC[threadIdx.x] = 0u;
    __syncthreads();
    XcdBarrier xbar; xbar.bar = (unsigned*)a.ws; xbar.x = 0; xbar.st = nullptr;
    if (a.ph_hi - a.ph_lo > 1) xbar = xcd_barrier_post((unsigned*)a.ws, MISC);
    const float* x = a.in[0]; const float* w_in = a.in[1]; const float* ln_mix = a.in[2]; const float* ln_mlp = a.in[3]; const float* sg_norm = a.in[4];
    const float* w_s = a.in[5]; const float* b_s = a.in[6]; const float* lb_logits = a.in[7]; const float* rec_norm = a.in[8];
    const float* w_pa = a.in[9]; const float* w_pb = a.in[10]; const float* w_out = a.in[11]; const float* w_up = a.in[12]; const float* w_down = a.in[13]; const float* ln_final = a.in[14];
#define BUF(i) ((bf16*)(ws + WS_BUF(i)))
#define CONVERT_LAYER(LL) do { {    LAS float* scr = (LAS float*)(lds + wave * 16384); constexpr int I_IN = (DM / 64) * (NIN / 32), I_SQ = (DM / 64) * (DM / 32); for (int it = gw; it < I_IN + 3 * I_SQ; it += NGW) { if (it < I_IN) transpose_item(w_in + (size_t)(LL) * DM * NIN, DM, NIN, WIN, scr, it, lane); else { const int r = it - I_IN, which = r / I_SQ, ii = r % I_SQ; const float* src = (which == 0 ? w_pa : which == 1 ? w_pb : w_out) + (size_t)(LL) * DM * DM; bf16* dst = which == 0 ? WPA : which == 1 ? WPB : WOUT; transpose_item(src, DM, DM, dst, scr, ii, lane); } } } { const float* wsrc = w_s + (size_t)(LL) * 8 * 16384; unsigned* wdst = (unsigned*)(ws + WS_WSB); for (int i = bid * NTHR + tid; i < 8 * 16384 / 2; i += G * NTHR) { const f32x2 v = *(const f32x2*)(wsrc + 2 * i); wdst[i] = cvt_pk_bf16(v.x, v.y); } } } while (0)
    for (int p = a.ph_lo; p < a.ph_hi; ++p) {
        if (p != NPH - 1 && (p % PH_PER_LAYER) == 3) continue;
        if (p > a.ph_lo) { asm volatile("s_waitcnt vmcnt(0)" ::: "memory");
#ifdef PROBE_SYNC
            const unsigned long long ts0 = __builtin_amdgcn_s_memrealtime();
#endif
            if (a.ph_lo < 0) cg::this_grid().sync();
            xcd_barrier(xbar);
#ifdef PROBE_SYNC
            { const unsigned long long ts1 = __builtin_amdgcn_s_memrealtime(); if (blockIdx.x == PROBE_SYNC_BLK && threadIdx.x == 0) { float* pp = (float*)(a.ws + 32768); const float prev = (p == a.ph_lo + 1) ? 0.f : *(volatile float*)pp; *pp = prev + (float)(ts1 - ts0) * (1.0f / PROBE_DIV); } }
#endif
            }
        int tid = threadIdx.x; asm volatile("" : "+v"(tid));
        const int lane = tid & 63, wave = __builtin_amdgcn_readfirstlane(tid >> 6), gw = bid * NWAVES + wave;
        unsigned char* ws = a.ws; asm volatile("" : "+s"(ws));
        float* out = a.out; asm volatile("" : "+s"(out));
        float* LB = (float*)(ws + WS_LB); unsigned long long* RSQ = (unsigned long long*)(ws + WS_RSQ);
        bf16* WIN = (bf16*)(ws + WS_WIN); bf16* WPA = (bf16*)(ws + WS_WPA); bf16* WPB = (bf16*)(ws + WS_WPB); bf16* WOUT = (bf16*)(ws + WS_WOUT);
        bf16* WUP = (bf16*)(ws + WS_WUP); bf16* WDN = (bf16*)(ws + WS_WDN);
#ifdef DBG_NRUN
        if (p == DBG_NRUN) {
            for (size_t i = (size_t)bid * NTHR + tid; i < (size_t)M * DM; i += (size_t)G * NTHR) { float s = (DBG_NRUN >= 8) ? out[i] : 0.f;
                for (int k = 0; k < 8; ++k) s += bflo((unsigned)((const bf16*)(ws + WS_BUF(k)))[i]); out[i] = s; }
            continue;
        }
        if (p > DBG_NRUN) continue;
#endif
        if (p == NPH - 1) {
            for (int m = gw; m < M; m += NGW) {
                const float rs = rsqrtf((float)RSQ[3 * (size_t)M + m] * (1.0f / 16777216.0f / 1024.0f) + EPS);
                const v4u* xr = (const v4u*)(BUF(0) + (size_t)m * DM) + lane; f32x4* o = (f32x4*)(out + (size_t)m * DM) + 2 * lane;
#pragma unroll
                for (int j = 0; j < 2; ++j) { const v4u xv = xr[64 * j];
                    o[128 * j] = (f32x4){bflo(xv.x) * rs, bfhi(xv.x) * rs, bflo(xv.y) * rs, bfhi(xv.y) * rs}; o[128 * j + 1] = (f32x4){bflo(xv.z) * rs, bfhi(xv.z) * rs, bflo(xv.w) * rs, bfhi(xv.w) * rs}; }
            }
            continue;
        }
        const int l = p / PH_PER_LAYER, j = p % PH_PER_LAYER;
#ifdef PROBE_PH
        unsigned long long t0p = 0; if ((PROBE_PH >> j) & 1) t0p = __builtin_amdgcn_s_memrealtime();
#endif
        const float* hin = (l == 0) ? x : out;
#ifndef PHASE_MASK
#define PHASE_MASK 0x7ff
#endif
        if (!((PHASE_MASK >> j) & 1)) continue;
        switch (j) {
        case 0: {
#ifdef DBG_FILL
            if (l == 0) { v4u* fp = (v4u*)(ws + WS_BUF(1)); const size_t n16 = (size_t)7 * BUFB / 16; for (size_t i = (size_t)bid * NTHR + tid; i < n16; i += (size_t)G * NTHR) fp[i] = (v4u){DBG_FILL, DBG_FILL, DBG_FILL, DBG_FILL}; }
#endif
            CONVERT_LAYER(l);
            for (int i = bid * NTHR + tid; i < 2 * DM; i += G * NTHR) { LB[i] = 0.f; LB[2 * DM + i] = 1.f / (1.f + __expf(lb_logits[i] - lb_logits[2 * DM + i])); }
            if (l == 0) {
                for (int i = bid * NTHR + tid; i < 4 * M; i += G * NTHR) RSQ[i] = 0ull;
                for (int m = gw; m < M; m += NGW) rms_row_bf16(hin + (size_t)m * DM, ln_mix + l * DM, BUF(0) + (size_t)m * DM, lane);
            }
            __syncthreads();
        } break;
        case 1: {
#define PROJ(MA, MB, split, sec0, bufi, lbp) { pg8::Gemm g{BUF(0), WIN + (size_t)(sec0) * DM * DM, M, 3 * DM, DM}; pg8::StaticOrder S; S.init(M, 3 * DM, G, bid); \
            pg8::EpiProj<MA, MB> E{BUF(bufi), (size_t)M * DM, lbp, (l == 0) ? (const unsigned long long*)nullptr : (const unsigned long long*)(RSQ + M), split}; pg8::gemm_phase<pg8::EpiProj<MA, MB>, pg8::StaticOrder, PROJ_ALIGN, true>(lds, g, S, E); }
            PROJ(0, 1, 2, 0, 1, LB) PROJ(2, 3, 2, 3, 4, LB + (size_t)l * 2 * DM)
        } break;
        case 2: {
            unsigned* done = (unsigned*)(ws + 14336) + l * 64;
            sg_phase(lds, BUF(1), BUF(2), (const bf16*)(ws + WS_WSB), b_s + (size_t)l * 1024, sg_norm + (size_t)l * DM, bid, G, done);
            hg_phase(lds, BUF(3), BUF(4), BUF(5), BUF(6), BUF(2), BUF(7), bid, G, done);
        } break;
        case 3: break;
        case 4: {
            PROJ(3, 4, 1, 6, 3, LB)
        } break;
        case 5: {
            convert_weight(w_up + (size_t)l * DM * DFF, DM, DFF, WUP, lds, gw, NGW, wave, lane);
            convert_weight(w_down + (size_t)l * DFF * DM, DFF, DM, WDN, lds, gw, NGW, wave, lane);
            for (int m = gw; m < M; m += NGW) cb_row(BUF(2), BUF(7), BUF(3), rec_norm + (size_t)l * DM, (size_t)m, lane);
            __syncthreads();
        } break;
        case 6: {
            pg8::Gemm g{BUF(1), WPA, 2 * M, 2 * DM, DM}; pg8::PairOrder S; S.init(M, DM, G, bid); pg8::EpiGate E{BUF(4), BUF(5)};
            pg8::gemm_phase<pg8::EpiGate, pg8::PairOrder, true, true>(lds, g, S, E);
        } break;
        case 7: {
            pg8::Gemm g{BUF(4), WOUT, M, DM, DM}; pg8::StaticOrder S; S.init(M, DM, G, bid);
            if (l == 0) { pg8::EpiResid<true> E{x, (const bf16*)nullptr, ln_mix, (float*)nullptr, BUF(0), ln_mlp, RSQ};
                pg8::gemm_phase<pg8::EpiResid<true>, pg8::StaticOrder, true, true>(lds, g, S, E); }
            else { pg8::EpiResid<false> E{(const float*)nullptr, BUF(0), ln_mix + DM, (float*)nullptr, BUF(0), ln_mlp + DM, RSQ + 2 * (size_t)M};
                pg8::gemm_phase<pg8::EpiResid<false>, pg8::StaticOrder, true, true>(lds, g, S, E); }
        } break;
        case 8: {
            pg8::Gemm g{BUF(0), WUP, M, DFF, DM}; pg8::StaticOrder S; S.init(M, DFF, G, bid); pg8::EpiRelu2 E{BUF(1), DFF, RSQ + (size_t)(l == 0 ? 0 : 2) * M};
            pg8::gemm_phase<pg8::EpiRelu2, pg8::StaticOrder, true, true>(lds, g, S, E);
        } break;
        case 9: {
            pg8::Gemm g{BUF(1), WDN, M, DM, DFF}; pg8::StaticOrder S; S.init(M, DM, G, bid);
            pg8::EpiResid<false> E{(const float*)nullptr, BUF(0), ln_mlp + l * DM, (float*)nullptr, BUF(0), (l == 0) ? ln_mix + DM : ln_final, RSQ + (size_t)(l == 0 ? 1 : 3) * M};
            pg8::gemm_phase<pg8::EpiResid<false>, pg8::StaticOrder, true, true>(lds, g, S, E);
        } break;
        }
#ifdef PROBE_PH
        if ((PROBE_PH >> j) & 1) { asm volatile("s_waitcnt vmcnt(0)" ::: "memory"); __syncthreads(); const unsigned long long t1p = __builtin_amdgcn_s_memrealtime();
#ifdef PROBE_MAX
            if (tid == 0) atomicMax((unsigned*)(ws + 32768) + 1 + p, (unsigned)(t1p - t0p));
#else
            if (bid == 0 && tid == 0) atomicAdd((unsigned*)(ws + 32768) + 1 + p, (unsigned)(t1p - t0p));
#endif
        }
#endif
    }
#if defined(PROBE_PH)
    if (bid == 0 && threadIdx.x == 0) { asm volatile("s_waitcnt vmcnt(0)" ::: "memory"); unsigned s = 0; for (int q = 0; q < NPH; ++q) s += __hip_atomic_load((unsigned*)(a.ws + 32768) + 1 + q, __ATOMIC_RELAXED, __HIP_MEMORY_SCOPE_AGENT); a.out[0] = (float)s * (1.0f / PROBE_DIV); }
#elif defined(PROBE_SYNC)
    if (bid == 0 && threadIdx.x == 0) { asm volatile("s_waitcnt vmcnt(0)" ::: "memory"); a.out[0] = *(volatile float*)(a.ws + 32768); }
#endif
#undef BUF
}

extern "C" void kernel_launch(void* const* d_in, const int* in_sizes, int n_in, void* d_out, int out_size, void* d_ws, size_t ws_size, hipStream_t stream) {
    static int grid = 0;
    if (grid == 0) {
        if (n_in != 15 || out_size != M * DM || ws_size < WS_END) { fprintf(stderr, "kernel_launch: unexpected problem (n_in %d, out %d, ws %zu < %zu)\n", n_in, out_size, ws_size, (size_t)WS_END); grid = -1; return; }
        int dev = 0, cus = 0, per_cu = 0;
        hipGetDevice(&dev); hipDeviceGetAttribute(&cus, hipDeviceAttributeMultiprocessorCount, dev);
        if (hipFuncSetAttribute((const void*)fwd, hipFuncAttributeMaxDynamicSharedMemorySize, LDS_BYTES) != hipSuccess) { fprintf(stderr, "kernel_launch: hipFuncSetAttribute failed\n"); grid = -1; return; }
        if (hipOccupancyMaxActiveBlocksPerMultiprocessor(&per_cu, (const void*)fwd, NTHR, LDS_BYTES) != hipSuccess || per_cu < 1) { fprintf(stderr, "kernel_launch: occupancy query says %d\n", per_cu); per_cu = 1; }
        (void)hipGetLastError();
        grid = cus;
    }
    if (grid < 0) return;
#if defined(PROBE_PH)
    (void)hipMemsetAsync((char*)d_ws + 32768, 0, 512, stream);
#endif
    (void)hipMemsetAsync(d_ws, 0, 16384, stream);
    Args a{};
    for (int i = 0; i < 15; ++i) a.in[i] = (const float*)d_in[i];
    a.out = (float*)d_out; a.ws = (unsigned char*)d_ws;
#if ONE_LAUNCH
    a.ph_lo = 0; a.ph_hi = NPH;
    void* args[] = {&a};
    hipError_t e = hipLaunchCooperativeKernel((const void*)fwd, dim3(grid), dim3(NTHR), args, LDS_BYTES, stream);
    if (e != hipSuccess) fprintf(stderr, "cooperative launch failed: %s (grid %d)\n", hipGetErrorString(e), grid);
#else
    for (int p = 0; p < NPH; ++p) { a.ph_lo = p; a.ph_hi = p + 1; hipLaunchKernelGGL(fwd, dim3(grid), dim3(NTHR), LDS_BYTES, stream, a); }
#endif
}
```
